# Optimizing an MI355X kernel written in HIP

```python
import math
import jax, jax.numpy as jnp
from jax import lax
import numpy as np

D_MODEL = 2048
BATCH = 4
SEQ = 2048
DEPTH = 2

N_MEM = 256
GRID_W = 64
MIX_W = D_MODEL
NA_HEAD_DIM = 64
NA_W = 3 * MIX_W // 8
NA_HEADS = NA_W // NA_HEAD_DIM
NA_KR = 8
NA_KC = 16
HY_W = MIX_W // 4
HY_ORDER = 2
HY_BANDS = 8
HY_POS_DIM = 1 + 2 * HY_BANDS
HY_FILT_FF = 64
HY_FAST_DECAY_PCT = 0.3
HY_SLOW_DECAY_PCT = 1.5
HY_DECAY_TARGET = 1e-2
RET_HEAD_DIM = 128
RET_W = MIX_W - NA_W - HY_W
RET_HEADS = RET_W // RET_HEAD_DIM
RET_CHUNK = 128
P_IN = 3 * NA_W + 3 * HY_W + 4 * RET_W
CROSS_HEADS = 4
CROSS_HEAD_DIM = D_MODEL // CROSS_HEADS
N_EXPERTS = 16
EXPERT_FF = 2048
EC_CAPACITY = 2
RMS_EPS = 1e-6
GN_EPS = 1e-5

kernel_name = "hymba_style_hybrid_encoder"

F32 = jnp.float32


def rms_norm(x, g):
    xf = x.astype(F32)
    y = xf * lax.rsqrt(jnp.mean(xf * xf, axis=-1, keepdims=True) + RMS_EPS)
    return (y * g.astype(F32)).astype(x.dtype)


def group_rms_norm(parts, gain):
    normed = [p.astype(F32) * lax.rsqrt(jnp.mean(jnp.square(p.astype(F32)), axis=-1, keepdims=True) + RMS_EPS) for p in parts]
    y = jnp.concatenate(normed, axis=-1) * gain.astype(F32)
    return y.astype(parts[0].dtype)


def neighbourhood_attention(q, k, v, rpb):
    B, L, H, dh = q.shape
    rows = L // GRID_W
    kr = min(NA_KR, rows)
    q = q.reshape(B, rows, GRID_W, H, dh)
    k = k.reshape(B, rows, GRID_W, H, dh)
    v = v.reshape(B, rows, GRID_W, H, dh)
    r = jnp.arange(rows)
    row_start = jnp.clip(r - kr // 2, 0, rows - kr)
    row_idx = row_start[:, None] + jnp.arange(kr)[None, :]
    k_band = k[:, row_idx]
    v_band = v[:, row_idx]
    s = jnp.einsum('brchd,brkwhd->bhrckw', q, k_band).astype(F32) * (dh ** -0.5)
    c = jnp.arange(GRID_W)
    col_start = jnp.clip(c - NA_KC // 2, 0, GRID_W - NA_KC)
    col_in = (c[None, :] >= col_start[:, None]) & (c[None, :] < col_start[:, None] + NA_KC)
    dr = row_idx - r[:, None] + (NA_KR - 1)
    dc = jnp.clip(c[None, :] - c[:, None] + (NA_KC - 1), 0, 2 * NA_KC - 2)
    bias = rpb[:, dr[:, None, :, None], dc[None, :, None, :]].astype(F32)
    s = jnp.where(col_in[None, None, None, :, None, :], s + bias[None], -jnp.inf)
    p = jax.nn.softmax(s, axis=(-2, -1)).astype(v.dtype)
    o = jnp.einsum('bhrckw,brkwhd->brchd', p, v_band)
    return o.reshape(B, L, H * dh)


def hyena_filters(L, w1, b1, w2, b2, w3, freq):
    t = jnp.arange(L, dtype=F32)
    t01 = t / (L - 1)
    bands = jnp.linspace(1e-4, HY_BANDS - 1, HY_BANDS, dtype=F32)
    ang = (2.0 * math.pi) * (t[:, None] / L) * bands[None, :]
    feats = jnp.concatenate([t01[:, None], jnp.cos(ang), -jnp.sin(ang)], axis=-1)
    f = freq.astype(F32)
    h = jnp.sin(f * (feats @ w1.astype(F32) + b1.astype(F32)))
    h = jnp.sin(f * (h @ w2.astype(F32) + b2.astype(F32)))
    h = (h @ w3.astype(F32)).reshape(L, HY_ORDER, 2, HY_W)
    min_decay = math.log(HY_DECAY_TARGET) / HY_SLOW_DECAY_PCT
    max_decay = math.log(HY_DECAY_TARGET) / HY_FAST_DECAY_PCT
    deltas = jnp.abs(jnp.linspace(min_decay, max_decay, HY_W, dtype=F32))
    window = jnp.exp(-t01[:, None] * deltas[None, :])
    return h * window[:, None, None, :]


def hyena_mixer(u, conv_w, conv_b, w1, b1, w2, b2, w3, freq, skip_d):
    B, L, _ = u.shape
    p = jnp.pad(u, ((0, 0), (1, 1), (0, 0)))
    s = p[:, :-2] * conv_w[0] + p[:, 1:-1] * conv_w[1] + p[:, 2:] * conv_w[2] + conv_b
    x1, x2, v = jnp.split(s, 3, axis=-1)
    filt = hyena_filters(L, w1, b1, w2, b2, w3, freq)
    kbuf = jnp.concatenate([filt[:, :, 0], jnp.zeros((1, HY_ORDER, HY_W), F32), filt[1:, :, 1][::-1]], axis=0)
    kfreq = jnp.fft.rfft(kbuf, axis=0)
    n = 2 * L
    z = v.astype(F32)
    for o, gate in enumerate((x1, x2)):
        conv = jnp.fft.irfft(jnp.fft.rfft(z, n=n, axis=1) * kfreq[None, :, o], n=n, axis=1)[:, :L]
        z = gate.astype(F32) * (conv + skip_d[o].astype(F32) * z)
    return z.astype(u.dtype)


def rotary(x, pos):
    half = x.shape[-1] // 2
    inv = 1.0 / (10000.0 ** jnp.linspace(0.0, 1.0, half, dtype=F32))
    ang = pos[:, None] * inv[None, :]
    cos = jnp.cos(ang)[None, :, None, :]
    sin = jnp.sin(ang)[None, :, None, :]
    x1, x2 = x[..., :half], x[..., half:]
    return jnp.concatenate([x1 * cos - x2 * sin, x1 * sin + x2 * cos], axis=-1)


def retention_chunkwise(q, k, v, log_gamma, include_diag):
    B, H, L, d = q.shape
    c = RET_CHUNK
    n = L // c
    qc = q.reshape(B, H, n, c, d)
    kc = k.reshape(B, H, n, c, d)
    vc = v.reshape(B, H, n, c, d)
    i = jnp.arange(c, dtype=F32)
    diff = i[:, None] - i[None, :]
    mask = (diff >= 0) if include_diag else (diff > 0)
    dec = jnp.where(mask[None], jnp.exp(log_gamma[:, None, None] * jnp.where(mask, diff, 0.0)[None]), 0.0)
    a = jnp.einsum('bhnid,bhnjd->bhnij', qc, kc) * dec[None, :, None]
    y = jnp.einsum('bhnij,bhnje->bhnie', a, vc)
    zeta = jnp.exp(log_gamma[:, None] * (c - 1 - i)[None, :])
    kv = jnp.einsum('bhnjd,hj,bhnje->nbhde', kc, zeta, vc)
    chunk_decay = jnp.exp(log_gamma * c)[None, :, None, None]

    def step(state, kv_n):
        return chunk_decay * state + kv_n, state

    _, prev = lax.scan(step, jnp.zeros((B, H, d, d), F32), kv)
    xi = jnp.exp(log_gamma[:, None] * (i + 1.0)[None, :])
    y = y + jnp.einsum('bhnid,hi,nbhde->bhnie', qc, xi, prev)
    return y.reshape(B, H, L, d)


def retention_mixer(r_in):
    B, L, _ = r_in.shape
    q, k, v, g = jnp.split(r_in, 4, axis=-1)
    shp = (B, L, RET_HEADS, RET_HEAD_DIM)
    pos = jnp.arange(L, dtype=F32)
    q = rotary(q.reshape(shp).astype(F32), pos) * (RET_HEAD_DIM ** -0.5)
    k = rotary(k.reshape(shp).astype(F32), pos)
    v = v.reshape(shp).astype(F32)
    q, k, v = (jnp.transpose(t, (0, 2, 1, 3)) for t in (q, k, v))
    hidx = jnp.arange(RET_HEADS, dtype=F32)
    lg_fwd = jnp.log1p(-jnp.exp2(-5.0 - hidx))
    lg_bwd = jnp.log1p(-jnp.exp2(-5.5 - hidx))
    y_f = retention_chunkwise(q, k, v, lg_fwd, True)
    y_b = jnp.flip(retention_chunkwise(jnp.flip(q, 2), jnp.flip(k, 2), jnp.flip(v, 2), lg_bwd, False), 2)
    y = jnp.transpose(y_f + y_b, (0, 2, 1, 3))
    mu = jnp.mean(y, axis=-1, keepdims=True)
    var = jnp.mean(jnp.square(y - mu), axis=-1, keepdims=True)
    y = ((y - mu) * lax.rsqrt(var + GN_EPS)).reshape(B, L, RET_W)
    return (y * jax.nn.silu(g.astype(F32))).astype(r_in.dtype)


def cross_attend(h, mem_n, w_cq, w_ckv, w_co):
    B, L, _ = h.shape
    M = mem_n.shape[1]
    q = (h @ w_cq).reshape(B, L, CROSS_HEADS, CROSS_HEAD_DIM)
    kv = (mem_n @ w_ckv).reshape(B, M, 2, CROSS_HEADS, CROSS_HEAD_DIM)
    k, v = kv[:, :, 0], kv[:, :, 1]
    s = jnp.einsum('blhd,bmhd->bhlm', q, k).astype(F32) * (CROSS_HEAD_DIM ** -0.5)
    p = jax.nn.softmax(s, axis=-1).astype(v.dtype)
    o = jnp.einsum('bhlm,bmhd->blhd', p, v).reshape(B, L, D_MODEL)
    return o @ w_co


def expert_choice_ffn(h, w_router, w_gate, w_up, w_down):
    B, T, D = h.shape
    cap = EC_CAPACITY * T // N_EXPERTS
    aff = jax.nn.softmax(jnp.einsum('btd,de->bte', h, w_router).astype(F32), axis=-1)
    g, idx = lax.top_k(jnp.transpose(aff, (0, 2, 1)), cap)
    xe = jax.vmap(lambda hb, ib: hb[ib])(h, idx)
    a = jnp.einsum('becd,edf->becf', xe, w_gate)
    u = jnp.einsum('becd,edf->becf', xe, w_up)
    y = jnp.einsum('becf,efd->becd', jax.nn.silu(a) * u, w_down)
    y = y * g[..., None].astype(y.dtype)
    return jax.vmap(lambda yb, ib: jnp.zeros((T, D), yb.dtype).at[ib.reshape(-1)].add(yb.reshape(-1, D)))(y, idx)


def setup_inputs(seed: int = 0) -> dict:
    key = jax.random.key(seed)
    ks = jax.random.split(key, 32)

    def nrm(k, shape, scale):
        return jax.random.normal(k, shape, F32) * scale

    def gain(k, shape):
        return 1.0 + 0.05 * jax.random.normal(k, shape, F32)

    L_ = DEPTH
    return {
        "x": nrm(ks[0], (BATCH, SEQ, D_MODEL), 1.0),
        "mem": nrm(ks[1], (BATCH, N_MEM, D_MODEL), 1.0),
        "norm_mix": gain(ks[2], (L_, D_MODEL)),
        "w_in": nrm(ks[3], (L_, D_MODEL, P_IN), D_MODEL ** -0.5),
        "na_rpb": nrm(ks[4], (L_, NA_HEADS, 2 * NA_KR - 1, 2 * NA_KC - 1), 0.02),
        "hy_conv_w": nrm(ks[5], (L_, 3, 3 * HY_W), 3 ** -0.5),
        "hy_conv_b": nrm(ks[6], (L_, 3 * HY_W), 0.02),
        "hy_filt_w1": nrm(ks[7], (L_, HY_POS_DIM, HY_FILT_FF), HY_POS_DIM ** -0.5),
        "hy_filt_b1": nrm(ks[8], (L_, HY_FILT_FF), 0.02),
        "hy_filt_w2": nrm(ks[9], (L_, HY_FILT_FF, HY_FILT_FF), HY_FILT_FF ** -0.5),
        "hy_filt_b2": nrm(ks[10], (L_, HY_FILT_FF), 0.02),
        "hy_filt_w3": nrm(ks[11], (L_, HY_FILT_FF, HY_ORDER * 2 * HY_W), HY_FILT_FF ** -0.5),
        "hy_sin_freq": gain(ks[12], (L_, HY_FILT_FF)),
        "hy_skip_d": nrm(ks[13], (L_, HY_ORDER, HY_W), 0.1),
        "branch_norm": gain(ks[14], (L_, MIX_W)),
        "w_out": nrm(ks[15], (L_, MIX_W, D_MODEL), MIX_W ** -0.5),
        "norm_cross": gain(ks[16], (L_, D_MODEL)),
        "mem_norm": gain(ks[17], (D_MODEL,)),
        "w_cq": nrm(ks[18], (L_, D_MODEL, D_MODEL), D_MODEL ** -0.5),
        "w_ckv": nrm(ks[19], (L_, D_MODEL, 2 * D_MODEL), D_MODEL ** -0.5),
        "w_co": nrm(ks[20], (L_, D_MODEL, D_MODEL), D_MODEL ** -0.5),
        "norm_moe": gain(ks[21], (L_, D_MODEL)),
        "w_router": nrm(ks[22], (L_, D_MODEL, N_EXPERTS), D_MODEL ** -0.5),
        "w_gate": nrm(ks[23], (L_, N_EXPERTS, D_MODEL, EXPERT_FF), D_MODEL ** -0.5),
        "w_up": nrm(ks[24], (L_, N_EXPERTS, D_MODEL, EXPERT_FF), D_MODEL ** -0.5),
        "w_down": nrm(ks[25], (L_, N_EXPERTS, EXPERT_FF, D_MODEL), EXPERT_FF ** -0.5),
        "final_norm": gain(ks[26], (D_MODEL,)),
    }


def reference(x, mem, norm_mix, w_in, na_rpb, hy_conv_w, hy_conv_b, hy_filt_w1, hy_filt_b1,
              hy_filt_w2, hy_filt_b2, hy_filt_w3, hy_sin_freq, hy_skip_d, branch_norm, w_out,
              norm_cross, mem_norm, w_cq, w_ckv, w_co, norm_moe, w_router, w_gate, w_up, w_down,
              final_norm):
    B, L, _ = x.shape
    mem_n = rms_norm(mem, mem_norm)
    for l in range(DEPTH):
        h = rms_norm(x, norm_mix[l])
        proj = h @ w_in[l]
        na_in, hy_in, ret_in = jnp.split(proj, [3 * NA_W, 3 * NA_W + 3 * HY_W], axis=-1)
        na_q, na_k, na_v = (t.reshape(B, L, NA_HEADS, NA_HEAD_DIM) for t in jnp.split(na_in, 3, axis=-1))
        y_na = neighbourhood_attention(na_q, na_k, na_v, na_rpb[l])
        y_hy = hyena_mixer(hy_in, hy_conv_w[l], hy_conv_b[l], hy_filt_w1[l], hy_filt_b1[l],
                           hy_filt_w2[l], hy_filt_b2[l], hy_filt_w3[l], hy_sin_freq[l], hy_skip_d[l])
        y_ret = retention_mixer(ret_in)
        y = group_rms_norm([y_na, y_hy, y_ret], branch_norm[l])
        x = x + y @ w_out[l]
        x = x + cross_attend(rms_norm(x, norm_cross[l]), mem_n, w_cq[l], w_ckv[l], w_co[l])
        x = x + expert_choice_ffn(rms_norm(x, norm_moe[l]), w_router[l], w_gate[l], w_up[l], w_down[l])
    return rms_norm(x, final_norm)
```

```cpp
#include <hip/hip_runtime.h>
#include <cstdio>
#include <cstdint>
#include <cmath>

#define LAS __attribute__((address_space(3)))
typedef unsigned short bf16_t;
typedef short bf16x8 __attribute__((ext_vector_type(8)));
typedef float f32x4 __attribute__((ext_vector_type(4)));
typedef float f32x2 __attribute__((ext_vector_type(2)));
typedef unsigned u32x4 __attribute__((ext_vector_type(4)));
typedef unsigned u32x2 __attribute__((ext_vector_type(2)));

constexpr int NB = 4, SEQ = 2048, DM = 2048, NT = NB * SEQ, DEPTH = 2;
constexpr int NMEM = 256, GW = 64, ROWS = SEQ / GW;
constexpr int NAW = 768, NAH = 12, NADH = 64;
constexpr int HYW = 512, HYFF = 64;
constexpr int RETW = 768, RETH = 6, RETD = 128;
constexpr int PIN = 6912;
constexpr int OFF_NAQ = 0, OFF_NAK = 768, OFF_NAV = 1536, OFF_HY = 2304, OFF_RQ = 3840, OFF_RK = 4608, OFF_RV = 5376, OFF_RG = 6144;
constexpr int XH = 4, XD = 512;
constexpr int NE = 16, FF = 2048, CAP = 256;
constexpr float RMS_EPS = 1e-6f, GN_EPS = 1e-5f;

enum { I_X = 0, I_MEM, I_NORM_MIX, I_W_IN, I_NA_RPB, I_HY_CONV_W, I_HY_CONV_B, I_HY_W1, I_HY_B1, I_HY_W2, I_HY_B2, I_HY_W3, I_HY_FREQ, I_HY_SKIP,
       I_BRANCH_NORM, I_W_OUT, I_NORM_CROSS, I_MEM_NORM, I_W_CQ, I_W_CKV, I_W_CO, I_NORM_MOE, I_W_ROUTER, I_W_GATE, I_W_UP, I_W_DOWN, I_FINAL_NORM, N_IN };

constexpr size_t MiB = (size_t)1 << 20;
constexpr size_t WS_CTL   = 0;
constexpr size_t WS_XRES  = 1 * MiB;
constexpr size_t WS_HN    = WS_XRES + 64 * MiB;
constexpr size_t WS_PROJ  = WS_HN + 32 * MiB;
constexpr size_t WS_YCAT  = WS_PROJ + 108 * MiB;
constexpr size_t WS_YN    = WS_YCAT + 32 * MiB;
constexpr size_t WS_QC    = WS_YN + 32 * MiB;
constexpr size_t WS_KVC   = WS_QC + 32 * MiB;
constexpr size_t WS_OC    = WS_KVC + 16 * MiB;
constexpr size_t WS_MEMN  = WS_OC + 32 * MiB;
constexpr size_t WS_AFF   = WS_MEMN + 4 * MiB;
constexpr size_t WS_IDX   = WS_AFF + 1 * MiB;
constexpr size_t WS_GSEL  = WS_IDX + 1 * MiB;
constexpr size_t WS_INV   = WS_GSEL + 1 * MiB;
constexpr size_t WS_XE    = WS_INV + 1 * MiB;
constexpr size_t WS_ACT   = WS_XE + 64 * MiB;
constexpr size_t WS_YMOE  = WS_ACT + 64 * MiB;
constexpr size_t WS_ROT   = WS_YMOE + 128 * MiB;
constexpr size_t WS_KF    = WS_ROT + 1 * MiB;
constexpr size_t WS_HS    = WS_KF + 32 * MiB;
constexpr size_t WS_WIN   = WS_HS + 48 * MiB;
constexpr size_t WS_WOUT  = WS_WIN + 54 * MiB;
constexpr size_t WS_WCQ   = WS_WOUT + 16 * MiB;
constexpr size_t WS_WCKV  = WS_WCQ + 16 * MiB;
constexpr size_t WS_WCO   = WS_WCKV + 32 * MiB;
constexpr size_t WS_WGU   = WS_WCO + 16 * MiB;
constexpr size_t WS_WDN   = WS_WGU + 512 * MiB;
constexpr size_t WS_END   = WS_WDN + 256 * MiB;

struct P { const float* in[N_IN]; float* out; unsigned char* ws; };

__device__ __forceinline__ float bf2f(unsigned v) { return __uint_as_float(v << 16); }
__device__ __forceinline__ unsigned f2bf(float f) { unsigned u = __float_as_uint(f); u += 0x7fffu + ((u >> 16) & 1u); return u >> 16; }
__device__ __forceinline__ unsigned pk2(float lo, float hi) { return f2bf(lo) | (f2bf(hi) << 16); }
__device__ __forceinline__ unsigned cvt_pk_bf16(float lo, float hi) { unsigned r; asm volatile("v_cvt_pk_bf16_f32 %0, %1, %2" : "=v"(r) : "v"(lo), "v"(hi)); return r; }
__device__ __forceinline__ void unpack8(const u32x4 w, float (&f)[8]) {
    f[0] = bf2f(w.x & 0xffffu); f[1] = bf2f(w.x >> 16); f[2] = bf2f(w.y & 0xffffu); f[3] = bf2f(w.y >> 16);
    f[4] = bf2f(w.z & 0xffffu); f[5] = bf2f(w.z >> 16); f[6] = bf2f(w.w & 0xffffu); f[7] = bf2f(w.w >> 16);
}
__device__ __forceinline__ float wave_sum(float v) {
#pragma unroll
    for (int o = 1; o < 64; o <<= 1) v += __shfl_xor(v, o);
    return v;
}
#define LDS_WAIT() asm volatile("s_waitcnt lgkmcnt(0)" ::: "memory")
namespace pg8 {
constexpr int BM = 256, BK = 64, HALF = 128, HTB = HALF * BK * 2  , STAGE_BYTES = 8 * HTB, NXCD = 8, WGM = 8;

__host__ __device__ __forceinline__ int lds_byte(int r, int c) { const int st = (r >> 4) * 2 + (c >> 5), rr = r & 15, cc = c & 31, ob = rr * 64 + cc * 2; return st * 1024 + (ob ^ (((ob >> 9) & 1) << 5)); }
__host__ __device__ __forceinline__ void stage_rc(int b, int& R, int& C) { const int st = b / 1024, sb = b % 1024, swz = sb ^ (((sb >> 9) & 1) << 5); R = (st >> 1) * 16 + swz / 64; C = (st & 1) * 32 + (swz % 64) / 2; }
__host__ __device__ __forceinline__ int perm32(int rho) { const int n = rho >> 4, i = rho & 15; return 8 * (i >> 2) + 4 * n + (i & 3); }

struct Unit { int pm, pn; };
struct Gemm { const bf16_t* A; const bf16_t* Bt; int K; };

struct StaticOrder {
    int nM, nN, nwg, G, c;
    __device__ void init(int M, int N, int G_, int c_) { nM = M / BM; nN = N / BM; nwg = nM * nN; G = G_; c = c_; }
    __device__ bool next(int i, Unit& u) const {
        const long L = (long)i * G + c; if (L >= nwg) return false;
        int wgid = (int)L; { const int q = nwg / NXCD, r = nwg % NXCD, xcd = wgid % NXCD, off = wgid / NXCD; wgid = (xcd < r ? xcd * (q + 1) : r * (q + 1) + (xcd - r) * q) + off; }
        const int nig = WGM * nN, gid = wgid / nig, fm = gid * WGM, gsz = (nM - fm) < WGM ? (nM - fm) : WGM;
        u.pm = fm + ((wgid % nig) % gsz); u.pn = (wgid % nig) / gsz; return true;
    }
};
struct MoeOrder {
    int npn, G, c;
    __device__ void init(int npn_, int G_, int c_) { npn = npn_; G = G_; c = c_; }
    __device__ bool next(int i, Unit& u) const {
        const int L = i * G + c; const int per_e = 4 * npn; if (L >= 16 * per_e) return false;
        const int e = L / per_e, r = L % per_e; u.pm = e * 4 + (r & 3); u.pn = e * npn + (r >> 2); return true;
    }
};

template <class Epi, class Sched>
__device__ __forceinline__ void gemm_phase(LAS unsigned char* lds, const Gemm g, const Sched& S, const Epi& E) {
    const int tid = threadIdx.x, wid = __builtin_amdgcn_readfirstlane(tid >> 6), lane = tid & 63, wr = wid >> 2, wc = wid & 3, fr = lane & 15, fq = lane >> 4;
    const int K = g.K, nt = K / BK;
    unsigned voffA[2], voffB[2];
#pragma unroll
    for (int i = 0; i < 2; ++i) { int R, C; stage_rc(tid * 16 + i * 8192, R, C); const int Rb = Epi::PERM ? ((R & ~31) + perm32(R & 31)) : R;
        voffA[i] = (unsigned)(R * K + C) * 2u; voffB[i] = (unsigned)(Rb * K + C) * 2u; }
    const size_t kstep = (size_t)(BK * 2);
    const size_t hstep = (size_t)HALF * K * 2;
    const size_t tstep = 2 * hstep;
    const unsigned ldsw = (unsigned)wid * 1024u;
    const int aoff = lds_byte(wr * 64 + fr, fq * 8), boff = lds_byte(wc * 32 + fr, fq * 8);
#define PG8_SA(b, h) (((b) * 2 + (h)) * HTB)
#define PG8_SB(b, h) ((4 + (b) * 2 + (h)) * HTB)
#define PG8_STAGE(bufoff, gbase, voff) do { _Pragma("unroll") for (int _i = 0; _i < 2; ++_i) \
        __builtin_amdgcn_global_load_lds((const unsigned*)((const char*)(gbase) + (voff)[_i]), (LAS unsigned*)(lds + (bufoff) + ldsw + _i * 8192), 16, 0, 0); } while (0)
#define PG8_LDA(dst, b, h) do { _Pragma("unroll") for (int m = 0; m < 4; ++m) _Pragma("unroll") for (int k = 0; k < 2; ++k) dst[m][k] = *(const LAS bf16x8*)(lds + PG8_SA(b, h) + aoff + m * 2048 + k * 1024); } while (0)
#define PG8_LDB(dst, b, h) do { _Pragma("unroll") for (int n = 0; n < 2; ++n) _Pragma("unroll") for (int k = 0; k < 2; ++k) dst[n][k] = *(const LAS bf16x8*)(lds + PG8_SB(b, h) + boff + n * 2048 + k * 1024); } while (0)
#define PG8_MMA(ai, bj, At, Bt) do { __builtin_amdgcn_s_setprio(1); _Pragma("unroll") for (int m = 0; m < 4; ++m) _Pragma("unroll") for (int n = 0; n < 2; ++n) _Pragma("unroll") for (int k = 0; k < 2; ++k) \
        acc[ai][bj][m][n] = __builtin_amdgcn_mfma_f32_16x16x32_bf16(Bt[n][k], At[m][k], acc[ai][bj][m][n], 0, 0, 0); __builtin_amdgcn_s_setprio(0); } while (0)
#define PG8_WAIT_V(n) asm volatile("s_waitcnt vmcnt(" #n ")" ::: "memory")
#define PG8_WAIT_L(n) asm volatile("s_waitcnt lgkmcnt(" #n ")" ::: "memory")
#define PG8_BAR __builtin_amdgcn_s_barrier()
#define PG8_SCHED __builtin_amdgcn_sched_barrier(0)
    Unit cur, nxt; int ui = 0;
    if (!S.next(0, cur)) return;
    f32x4 acc[2][2][4][2];
#pragma unroll
    for (int a = 0; a < 2; ++a)
#pragma unroll
        for (int b = 0; b < 2; ++b)
#pragma unroll
            for (int m = 0; m < 4; ++m)
#pragma unroll
                for (int n = 0; n < 2; ++n) acc[a][b][m][n] = (f32x4){0.f, 0.f, 0.f, 0.f};
    bf16x8 At[4][2], B0[2][2], B1[2][2];
    const char* cA = (const char*)g.A + (size_t)cur.pm * tstep; const char* cB = (const char*)g.Bt + (size_t)cur.pn * tstep;
    PG8_STAGE(PG8_SB(0, 0), cB, voffB); PG8_STAGE(PG8_SA(0, 0), cA, voffA); PG8_STAGE(PG8_SB(0, 1), cB + hstep, voffB); PG8_STAGE(PG8_SA(0, 1), cA + hstep, voffA);
    if (wr == 1) PG8_BAR;
    PG8_WAIT_V(4); PG8_BAR;
    PG8_STAGE(PG8_SB(1, 0), cB + kstep, voffB); PG8_STAGE(PG8_SA(1, 0), cA + kstep, voffA); PG8_STAGE(PG8_SB(1, 1), cB + hstep + kstep, voffB);
    PG8_WAIT_V(6); PG8_BAR;
    for (;;) {
        const bool has_next = S.next(ui + 1, nxt);
        const char* nA = has_next ? (const char*)g.A + (size_t)nxt.pm * tstep : cA; const char* nB = has_next ? (const char*)g.Bt + (size_t)nxt.pn * tstep : cB;
        for (int t = 0; t < nt; t += 2) {
            const bool last = (t == nt - 2);
            const char* a1 = cA + (size_t)(t + 1) * kstep;
            const char* a2 = last ? nA : cA + (size_t)(t + 2) * kstep; const char* b2 = last ? nB : cB + (size_t)(t + 2) * kstep;
            const char* a3 = a2 + kstep; const char* b3 = b2 + kstep;
            PG8_LDB(B0, 0, 0); PG8_SCHED; PG8_LDA(At, 0, 0); PG8_STAGE(PG8_SA(1, 1), a1 + hstep, voffA);
            PG8_WAIT_L(8); PG8_BAR; PG8_WAIT_L(0); PG8_MMA(0, 0, At, B0); PG8_BAR; PG8_SCHED;
            PG8_LDB(B1, 0, 1); PG8_STAGE(PG8_SB(0, 0), b2, voffB);
            PG8_BAR; PG8_WAIT_L(0); PG8_MMA(0, 1, At, B1); PG8_BAR;
            PG8_LDA(At, 0, 1); PG8_STAGE(PG8_SA(0, 0), a2, voffA);
            PG8_BAR; PG8_WAIT_L(0); PG8_MMA(1, 0, At, B0); PG8_BAR; PG8_SCHED;
            PG8_STAGE(PG8_SB(0, 1), b2 + hstep, voffB);
            PG8_WAIT_V(6); PG8_BAR; PG8_MMA(1, 1, At, B1); PG8_BAR;
            PG8_LDB(B0, 1, 0); PG8_SCHED; PG8_LDA(At, 1, 0); PG8_STAGE(PG8_SA(0, 1), a2 + hstep, voffA);
            PG8_WAIT_L(8); PG8_BAR; PG8_WAIT_L(0); PG8_MMA(0, 0, At, B0); PG8_BAR; PG8_SCHED;
            PG8_LDB(B1, 1, 1); PG8_STAGE(PG8_SB(1, 0), b3, voffB);
            PG8_BAR; PG8_WAIT_L(0); PG8_MMA(0, 1, At, B1); PG8_BAR;
            PG8_LDA(At, 1, 1); PG8_STAGE(PG8_SA(1, 0), a3, voffA);
            PG8_BAR; PG8_WAIT_L(0); PG8_MMA(1, 0, At, B0); PG8_BAR; PG8_SCHED;
            PG8_STAGE(PG8_SB(1, 1), b3 + hstep, voffB);
            PG8_WAIT_V(6); PG8_BAR; PG8_MMA(1, 1, At, B1); PG8_BAR;
        }
        E(acc, cur, wr, wc, fr, fq);
        if (!has_next) break;
#pragma unroll
        for (int a = 0; a < 2; ++a)
#pragma unroll
            for (int b = 0; b < 2; ++b)
#pragma unroll
                for (int m = 0; m < 4; ++m)
#pragma unroll
                    for (int n = 0; n < 2; ++n) acc[a][b][m][n] = (f32x4){0.f, 0.f, 0.f, 0.f};
        cur = nxt; cA = nA; cB = nB; ++ui;
    }
    PG8_WAIT_V(0);
    if (wr == 0) PG8_BAR;
    PG8_BAR;
#undef PG8_SA
#undef PG8_SB
#undef PG8_STAGE
#undef PG8_LDA
#undef PG8_LDB
#undef PG8_MMA
#undef PG8_WAIT_V
#undef PG8_WAIT_L
#undef PG8_BAR
#undef PG8_SCHED
}
}
enum { PH_CVT = 0, PH_PRE, PH_NORM1, PH_INPROJ, PH_NA, PH_HYPRE, PH_HYCONV, PH_RET, PH_GNORM, PH_OUT, PH_NORM2, PH_CQ, PH_CKV, PH_XATT, PH_CO, PH_ROUTER, PH_TOPK, PH_GATHER,
       PH_GU, PH_DOWN, PH_COMBINE, N_PHASES };
constexpr int NTHR = 512, NWAVES = 8;
constexpr int LDS_BYTES = 150 * 1024;

struct Ctx { int tid, lane, wave, G, bid; LAS unsigned char* lds; };

__device__ __forceinline__ void cvt_item(const float* colp, size_t stride, int K, bf16_t* WT, LAS float* scr, int k0, int n0, int lane) {
#pragma unroll 8
    for (int i = 0; i < 32; ++i) { const int kk = 2 * i + (lane >> 5); scr[kk * 33 + (lane & 31)] = colp[(size_t)(k0 + kk) * stride]; }
    LDS_WAIT();
    const int c = lane & 7;
#pragma unroll
    for (int j = 0; j < 4; ++j) { const int n = (lane >> 3) + 8 * j; const LAS float* s = scr + (8 * c) * 33 + n;
        u32x4 o; o.x = pk2(s[0 * 33], s[1 * 33]); o.y = pk2(s[2 * 33], s[3 * 33]); o.z = pk2(s[4 * 33], s[5 * 33]); o.w = pk2(s[6 * 33], s[7 * 33]);
        *(u32x4*)(WT + (size_t)(n0 + n) * K + k0 + 8 * c) = o; }
    LDS_WAIT();
}
__device__ __forceinline__ int win_src_col(int n) {
    if (n >= OFF_RQ && n < OFF_RV) { const int base = n & ~127, p = n & 127; return base + (p >> 1) + 64 * (p & 1); }
    return n;
}
__device__ void ph_cvt(const P& p, const Ctx& c) {
    LAS float* scr = (LAS float*)(c.lds) + c.wave * (64 * 33);
    const int gw = c.bid * NWAVES + c.wave, NGW = c.G * NWAVES;
    constexpr int I_IN = 32 * (PIN / 32), I_SQ = 32 * (DM / 32), I_KV = 32 * (4096 / 32), I_GU = NE * 32 * (4096 / 32), I_DN = NE * 32 * (DM / 32);
    constexpr int PER_LAYER = I_IN + 3 * I_SQ + I_KV + I_GU + I_DN;
    for (int it = gw; it < DEPTH * PER_LAYER; it += NGW) {
        const int l = it / PER_LAYER; int r = it % PER_LAYER;
        const int ln = c.lane & 31;
        if (r < I_IN) { const int kb = r / (PIN / 32), nb = r % (PIN / 32);
            const float* W = p.in[I_W_IN] + (size_t)l * DM * PIN; bf16_t* WT = (bf16_t*)(p.ws + WS_WIN) + (size_t)l * PIN * DM;
            cvt_item(W + win_src_col(nb * 32 + ln), PIN, DM, WT, scr, kb * 64, nb * 32, c.lane); continue; }
        r -= I_IN;
        if (r < 3 * I_SQ) { const int which = r / I_SQ; r %= I_SQ; const int kb = r / (DM / 32), nb = r % (DM / 32);
            const int ii = which == 0 ? I_W_OUT : (which == 1 ? I_W_CQ : I_W_CO); const size_t wo = which == 0 ? WS_WOUT : (which == 1 ? WS_WCQ : WS_WCO);
            const float* W = p.in[ii] + (size_t)l * DM * DM; bf16_t* WT = (bf16_t*)(p.ws + wo) + (size_t)l * DM * DM;
            cvt_item(W + nb * 32 + ln, DM, DM, WT, scr, kb * 64, nb * 32, c.lane); continue; }
        r -= 3 * I_SQ;
        if (r < I_KV) { const int kb = r / 128, nb = r % 128;
            const float* W = p.in[I_W_CKV] + (size_t)l * DM * 4096; bf16_t* WT = (bf16_t*)(p.ws + WS_WCKV) + (size_t)l * 4096 * DM;
            cvt_item(W + nb * 32 + ln, 4096, DM, WT, scr, kb * 64, nb * 32, c.lane); continue; }
        r -= I_KV;
        if (r < I_GU) { const int e = r / (32 * 128); r %= (32 * 128); const int kb = r / 128, nb = r % 128;
            const int n0 = nb * 32, j = n0 >> 8, half = (n0 >> 7) & 1, f = 128 * j + (n0 & 127) + ln;
            const float* W = p.in[half ? I_W_UP : I_W_GATE] + ((size_t)l * NE + e) * DM * FF;
            bf16_t* WT = (bf16_t*)(p.ws + WS_WGU) + ((size_t)l * NE + e) * 4096 * DM;
            cvt_item(W + f, FF, DM, WT, scr, kb * 64, n0, c.lane); continue; }
        r -= I_GU;
        { const int e = r / (32 * 64); r %= (32 * 64); const int kb = r / 64, nb = r % 64;
            const float* W = p.in[I_W_DOWN] + ((size_t)l * NE + e) * FF * DM; bf16_t* WT = (bf16_t*)(p.ws + WS_WDN) + ((size_t)l * NE + e) * DM * FF;
            cvt_item(W + nb * 32 + ln, DM, FF, WT, scr, kb * 64, nb * 32, c.lane); }
    }
}

__device__ __forceinline__ void row_load_f32(const float* row, int lane, f32x4 (&v)[8]) {
#pragma unroll
    for (int j = 0; j < 8; ++j) v[j] = *(const f32x4*)(row + 256 * j + 4 * lane);
}
__device__ __forceinline__ float row_ssq(const f32x4 (&v)[8]) {
    float s = 0.f;
#pragma unroll
    for (int j = 0; j < 8; ++j) s += (v[j].x * v[j].x + v[j].y * v[j].y) + (v[j].z * v[j].z + v[j].w * v[j].w);
    return wave_sum(s);
}
__device__ __forceinline__ void row_store_bf16(bf16_t* row, int lane, const f32x4 (&v)[8]) {
#pragma unroll
    for (int j = 0; j < 8; ++j) { u32x2 o; o.x = pk2(v[j].x, v[j].y); o.y = pk2(v[j].z, v[j].w); *(u32x2*)(row + 256 * j + 4 * lane) = o; }
}
__device__ __forceinline__ void rmsnorm_row_to_bf16(const float* xrow, const float* gain, bf16_t* orow, int lane) {
    f32x4 v[8]; row_load_f32(xrow, lane, v);
    const float rstd = rsqrtf(row_ssq(v) * (1.f / DM) + RMS_EPS);
#pragma unroll
    for (int j = 0; j < 8; ++j) { const f32x4 g = *(const f32x4*)(gain + 256 * j + 4 * lane); v[j] = v[j] * rstd * g; }
    row_store_bf16(orow, lane, v);
}

__device__ void ph_pre(const P& p, const Ctx& c) {
    const int gw = c.bid * NWAVES + c.wave, NGW = c.G * NWAVES;
    for (int m = gw; m < NB * NMEM; m += NGW) rmsnorm_row_to_bf16(p.in[I_MEM] + (size_t)m * DM, p.in[I_MEM_NORM], (bf16_t*)(p.ws + WS_MEMN) + (size_t)m * DM, c.lane);
    { const f32x4* s = (const f32x4*)p.in[I_X]; f32x4* d = (f32x4*)(p.ws + WS_XRES);
      for (size_t i = (size_t)c.bid * NTHR + c.tid; i < (size_t)NT * DM / 4; i += (size_t)c.G * NTHR) d[i] = s[i]; }
    { float* ct = (float*)(p.ws + WS_ROT); float* st = ct + SEQ * 64;
      for (int i = c.bid * NTHR + c.tid; i < SEQ * 64; i += c.G * NTHR) { const int pos = i >> 6, k = i & 63;
          const float lin = (float)k / 63.0f; const float inv = 1.0f / powf(10000.0f, lin); const float ang = (float)pos * inv;
          ct[i] = (float)cos((double)ang); st[i] = (float)sin((double)ang); } }
    LAS float* sm = (LAS float*)c.lds;
    for (int u = c.bid; u < DEPTH * SEQ; u += c.G) {
        const int l = u / SEQ, t = u % SEQ;
        const float t01 = (float)t / (float)(SEQ - 1);
        __syncthreads();
        if (c.tid < 17) { float f;
            if (c.tid == 0) f = t01;
            else { const int i = (c.tid - 1) & 7; const float band = 1e-4f + (float)i * ((7.0f - 1e-4f) / 7.0f);
                   const float ang = (2.0f * 3.14159265358979323846f) * ((float)t / (float)SEQ) * band;
                   f = (c.tid <= 8) ? cosf(ang) : -sinf(ang); }
            sm[c.tid] = f; }
        __syncthreads();
        if (c.tid < 64) { const float* w1 = p.in[I_HY_W1] + (size_t)l * 17 * 64; float a = p.in[I_HY_B1][l * 64 + c.tid];
            for (int i = 0; i < 17; ++i) a += sm[i] * w1[i * 64 + c.tid];
            sm[32 + c.tid] = sinf(p.in[I_HY_FREQ][l * 64 + c.tid] * a); }
        __syncthreads();
        if (c.tid < 64) { const float* w2 = p.in[I_HY_W2] + (size_t)l * 64 * 64; float a = p.in[I_HY_B2][l * 64 + c.tid];
            for (int i = 0; i < 64; ++i) a += sm[32 + i] * w2[i * 64 + c.tid];
            sm[96 + c.tid] = sinf(p.in[I_HY_FREQ][l * 64 + c.tid] * a); }
        __syncthreads();
        const float* w3 = p.in[I_HY_W3] + (size_t)l * 64 * 2048;
        float* kf = (float*)(p.ws + WS_KF) + (size_t)l * 2 * 512 * 4096;
        const float min_decay = logf(1e-2f) / 1.5f, max_decay = logf(1e-2f) / 0.3f;
        for (int n = c.tid; n < 2048; n += NTHR) {
            float a = 0.f;
            for (int i = 0; i < 64; ++i) a += sm[96 + i] * w3[i * 2048 + n];
            const int o = n >> 10, dir = (n >> 9) & 1, ch = n & 511;
            const float delta = fabsf(min_decay + (max_decay - min_decay) * ((float)ch / 511.0f));
            a *= expf(-t01 * delta);
            float* kc = kf + ((size_t)o * 512 + ch) * 4096;
            if (dir == 0) kc[2048 + t] = a; else { if (t >= 1) kc[2048 - t] = a; else kc[0] = 0.f; }
        }
    }
}

__device__ void ph_norm(const P& p, const Ctx& c, const float* gain) {
    const int gw = c.bid * NWAVES + c.wave, NGW = c.G * NWAVES;
    for (int m = gw; m < NT; m += NGW) rmsnorm_row_to_bf16((const float*)(p.ws + WS_XRES) + (size_t)m * DM, gain, (bf16_t*)(p.ws + WS_HN) + (size_t)m * DM, c.lane);
}

struct EpiInProj {
    static constexpr bool PERM = true;
    bf16_t* O; const float* rc; const float* rs;
    __device__ __forceinline__ void operator()(const f32x4 (&acc)[2][2][4][2], const pg8::Unit& u, int wr, int wc, int fr, int fq) const {
        const int row0 = u.pm * 256 + wr * 64 + fr, col0 = u.pn * 256 + wc * 32 + 8 * fq;
        const bool rot = (u.pn >= OFF_RQ / 256) && (u.pn < OFF_RV / 256);
        const float qs = (u.pn < OFF_RK / 256) ? 0.08838834764831845f : 1.0f;
#pragma unroll
        for (int ai = 0; ai < 2; ++ai)
#pragma unroll
            for (int m = 0; m < 4; ++m) { const int row = row0 + ai * 128 + m * 16; bf16_t* rowp = O + (size_t)row * PIN + col0;
#pragma unroll
                for (int bj = 0; bj < 2; ++bj) { f32x4 v0 = acc[ai][bj][m][0], v1 = acc[ai][bj][m][1];
                    if (rot) { const int pos = row & (SEQ - 1); const int i0 = ((col0 + bj * 128) & 127) >> 1;
                        const f32x4 cs = *(const f32x4*)(rc + pos * 64 + i0), sn = *(const f32x4*)(rs + pos * 64 + i0);
                        f32x4 r0, r1;
                        r0.x = (v0.x * cs.x - v0.y * sn.x) * qs; r0.y = (v0.x * sn.x + v0.y * cs.x) * qs;
                        r0.z = (v0.z * cs.y - v0.w * sn.y) * qs; r0.w = (v0.z * sn.y + v0.w * cs.y) * qs;
                        r1.x = (v1.x * cs.z - v1.y * sn.z) * qs; r1.y = (v1.x * sn.z + v1.y * cs.z) * qs;
                        r1.z = (v1.z * cs.w - v1.w * sn.w) * qs; r1.w = (v1.z * sn.w + v1.w * cs.w) * qs;
                        v0 = r0; v1 = r1; }
                    u32x4 w; w.x = cvt_pk_bf16(v0.x, v0.y); w.y = cvt_pk_bf16(v0.z, v0.w); w.z = cvt_pk_bf16(v1.x, v1.y); w.w = cvt_pk_bf16(v1.z, v1.w);
                    *(u32x4*)(rowp + bj * 128) = w; } }
    }
};
struct EpiBf16 {
    static constexpr bool PERM = true;
    bf16_t* O; int ldc;
    __device__ __forceinline__ void operator()(const f32x4 (&acc)[2][2][4][2], const pg8::Unit& u, int wr, int wc, int fr, int fq) const {
        const int row0 = u.pm * 256 + wr * 64 + fr, col0 = u.pn * 256 + wc * 32 + 8 * fq;
#pragma unroll
        for (int ai = 0; ai < 2; ++ai)
#pragma unroll
            for (int m = 0; m < 4; ++m) { bf16_t* rowp = O + (size_t)(row0 + ai * 128 + m * 16) * ldc + col0;
#pragma unroll
                for (int bj = 0; bj < 2; ++bj) { const f32x4 v0 = acc[ai][bj][m][0], v1 = acc[ai][bj][m][1];
                    u32x4 w; w.x = cvt_pk_bf16(v0.x, v0.y); w.y = cvt_pk_bf16(v0.z, v0.w); w.z = cvt_pk_bf16(v1.x, v1.y); w.w = cvt_pk_bf16(v1.z, v1.w);
                    *(u32x4*)(rowp + bj * 128) = w; } }
    }
};
struct EpiResid {
    static constexpr bool PERM = false;
    float* X;
    __device__ __forceinline__ void operator()(const f32x4 (&acc)[2][2][4][2], const pg8::Unit& u, int wr, int wc, int fr, int fq) const {
        const int row0 = u.pm * 256 + wr * 64 + fr, col0 = u.pn * 256 + wc * 32 + 4 * fq;
#pragma unroll
        for (int ai = 0; ai < 2; ++ai)
#pragma unroll
            for (int m = 0; m < 4; ++m) { float* rowp = X + (size_t)(row0 + ai * 128 + m * 16) * DM + col0;
#pragma unroll
                for (int bj = 0; bj < 2; ++bj)
#pragma unroll
                    for (int n = 0; n < 2; ++n) { f32x4* q = (f32x4*)(rowp + bj * 128 + n * 16); *q = *q + acc[ai][bj][m][n]; } }
    }
};
struct EpiGU {
    static constexpr bool PERM = true;
    bf16_t* O; int npn;
    __device__ __forceinline__ void operator()(const f32x4 (&acc)[2][2][4][2], const pg8::Unit& u, int wr, int wc, int fr, int fq) const {
        const int row0 = u.pm * 256 + wr * 64 + fr, col0 = (u.pn % npn) * 128 + wc * 32 + 8 * fq;
#pragma unroll
        for (int ai = 0; ai < 2; ++ai)
#pragma unroll
            for (int m = 0; m < 4; ++m) { bf16_t* rowp = O + (size_t)(row0 + ai * 128 + m * 16) * FF + col0;
                float h[8];
#pragma unroll
                for (int n = 0; n < 2; ++n)
#pragma unroll
                    for (int j = 0; j < 4; ++j) { const float a = acc[ai][0][m][n][j], b = acc[ai][1][m][n][j]; h[n * 4 + j] = a / (1.0f + __expf(-a)) * b; }
                u32x4 w; w.x = cvt_pk_bf16(h[0], h[1]); w.y = cvt_pk_bf16(h[2], h[3]); w.z = cvt_pk_bf16(h[4], h[5]); w.w = cvt_pk_bf16(h[6], h[7]);
                *(u32x4*)rowp = w; }
    }
};
struct EpiDown {
    static constexpr bool PERM = false;
    float* Y; int npn;
    __device__ __forceinline__ void operator()(const f32x4 (&acc)[2][2][4][2], const pg8::Unit& u, int wr, int wc, int fr, int fq) const {
        const int row0 = u.pm * 256 + wr * 64 + fr, col0 = (u.pn % npn) * 256 + wc * 32 + 4 * fq;
#pragma unroll
        for (int ai = 0; ai < 2; ++ai)
#pragma unroll
            for (int m = 0; m < 4; ++m) { float* rowp = Y + (size_t)(row0 + ai * 128 + m * 16) * DM + col0;
#pragma unroll
                for (int bj = 0; bj < 2; ++bj)
#pragma unroll
                    for (int n = 0; n < 2; ++n) *(f32x4*)(rowp + bj * 128 + n * 16) = acc[ai][bj][m][n]; }
    }
};

__device__ void ph_na(const P& p, const Ctx& c, int l) {
    const bf16_t* proj = (const bf16_t*)(p.ws + WS_PROJ); bf16_t* ycat = (bf16_t*)(p.ws + WS_YCAT);
    LAS float* Pm = (LAS float*)c.lds;
    const float* rpb = p.in[I_NA_RPB] + (size_t)l * NAH * 15 * 31;
    for (int u = c.bid; u < NB * ROWS * NAH; u += c.G) {
        const int h = u % NAH, r = (u / NAH) % ROWS, b = u / (NAH * ROWS);
        const int qc = c.tid >> 3, sub = c.tid & 7;
        const int rs = min(max(r - 4, 0), ROWS - 8), cs = min(max(qc - 8, 0), GW - 16);
        const int tok = b * SEQ + r * GW + qc;
        float q[64];
        { const u32x4* qp = (const u32x4*)(proj + (size_t)tok * PIN + OFF_NAQ + h * 64);
#pragma unroll
          for (int i = 0; i < 8; ++i) { float f[8]; unpack8(qp[i], f);
#pragma unroll
              for (int j = 0; j < 8; ++j) q[i * 8 + j] = f[j] * 0.125f; } }
        const int krow = rs + sub;
        float s[16]; float mx = -INFINITY;
#pragma unroll
        for (int j = 0; j < 16; ++j) { const int kc = cs + j; const u32x4* kp = (const u32x4*)(proj + (size_t)(b * SEQ + krow * GW + kc) * PIN + OFF_NAK + h * 64);
            float d = 0.f;
#pragma unroll
            for (int i = 0; i < 8; ++i) { float f[8]; unpack8(kp[i], f);
#pragma unroll
                for (int jj = 0; jj < 8; ++jj) d += q[i * 8 + jj] * f[jj]; }
            s[j] = d + rpb[(h * 15 + (krow - r + 7)) * 31 + (kc - qc + 15)]; mx = fmaxf(mx, s[j]); }
        mx = fmaxf(mx, __shfl_xor(mx, 1)); mx = fmaxf(mx, __shfl_xor(mx, 2)); mx = fmaxf(mx, __shfl_xor(mx, 4));
        float sum = 0.f;
#pragma unroll
        for (int j = 0; j < 16; ++j) { s[j] = __expf(s[j] - mx); sum += s[j]; }
        sum += __shfl_xor(sum, 1); sum += __shfl_xor(sum, 2); sum += __shfl_xor(sum, 4);
        const float inv = 1.0f / sum;
        __syncthreads();
#pragma unroll
        for (int j = 0; j < 16; ++j) Pm[qc * 129 + sub * 16 + j] = s[j] * inv;
        __syncthreads();
        float o[8];
#pragma unroll
        for (int i = 0; i < 8; ++i) o[i] = 0.f;
        for (int key = 0; key < 128; ++key) { const int kr = rs + (key >> 4), kc = cs + (key & 15);
            const u32x4 vv = *(const u32x4*)(proj + (size_t)(b * SEQ + kr * GW + kc) * PIN + OFF_NAV + h * 64 + sub * 8);
            float f[8]; unpack8(vv, f); const float pr = Pm[qc * 129 + key];
#pragma unroll
            for (int i = 0; i < 8; ++i) o[i] += pr * f[i]; }
        u32x4 w; w.x = pk2(o[0], o[1]); w.y = pk2(o[2], o[3]); w.z = pk2(o[4], o[5]); w.w = pk2(o[6], o[7]);
        *(u32x4*)(ycat + (size_t)tok * DM + h * 64 + sub * 8) = w;
    }
}

__device__ void ph_hypre(const P& p, const Ctx& c, int l) {
    const bf16_t* proj = (const bf16_t*)(p.ws + WS_PROJ); float* hs = (float*)(p.ws + WS_HS);
    LAS float* U = (LAS float*)c.lds;
    const float* cw = p.in[I_HY_CONV_W] + (size_t)l * 3 * 1536; const float* cb = p.in[I_HY_CONV_B] + (size_t)l * 1536;
    for (int u = c.bid; u < NB * 32 * 24; u += c.G) {
        const int cg = u % 24, tt = (u / 24) % 32, b = u / (24 * 32); const int t0 = tt * 64;
        __syncthreads();
        for (int idx = c.tid; idx < 66 * 64; idx += NTHR) { const int rr = idx >> 6, cc = idx & 63; const int t = t0 - 1 + rr;
            U[rr * 65 + cc] = (t >= 0 && t < SEQ) ? bf2f(proj[(size_t)(b * SEQ + t) * PIN + OFF_HY + cg * 64 + cc]) : 0.f; }
        __syncthreads();
        for (int idx = c.tid; idx < 64 * 64; idx += NTHR) { const int tl = idx & 63, cc = idx >> 6; const int ch = cg * 64 + cc;
            const float s = U[tl * 65 + cc] * cw[ch] + U[(tl + 1) * 65 + cc] * cw[1536 + ch] + U[(tl + 2) * 65 + cc] * cw[3072 + ch] + cb[ch];
            hs[((size_t)b * 1536 + ch) * SEQ + t0 + tl] = s; }
    }
}

__device__ void ph_hyconv(const P& p, const Ctx& c, int l) {
    const float* hs = (const float*)(p.ws + WS_HS); bf16_t* ycat = (bf16_t*)(p.ws + WS_YCAT);
    LAS float* kf = (LAS float*)c.lds;
    LAS float* z = kf + 4096;
    for (int u = c.bid; u < NB * HYW; u += c.G) {
        const int ch = u % HYW, b = u / HYW;
        __syncthreads();
        for (int t = c.tid; t < SEQ; t += NTHR) z[t] = hs[((size_t)b * 1536 + 1024 + ch) * SEQ + t];
        for (int o = 0; o < 2; ++o) {
            const float* kg = (const float*)(p.ws + WS_KF) + (((size_t)l * 2 + o) * 512 + ch) * 4096;
            for (int i = c.tid; i < 4096; i += NTHR) kf[i] = kg[i];
            __syncthreads();
            float acc[4] = {0.f, 0.f, 0.f, 0.f};
            for (int s = 0; s < SEQ; ++s) { const float zs = z[s];
#pragma unroll
                for (int q = 0; q < 4; ++q) acc[q] += kf[2048 + c.tid + 512 * q - s] * zs; }
            const float sd = p.in[I_HY_SKIP][((size_t)l * 2 + o) * HYW + ch];
            float zn[4];
#pragma unroll
            for (int q = 0; q < 4; ++q) { const int t = c.tid + 512 * q; const float gate = hs[((size_t)b * 1536 + o * 512 + ch) * SEQ + t]; zn[q] = gate * (acc[q] + sd * z[t]); }
            __syncthreads();
#pragma unroll
            for (int q = 0; q < 4; ++q) z[c.tid + 512 * q] = zn[q];
            __syncthreads();
        }
        for (int t = c.tid; t < SEQ; t += NTHR) ycat[(size_t)(b * SEQ + t) * DM + NAW + ch] = (bf16_t)f2bf(z[t]);
    }
}

__device__ void ph_ret(const P& p, const Ctx& c, int l) {
    const bf16_t* proj = (const bf16_t*)(p.ws + WS_PROJ); bf16_t* ycat = (bf16_t*)(p.ws + WS_YCAT);
    LAS float* Q = (LAS float*)c.lds;
    LAS float* Kc = Q + 64 * 129;
    LAS float* Vc = Kc + 64 * 129;
    LAS float* W = Vc + 64 * 128;
    for (int u = c.bid; u < NB * RETH * 32; u += c.G) {
        const int qt = u % 32, h = (u / 32) % RETH, b = u / (32 * RETH); const int t0 = qt * 64;
        const float lgf = log1pf(-exp2f(-5.0f - (float)h)), lgb = log1pf(-exp2f(-5.5f - (float)h));
        __syncthreads();
        for (int idx = c.tid; idx < 64 * 128; idx += NTHR) { const int i = idx >> 7, d = idx & 127; Q[i * 129 + d] = bf2f(proj[(size_t)(b * SEQ + t0 + i) * PIN + OFF_RQ + h * 128 + d]); }
        const int i = c.tid >> 3, g = c.tid & 7;
        float y[16];
#pragma unroll
        for (int e = 0; e < 16; ++e) y[e] = 0.f;
        for (int kc = 0; kc < 32; ++kc) { const int s0 = kc * 64;
            __syncthreads();
            for (int idx = c.tid; idx < 64 * 128; idx += NTHR) { const int j = idx >> 7, d = idx & 127; const size_t rb = (size_t)(b * SEQ + s0 + j) * PIN + h * 128 + d;
                Kc[j * 129 + d] = bf2f(proj[rb + OFF_RK]); Vc[j * 128 + d] = bf2f(proj[rb + OFF_RV]); }
            __syncthreads();
#pragma unroll 2
            for (int jj = 0; jj < 8; ++jj) { const int j = g + 8 * jj; float d = 0.f;
                for (int k = 0; k < 128; ++k) d += Q[i * 129 + k] * Kc[j * 129 + k];
                const int diff = (t0 + i) - (s0 + j);
                const float dec = diff >= 0 ? __expf(lgf * (float)diff) : __expf(lgb * (float)(-diff));
                W[i * 65 + j] = d * dec; }
            __syncthreads();
            for (int j = 0; j < 64; ++j) { const float w = W[i * 65 + j];
#pragma unroll
                for (int e = 0; e < 16; ++e) y[e] += w * Vc[j * 128 + g * 16 + e]; }
        }
        float s = 0.f;
#pragma unroll
        for (int e = 0; e < 16; ++e) s += y[e];
        s += __shfl_xor(s, 1); s += __shfl_xor(s, 2); s += __shfl_xor(s, 4);
        const float mu = s * (1.f / 128.f); float v2 = 0.f;
#pragma unroll
        for (int e = 0; e < 16; ++e) { y[e] -= mu; v2 += y[e] * y[e]; }
        v2 += __shfl_xor(v2, 1); v2 += __shfl_xor(v2, 2); v2 += __shfl_xor(v2, 4);
        const float rstd = rsqrtf(v2 * (1.f / 128.f) + GN_EPS);
        const size_t tok = (size_t)(b * SEQ + t0 + i);
        float gt[16]; { const u32x4* gp = (const u32x4*)(proj + tok * PIN + OFF_RG + h * 128 + g * 16); float f0[8], f1[8]; unpack8(gp[0], f0); unpack8(gp[1], f1);
#pragma unroll
            for (int e = 0; e < 8; ++e) { gt[e] = f0[e]; gt[8 + e] = f1[e]; } }
        unsigned w[8];
#pragma unroll
        for (int e = 0; e < 8; ++e) { const float a0 = gt[2 * e], a1 = gt[2 * e + 1];
            w[e] = pk2(y[2 * e] * rstd * (a0 / (1.0f + __expf(-a0))), y[2 * e + 1] * rstd * (a1 / (1.0f + __expf(-a1)))); }
        u32x4* op = (u32x4*)(ycat + tok * DM + NAW + HYW + h * 128 + g * 16);
        op[0] = (u32x4){w[0], w[1], w[2], w[3]}; op[1] = (u32x4){w[4], w[5], w[6], w[7]};
    }
}

__device__ void ph_gnorm(const P& p, const Ctx& c, int l) {
    const int gw = c.bid * NWAVES + c.wave, NGW = c.G * NWAVES;
    const float* gain = p.in[I_BRANCH_NORM] + (size_t)l * DM;
    for (int m = gw; m < NT; m += NGW) {
        const bf16_t* yr = (const bf16_t*)(p.ws + WS_YCAT) + (size_t)m * DM; bf16_t* orow = (bf16_t*)(p.ws + WS_YN) + (size_t)m * DM;
        float v[4][8]; float ss[3] = {0.f, 0.f, 0.f};
#pragma unroll
        for (int j = 0; j < 4; ++j) { const int e0 = 512 * j + 8 * c.lane; unpack8(*(const u32x4*)(yr + e0), v[j]);
            float s = 0.f;
#pragma unroll
            for (int i = 0; i < 8; ++i) s += v[j][i] * v[j][i];
            const int grp = e0 < NAW ? 0 : (e0 < NAW + HYW ? 1 : 2);
            ss[0] += grp == 0 ? s : 0.f; ss[1] += grp == 1 ? s : 0.f; ss[2] += grp == 2 ? s : 0.f; }
        const float r0 = rsqrtf(wave_sum(ss[0]) * (1.f / NAW) + RMS_EPS), r1 = rsqrtf(wave_sum(ss[1]) * (1.f / HYW) + RMS_EPS), r2 = rsqrtf(wave_sum(ss[2]) * (1.f / RETW) + RMS_EPS);
#pragma unroll
        for (int j = 0; j < 4; ++j) { const int e0 = 512 * j + 8 * c.lane; const float rr = e0 < NAW ? r0 : (e0 < NAW + HYW ? r1 : r2);
            const f32x4 g0 = *(const f32x4*)(gain + e0), g1 = *(const f32x4*)(gain + e0 + 4);
            u32x4 w; w.x = pk2(v[j][0] * rr * g0.x, v[j][1] * rr * g0.y); w.y = pk2(v[j][2] * rr * g0.z, v[j][3] * rr * g0.w);
            w.z = pk2(v[j][4] * rr * g1.x, v[j][5] * rr * g1.y); w.w = pk2(v[j][6] * rr * g1.z, v[j][7] * rr * g1.w);
            *(u32x4*)(orow + e0) = w; }
    }
}

__device__ void ph_xatt(const P& p, const Ctx& c, int l) {
    const bf16_t* qc = (const bf16_t*)(p.ws + WS_QC); const bf16_t* kv = (const bf16_t*)(p.ws + WS_KVC) + (size_t)l * 1024 * 4096; bf16_t* oc = (bf16_t*)(p.ws + WS_OC);
    LAS float* S = (LAS float*)c.lds;
    for (int u = c.bid; u < NB * XH * 32; u += c.G) {
        const int qt = u % 32, h = (u / 32) % XH, b = u / (32 * XH);
        const int i = c.tid >> 3, g = c.tid & 7; const size_t tok = (size_t)b * SEQ + qt * 64 + i;
        float acc[32];
#pragma unroll
        for (int jj = 0; jj < 32; ++jj) acc[jj] = 0.f;
        const u32x4* qp = (const u32x4*)(qc + tok * DM + h * XD);
        for (int dc = 0; dc < 64; ++dc) { float qf[8]; unpack8(qp[dc], qf);
#pragma unroll
            for (int jj = 0; jj < 32; ++jj) { const int j = g + 8 * jj; float kf[8]; unpack8(*(const u32x4*)(kv + (size_t)(b * NMEM + j) * 4096 + h * XD + dc * 8), kf);
#pragma unroll
                for (int e = 0; e < 8; ++e) acc[jj] += qf[e] * kf[e]; } }
        float mx = -INFINITY;
#pragma unroll
        for (int jj = 0; jj < 32; ++jj) { acc[jj] *= 0.04419417382415922f; mx = fmaxf(mx, acc[jj]); }
        mx = fmaxf(mx, __shfl_xor(mx, 1)); mx = fmaxf(mx, __shfl_xor(mx, 2)); mx = fmaxf(mx, __shfl_xor(mx, 4));
        float sum = 0.f;
#pragma unroll
        for (int jj = 0; jj < 32; ++jj) { acc[jj] = __expf(acc[jj] - mx); sum += acc[jj]; }
        sum += __shfl_xor(sum, 1); sum += __shfl_xor(sum, 2); sum += __shfl_xor(sum, 4);
        const float inv = 1.0f / sum;
        __syncthreads();
#pragma unroll
        for (int jj = 0; jj < 32; ++jj) S[i * 257 + g + 8 * jj] = acc[jj] * inv;
        __syncthreads();
        float o[64];
#pragma unroll
        for (int e = 0; e < 64; ++e) o[e] = 0.f;
        for (int j = 0; j < NMEM; ++j) { const float pr = S[i * 257 + j]; const u32x4* vp = (const u32x4*)(kv + (size_t)(b * NMEM + j) * 4096 + 2048 + h * XD + g * 64);
#pragma unroll
            for (int cc = 0; cc < 8; ++cc) { float vf[8]; unpack8(vp[cc], vf);
#pragma unroll
                for (int e = 0; e < 8; ++e) o[cc * 8 + e] += pr * vf[e]; } }
        u32x4* op = (u32x4*)(oc + tok * DM + h * XD + g * 64);
#pragma unroll
        for (int cc = 0; cc < 8; ++cc) { u32x4 w; w.x = pk2(o[cc * 8 + 0], o[cc * 8 + 1]); w.y = pk2(o[cc * 8 + 2], o[cc * 8 + 3]); w.z = pk2(o[cc * 8 + 4], o[cc * 8 + 5]); w.w = pk2(o[cc * 8 + 6], o[cc * 8 + 7]); op[cc] = w; }
    }
}

__device__ void ph_router(const P& p, const Ctx& c, int l) {
    const int gw = c.bid * NWAVES + c.wave, NGW = c.G * NWAVES;
    const float* gain = p.in[I_NORM_MOE] + (size_t)l * DM; const float* wr = p.in[I_W_ROUTER] + (size_t)l * DM * NE;
    for (int m = gw; m < NT; m += NGW) {
        f32x4 v[8]; row_load_f32((const float*)(p.ws + WS_XRES) + (size_t)m * DM, c.lane, v);
        const float rstd = rsqrtf(row_ssq(v) * (1.f / DM) + RMS_EPS);
        float lg[16];
#pragma unroll
        for (int e = 0; e < 16; ++e) lg[e] = 0.f;
#pragma unroll
        for (int j = 0; j < 8; ++j) { const f32x4 g = *(const f32x4*)(gain + 256 * j + 4 * c.lane); v[j] = v[j] * rstd * g;
#pragma unroll
            for (int q = 0; q < 4; ++q) { const float hv = v[j][q]; const f32x4* wp = (const f32x4*)(wr + (size_t)(256 * j + 4 * c.lane + q) * NE);
#pragma unroll
                for (int e4 = 0; e4 < 4; ++e4) { const f32x4 w = wp[e4]; lg[e4 * 4 + 0] += hv * w.x; lg[e4 * 4 + 1] += hv * w.y; lg[e4 * 4 + 2] += hv * w.z; lg[e4 * 4 + 3] += hv * w.w; } } }
        row_store_bf16((bf16_t*)(p.ws + WS_HN) + (size_t)m * DM, c.lane, v);
        float mx = -INFINITY;
#pragma unroll
        for (int e = 0; e < 16; ++e) { lg[e] = wave_sum(lg[e]); mx = fmaxf(mx, lg[e]); }
        float sum = 0.f;
#pragma unroll
        for (int e = 0; e < 16; ++e) { lg[e] = expf(lg[e] - mx); sum += lg[e]; }
        if (c.lane < 16) { float a = 0.f;
#pragma unroll
            for (int e = 0; e < 16; ++e) a = (c.lane == e) ? lg[e] : a;
            ((float*)(p.ws + WS_AFF))[(size_t)m * NE + c.lane] = a / sum; }
    }
}

__device__ void ph_topk(const P& p, const Ctx& c) {
    LAS float* a = (LAS float*)c.lds;
    const float* aff = (const float*)(p.ws + WS_AFF); int* idx = (int*)(p.ws + WS_IDX); float* gs = (float*)(p.ws + WS_GSEL); int* inv = (int*)(p.ws + WS_INV);
    for (int u = c.bid; u < NB * NE; u += c.G) {
        const int e = u % NE, b = u / NE;
        __syncthreads();
        for (int t = c.tid; t < SEQ; t += NTHR) a[t] = aff[(size_t)(b * SEQ + t) * NE + e];
        __syncthreads();
        for (int q = 0; q < 4; ++q) { const int i = c.tid + 512 * q; const float ai = a[i]; int rank = 0;
            for (int j = 0; j < SEQ; ++j) { const float aj = a[j]; rank += (aj > ai || (aj == ai && j < i)) ? 1 : 0; }
            if (rank < CAP) { idx[(b * NE + e) * CAP + rank] = i; gs[(b * NE + e) * CAP + rank] = ai; inv[(size_t)(b * SEQ + i) * NE + e] = rank; }
            else inv[(size_t)(b * SEQ + i) * NE + e] = -1; }
    }
}

__device__ void ph_gather(const P& p, const Ctx& c) {
    const int gw = c.bid * NWAVES + c.wave, NGW = c.G * NWAVES;
    const int* idx = (const int*)(p.ws + WS_IDX);
    for (int r = gw; r < NE * NB * CAP; r += NGW) { const int e = r / (NB * CAP), b = (r / CAP) % NB, slot = r % CAP;
        const int t = idx[(b * NE + e) * CAP + slot];
        const u32x4* s = (const u32x4*)((const bf16_t*)(p.ws + WS_HN) + (size_t)(b * SEQ + t) * DM); u32x4* d = (u32x4*)((bf16_t*)(p.ws + WS_XE) + (size_t)r * DM);
#pragma unroll
        for (int j = 0; j < 4; ++j) d[64 * j + c.lane] = s[64 * j + c.lane]; }
}

__device__ void ph_combine(const P& p, const Ctx& c, int l) {
    const int gw = c.bid * NWAVES + c.wave, NGW = c.G * NWAVES;
    const int* inv = (const int*)(p.ws + WS_INV); const float* gs = (const float*)(p.ws + WS_GSEL); const float* ym = (const float*)(p.ws + WS_YMOE);
    for (int m = gw; m < NT; m += NGW) { const int b = m / SEQ;
        float* xr = (float*)(p.ws + WS_XRES) + (size_t)m * DM;
        f32x4 v[8]; row_load_f32(xr, c.lane, v);
        for (int e = 0; e < NE; ++e) { const int slot = inv[(size_t)m * NE + e];
            if (slot >= 0) { const float g = gs[(b * NE + e) * CAP + slot]; const float* yr = ym + ((size_t)e * 1024 + b * CAP + slot) * DM;
#pragma unroll
                for (int j = 0; j < 8; ++j) v[j] = v[j] + g * *(const f32x4*)(yr + 256 * j + 4 * c.lane); } }
        if (l == DEPTH - 1) { const float rstd = rsqrtf(row_ssq(v) * (1.f / DM) + RMS_EPS); float* orow = p.out + (size_t)m * DM; const float* gain = p.in[I_FINAL_NORM];
#pragma unroll
            for (int j = 0; j < 8; ++j) *(f32x4*)(orow + 256 * j + 4 * c.lane) = v[j] * rstd * *(const f32x4*)(gain + 256 * j + 4 * c.lane); }
        else {
#pragma unroll
            for (int j = 0; j < 8; ++j) *(f32x4*)(xr + 256 * j + 4 * c.lane) = v[j]; }
    }
}
template <int PH> __device__ __forceinline__ void run_phase(const P& p, const Ctx& c, int l) {
    unsigned char* ws = p.ws;
    if constexpr (PH == PH_CVT) ph_cvt(p, c);
    else if constexpr (PH == PH_PRE) ph_pre(p, c);
    else if constexpr (PH == PH_NORM1) ph_norm(p, c, p.in[I_NORM_MIX] + (size_t)l * DM);
    else if constexpr (PH == PH_NORM2) ph_norm(p, c, p.in[I_NORM_CROSS] + (size_t)l * DM);
    else if constexpr (PH == PH_INPROJ) {
        pg8::Gemm g{(const bf16_t*)(ws + WS_HN), (const bf16_t*)(ws + WS_WIN) + (size_t)l * PIN * DM, DM};
        pg8::StaticOrder S; S.init(NT, PIN, c.G, c.bid);
        EpiInProj E{(bf16_t*)(ws + WS_PROJ), (const float*)(ws + WS_ROT), (const float*)(ws + WS_ROT) + SEQ * 64};
        pg8::gemm_phase(c.lds, g, S, E);
    }
    else if constexpr (PH == PH_NA) ph_na(p, c, l);
    else if constexpr (PH == PH_HYPRE) ph_hypre(p, c, l);
    else if constexpr (PH == PH_HYCONV) ph_hyconv(p, c, l);
    else if constexpr (PH == PH_RET) ph_ret(p, c, l);
    else if constexpr (PH == PH_GNORM) ph_gnorm(p, c, l);
    else if constexpr (PH == PH_OUT) {
        pg8::Gemm g{(const bf16_t*)(ws + WS_YN), (const bf16_t*)(ws + WS_WOUT) + (size_t)l * DM * DM, DM};
        pg8::StaticOrder S; S.init(NT, DM, c.G, c.bid);
        EpiResid E{(float*)(ws + WS_XRES)};
        pg8::gemm_phase(c.lds, g, S, E);
    }
    else if constexpr (PH == PH_CQ) {
        pg8::Gemm g{(const bf16_t*)(ws + WS_HN), (const bf16_t*)(ws + WS_WCQ) + (size_t)l * DM * DM, DM};
        pg8::StaticOrder S; S.init(NT, DM, c.G, c.bid);
        EpiBf16 E{(bf16_t*)(ws + WS_QC), DM};
        pg8::gemm_phase(c.lds, g, S, E);
    }
    else if constexpr (PH == PH_CKV) {
        pg8::Gemm g{(const bf16_t*)(ws + WS_MEMN), (const bf16_t*)(ws + WS_WCKV) + (size_t)l * 4096 * DM, DM};
        pg8::StaticOrder S; S.init(NB * NMEM, 4096, c.G, c.bid);
        EpiBf16 E{(bf16_t*)(ws + WS_KVC) + (size_t)l * 1024 * 4096, 4096};
        pg8::gemm_phase(c.lds, g, S, E);
    }
    else if constexpr (PH == PH_XATT) ph_xatt(p, c, l);
    else if constexpr (PH == PH_CO) {
        pg8::Gemm g{(const bf16_t*)(ws + WS_OC), (const bf16_t*)(ws + WS_WCO) + (size_t)l * DM * DM, DM};
        pg8::StaticOrder S; S.init(NT, DM, c.G, c.bid);
        EpiResid E{(float*)(ws + WS_XRES)};
        pg8::gemm_phase(c.lds, g, S, E);
    }
    else if constexpr (PH == PH_ROUTER) ph_router(p, c, l);
    else if constexpr (PH == PH_TOPK) ph_topk(p, c);
    else if constexpr (PH == PH_GATHER) ph_gather(p, c);
    else if constexpr (PH == PH_GU) {
        pg8::Gemm g{(const bf16_t*)(ws + WS_XE), (const bf16_t*)(ws + WS_WGU) + (size_t)l * NE * 4096 * DM, DM};
        pg8::MoeOrder S; S.init(16, c.G, c.bid);
        EpiGU E{(bf16_t*)(ws + WS_ACT), 16};
        pg8::gemm_phase(c.lds, g, S, E);
    }
    else if constexpr (PH == PH_DOWN) {
        pg8::Gemm g{(const bf16_t*)(ws + WS_ACT), (const bf16_t*)(ws + WS_WDN) + (size_t)l * NE * DM * FF, FF};
        pg8::MoeOrder S; S.init(8, c.G, c.bid);
        EpiDown E{(float*)(ws + WS_YMOE), 8};
        pg8::gemm_phase(c.lds, g, S, E);
    }
    else if constexpr (PH == PH_COMBINE) ph_combine(p, c, l);
}

template <int PH> __global__ void __launch_bounds__(NTHR, 2) k_ph(P p, int l) {
    extern __shared__ __attribute__((aligned(16))) unsigned char lds_raw[];
    Ctx c; c.tid = threadIdx.x; c.lane = c.tid & 63; c.wave = __builtin_amdgcn_readfirstlane(c.tid >> 6); c.G = gridDim.x; c.bid = blockIdx.x; c.lds = (LAS unsigned char*)lds_raw;
    run_phase<PH>(p, c, l);
}

template <int PH> static void launch_ph(const P& p, int l, int grid, hipStream_t stream) {
    static bool attr_done = false;
    if (!attr_done) { hipError_t e = hipFuncSetAttribute((const void*)k_ph<PH>, hipFuncAttributeMaxDynamicSharedMemorySize, LDS_BYTES);
        if (e != hipSuccess) fprintf(stderr, "kernel_launch: hipFuncSetAttribute(phase %d) failed: %s\n", PH, hipGetErrorName(e)); attr_done = true; }
    hipLaunchKernelGGL(k_ph<PH>, dim3(grid), dim3(NTHR), LDS_BYTES, stream, p, l);
    hipError_t le = hipGetLastError();
    if (le != hipSuccess) fprintf(stderr, "kernel_launch: launch of phase %d failed: %s\n", PH, hipGetErrorName(le));
}

extern "C" void kernel_launch(void* const* d_in, const int* in_sizes, int n_in, void* d_out, int out_size, void* d_ws, size_t ws_size, hipStream_t stream) {
    if (n_in != N_IN || out_size != NT * DM || ws_size < WS_END) { fprintf(stderr, "kernel_launch: unexpected shapes (n_in %d, out %d, ws %zu < %zu); nothing launched\n", n_in, out_size, ws_size, (size_t)WS_END); return; }
    P p{};
    for (int i = 0; i < N_IN; ++i) p.in[i] = (const float*)d_in[i];
    p.out = (float*)d_out; p.ws = (unsigned char*)d_ws;
    const int G = 256;
    launch_ph<PH_CVT>(p, 0, G, stream);
    launch_ph<PH_PRE>(p, 0, G, stream);
    for (int l = 0; l < DEPTH; ++l) {
        launch_ph<PH_NORM1>(p, l, G, stream);
        launch_ph<PH_INPROJ>(p, l, G, stream);
        launch_ph<PH_NA>(p, l, G, stream);
        launch_ph<PH_HYPRE>(p, l, G, stream);
        launch_ph<PH_HYCONV>(p, l, G, stream);
        launch_ph<PH_RET>(p, l, G, stream);
        launch_ph<PH_GNORM>(p, l, G, stream);
        launch_ph<PH_OUT>(p, l, G, stream);
        launch_ph<PH_NORM2>(p, l, G, stream);
        launch_ph<PH_CQ>(p, l, G, stream);
        launch_ph<PH_CKV>(p, l, G, stream);
        launch_ph<PH_XATT>(p, l, G, stream);
        launch_ph<PH_CO>(p, l, G, stream);
        launch_ph<PH_ROUTER>(p, l, G, stream);
        launch_ph<PH_TOPK>(p, l, G, stream);
        launch_ph<PH_GATHER>(p, l, G, stream);
        launch_ph<PH_GU>(p, l, G, stream);
        launch_ph<PH_DOWN>(p, l, G, stream);
        launch_ph<PH_COMBINE>(p, l, G, stream);
    }
}
```

```cpp
#include <hip/hip_runtime.h>
#include <cstdio>
#include <cstdint>
#include <cmath>

#define LAS __attribute__((address_space(3)))
typedef unsigned short bf16_t;
typedef short bf16x8 __attribute__((ext_vector_type(8)));
typedef float f32x4 __attribute__((ext_vector_type(4)));
typedef float f32x2 __attribute__((ext_vector_type(2)));
typedef unsigned u32x4 __attribute__((ext_vector_type(4)));
typedef unsigned u32x2 __attribute__((ext_vector_type(2)));

constexpr int NB = 4, SEQ = 2048, DM = 2048, NT = NB * SEQ, DEPTH = 2;
constexpr int NMEM = 256, GW = 64, ROWS = SEQ / GW;
constexpr int NAW = 768, NAH = 12, NADH = 64;
constexpr int HYW = 512, HYFF = 64;
constexpr int RETW = 768, RETH = 6, RETD = 128;
constexpr int PIN = 6912;
constexpr int OFF_NAQ = 0, OFF_NAK = 768, OFF_NAV = 1536, OFF_HY = 2304, OFF_RQ = 3840, OFF_RK = 4608, OFF_RV = 5376, OFF_RG = 6144;
constexpr int XH = 4, XD = 512;
constexpr int NE = 16, FF = 2048, CAP = 256;
constexpr float RMS_EPS = 1e-6f, GN_EPS = 1e-5f;

enum { I_X = 0, I_MEM, I_NORM_MIX, I_W_IN, I_NA_RPB, I_HY_CONV_W, I_HY_CONV_B, I_HY_W1, I_HY_B1, I_HY_W2, I_HY_B2, I_HY_W3, I_HY_FREQ, I_HY_SKIP,
       I_BRANCH_NORM, I_W_OUT, I_NORM_CROSS, I_MEM_NORM, I_W_CQ, I_W_CKV, I_W_CO, I_NORM_MOE, I_W_ROUTER, I_W_GATE, I_W_UP, I_W_DOWN, I_FINAL_NORM, N_IN };

constexpr size_t MiB = (size_t)1 << 20;
constexpr size_t WS_CTL   = 0;
constexpr size_t WS_XRES  = 1 * MiB;
constexpr size_t WS_HN    = WS_XRES + 64 * MiB;
constexpr size_t WS_PROJ  = WS_HN + 32 * MiB;
constexpr size_t WS_YCAT  = WS_PROJ + 108 * MiB;
constexpr size_t WS_YN    = WS_YCAT + 32 * MiB;
constexpr size_t WS_QC    = WS_YN + 32 * MiB;
constexpr size_t WS_KVC   = WS_QC + 32 * MiB;
constexpr size_t WS_OC    = WS_KVC + 16 * MiB;
constexpr size_t WS_MEMN  = WS_OC + 32 * MiB;
constexpr size_t WS_AFF   = WS_MEMN + 4 * MiB;
constexpr size_t WS_IDX   = WS_AFF + 1 * MiB;
constexpr size_t WS_GSEL  = WS_IDX + 1 * MiB;
constexpr size_t WS_INV   = WS_GSEL + 1 * MiB;
constexpr size_t WS_XE    = WS_INV + 1 * MiB;
constexpr size_t WS_ACT   = WS_XE + 64 * MiB;
constexpr size_t WS_YMOE  = WS_ACT + 64 * MiB;
constexpr size_t WS_ROT   = WS_YMOE + 128 * MiB;
constexpr size_t WS_KF    = WS_ROT + 1 * MiB;
constexpr size_t WS_HS    = WS_KF + 32 * MiB;
constexpr size_t WS_WIN   = WS_HS + 48 * MiB;
constexpr size_t WS_WOUT  = WS_WIN + 54 * MiB;
constexpr size_t WS_WCQ   = WS_WOUT + 16 * MiB;
constexpr size_t WS_WCKV  = WS_WCQ + 16 * MiB;
constexpr size_t WS_WCO   = WS_WCKV + 32 * MiB;
constexpr size_t WS_WGU   = WS_WCO + 16 * MiB;
constexpr size_t WS_WDN   = WS_WGU + 512 * MiB;
constexpr size_t WS_END   = WS_WDN + 256 * MiB;

struct P { const float* in[N_IN]; float* out; unsigned char* ws; };
typedef const __attribute__((address_space(4))) unsigned long long* KArgQ;
struct PD { KArgQ q;
    __device__ __forceinline__ const float* in(int i) const { return (const float*)q[i]; }
    __device__ __forceinline__ float* out() const { return (float*)q[N_IN]; }
    __device__ __forceinline__ unsigned char* ws() const { return (unsigned char*)q[N_IN + 1]; } };

__device__ __forceinline__ float bf2f(unsigned v) { return __uint_as_float(v << 16); }
__device__ __forceinline__ unsigned f2bf(float f) { unsigned u = __float_as_uint(f); u += 0x7fffu + ((u >> 16) & 1u); return u >> 16; }
__device__ __forceinline__ unsigned pk2(float lo, float hi) { return f2bf(lo) | (f2bf(hi) << 16); }
__device__ __forceinline__ unsigned cvt_pk_bf16(float lo, float hi) { unsigned r; asm volatile("v_cvt_pk_bf16_f32 %0, %1, %2" : "=v"(r) : "v"(lo), "v"(hi)); return r; }
__device__ __forceinline__ void unpack8(const u32x4 w, float (&f)[8]) {
    f[0] = bf2f(w.x & 0xffffu); f[1] = bf2f(w.x >> 16); f[2] = bf2f(w.y & 0xffffu); f[3] = bf2f(w.y >> 16);
    f[4] = bf2f(w.z & 0xffffu); f[5] = bf2f(w.z >> 16); f[6] = bf2f(w.w & 0xffffu); f[7] = bf2f(w.w >> 16);
}
__device__ __forceinline__ float wave_sum(float v) {
#pragma unroll
    for (int o = 1; o < 64; o <<= 1) v += __shfl_xor(v, o);
    return v;
}
#define LDS_WAIT() asm volatile("s_waitcnt lgkmcnt(0)" ::: "memory")
namespace pg8 {
constexpr int BM = 256, BK = 64, HALF = 128, HTB = HALF * BK * 2  , STAGE_BYTES = 8 * HTB, NXCD = 8, WGM = 8;

__host__ __device__ __forceinline__ int lds_byte(int r, int c) { const int st = (r >> 4) * 2 + (c >> 5), rr = r & 15, cc = c & 31, ob = rr * 64 + cc * 2; return st * 1024 + (ob ^ (((ob >> 9) & 1) << 5)); }
__host__ __device__ __forceinline__ void stage_rc(int b, int& R, int& C) { const int st = b / 1024, sb = b % 1024, swz = sb ^ (((sb >> 9) & 1) << 5); R = (st >> 1) * 16 + swz / 64; C = (st & 1) * 32 + (swz % 64) / 2; }
__host__ __device__ __forceinline__ int perm32(int rho) { const int n = rho >> 4, i = rho & 15; return 8 * (i >> 2) + 4 * n + (i & 3); }

struct Unit { int pm, pn; };
struct Gemm { const bf16_t* A; const bf16_t* Bt; int K; };

struct StaticOrder {
    int nM, nN, nwg, G, c;
    __device__ void init(int M, int N, int G_, int c_) { nM = M / BM; nN = N / BM; nwg = nM * nN; G = G_; c = c_; }
    __device__ bool next(int i, Unit& u) const {
        const long L = (long)i * G + c; if (L >= nwg) return false;
        int wgid = (int)L; { const int q = nwg / NXCD, r = nwg % NXCD, xcd = wgid % NXCD, off = wgid / NXCD; wgid = (xcd < r ? xcd * (q + 1) : r * (q + 1) + (xcd - r) * q) + off; }
        const int nig = WGM * nN, gid = wgid / nig, fm = gid * WGM, gsz = (nM - fm) < WGM ? (nM - fm) : WGM;
        u.pm = fm + ((wgid % nig) % gsz); u.pn = (wgid % nig) / gsz; return true;
    }
};
struct MoeOrder {
    int npn, G, c;
    __device__ void init(int npn_, int G_, int c_) { npn = npn_; G = G_; c = c_; }
    __device__ bool next(int i, Unit& u) const {
        const int L = i * G + c; const int per_e = 4 * npn; if (L >= 16 * per_e) return false;
        const int e = L / per_e, r = L % per_e; u.pm = e * 4 + (r & 3); u.pn = e * npn + (r >> 2); return true;
    }
};

template <class Epi, class Sched>
__device__ __forceinline__ void gemm_phase(LAS unsigned char* lds, const int tid, const Gemm g, const Sched& S, const Epi& E) {
    const int wid = __builtin_amdgcn_readfirstlane(tid >> 6), lane = tid & 63, wr = wid >> 2, wc = wid & 3, fr = lane & 15, fq = lane >> 4;
    const int K = g.K, nt = K / BK;
    unsigned voffA[2], voffB[2];
#pragma unroll
    for (int i = 0; i < 2; ++i) { int R, C; stage_rc(tid * 16 + i * 8192, R, C); const int Rb = Epi::PERM ? ((R & ~31) + perm32(R & 31)) : R;
        voffA[i] = (unsigned)(R * K + C) * 2u; voffB[i] = (unsigned)(Rb * K + C) * 2u; }
    const size_t kstep = (size_t)(BK * 2);
    const size_t hstep = (size_t)HALF * K * 2;
    const size_t tstep = 2 * hstep;
    const unsigned ldsw = (unsigned)wid * 1024u;
    const int aoff = lds_byte(wr * 64 + fr, fq * 8), boff = lds_byte(wc * 32 + fr, fq * 8);
#define PG8_SA(b, h) (((b) * 2 + (h)) * HTB)
#define PG8_SB(b, h) ((4 + (b) * 2 + (h)) * HTB)
#define PG8_STAGE(bufoff, gbase, voff) do { _Pragma("unroll") for (int _i = 0; _i < 2; ++_i) \
        __builtin_amdgcn_global_load_lds((const unsigned*)((const char*)(gbase) + (voff)[_i]), (LAS unsigned*)(lds + (bufoff) + ldsw + _i * 8192), 16, 0, 0); } while (0)
#define PG8_LDA(dst, b, h) do { _Pragma("unroll") for (int m = 0; m < 4; ++m) _Pragma("unroll") for (int k = 0; k < 2; ++k) dst[m][k] = *(const LAS bf16x8*)(lds + PG8_SA(b, h) + aoff + m * 2048 + k * 1024); } while (0)
#define PG8_LDB(dst, b, h) do { _Pragma("unroll") for (int n = 0; n < 2; ++n) _Pragma("unroll") for (int k = 0; k < 2; ++k) dst[n][k] = *(const LAS bf16x8*)(lds + PG8_SB(b, h) + boff + n * 2048 + k * 1024); } while (0)
#define PG8_MMA(ai, bj, At, Bt) do { __builtin_amdgcn_s_setprio(1); _Pragma("unroll") for (int m = 0; m < 4; ++m) _Pragma("unroll") for (int n = 0; n < 2; ++n) _Pragma("unroll") for (int k = 0; k < 2; ++k) \
        acc[ai][bj][m][n] = __builtin_amdgcn_mfma_f32_16x16x32_bf16(Bt[n][k], At[m][k], acc[ai][bj][m][n], 0, 0, 0); __builtin_amdgcn_s_setprio(0); } while (0)
#define PG8_WAIT_V(n) asm volatile("s_waitcnt vmcnt(" #n ")" ::: "memory")
#define PG8_WAIT_L(n) asm volatile("s_waitcnt lgkmcnt(" #n ")" ::: "memory")
#define PG8_BAR __builtin_amdgcn_s_barrier()
#define PG8_SCHED __builtin_amdgcn_sched_barrier(0)
    Unit cur, nxt; int ui = 0;
    if (!S.next(0, cur)) return;
    f32x4 acc[2][2][4][2];
#pragma unroll
    for (int a = 0; a < 2; ++a)
#pragma unroll
        for (int b = 0; b < 2; ++b)
#pragma unroll
            for (int m = 0; m < 4; ++m)
#pragma unroll
                for (int n = 0; n < 2; ++n) acc[a][b][m][n] = (f32x4){0.f, 0.f, 0.f, 0.f};
    bf16x8 At[4][2], B0[2][2], B1[2][2];
    const char* cA = (const char*)g.A + (size_t)cur.pm * tstep; const char* cB = (const char*)g.Bt + (size_t)cur.pn * tstep;
    PG8_STAGE(PG8_SB(0, 0), cB, voffB); PG8_STAGE(PG8_SA(0, 0), cA, voffA); PG8_STAGE(PG8_SB(0, 1), cB + hstep, voffB); PG8_STAGE(PG8_SA(0, 1), cA + hstep, voffA);
    if (wr == 1) PG8_BAR;
    PG8_WAIT_V(4); PG8_BAR;
    PG8_STAGE(PG8_SB(1, 0), cB + kstep, voffB); PG8_STAGE(PG8_SA(1, 0), cA + kstep, voffA); PG8_STAGE(PG8_SB(1, 1), cB + hstep + kstep, voffB);
    PG8_WAIT_V(6); PG8_BAR;
    for (;;) {
        const bool has_next = S.next(ui + 1, nxt);
        const char* nA = has_next ? (const char*)g.A + (size_t)nxt.pm * tstep : cA; const char* nB = has_next ? (const char*)g.Bt + (size_t)nxt.pn * tstep : cB;
        for (int t = 0; t < nt; t += 2) {
            const bool last = (t == nt - 2);
            const char* a1 = cA + (size_t)(t + 1) * kstep;
            const char* a2 = last ? nA : cA + (size_t)(t + 2) * kstep; const char* b2 = last ? nB : cB + (size_t)(t + 2) * kstep;
            const char* a3 = a2 + kstep; const char* b3 = b2 + kstep;
            PG8_LDB(B0, 0, 0); PG8_SCHED; PG8_LDA(At, 0, 0); PG8_STAGE(PG8_SA(1, 1), a1 + hstep, voffA);
            PG8_WAIT_L(8); PG8_BAR; PG8_WAIT_L(0); PG8_MMA(0, 0, At, B0); PG8_BAR; PG8_SCHED;
            PG8_LDB(B1, 0, 1); PG8_STAGE(PG8_SB(0, 0), b2, voffB);
            PG8_BAR; PG8_WAIT_L(0); PG8_MMA(0, 1, At, B1); PG8_BAR;
            PG8_LDA(At, 0, 1); PG8_STAGE(PG8_SA(0, 0), a2, voffA);
            PG8_BAR; PG8_WAIT_L(0); PG8_MMA(1, 0, At, B0); PG8_BAR; PG8_SCHED;
            PG8_STAGE(PG8_SB(0, 1), b2 + hstep, voffB);
            PG8_WAIT_V(6); PG8_BAR; PG8_MMA(1, 1, At, B1); PG8_BAR;
            PG8_LDB(B0, 1, 0); PG8_SCHED; PG8_LDA(At, 1, 0); PG8_STAGE(PG8_SA(0, 1), a2 + hstep, voffA);
            PG8_WAIT_L(8); PG8_BAR; PG8_WAIT_L(0); PG8_MMA(0, 0, At, B0); PG8_BAR; PG8_SCHED;
            PG8_LDB(B1, 1, 1); PG8_STAGE(PG8_SB(1, 0), b3, voffB);
            PG8_BAR; PG8_WAIT_L(0); PG8_MMA(0, 1, At, B1); PG8_BAR;
            PG8_LDA(At, 1, 1); PG8_STAGE(PG8_SA(1, 0), a3, voffA);
            PG8_BAR; PG8_WAIT_L(0); PG8_MMA(1, 0, At, B0); PG8_BAR; PG8_SCHED;
            PG8_STAGE(PG8_SB(1, 1), b3 + hstep, voffB);
            PG8_WAIT_V(6); PG8_BAR; PG8_MMA(1, 1, At, B1); PG8_BAR;
        }
        E(acc, cur, wr, wc, fr, fq);
        if (!has_next) break;
#pragma unroll
        for (int a = 0; a < 2; ++a)
#pragma unroll
            for (int b = 0; b < 2; ++b)
#pragma unroll
                for (int m = 0; m < 4; ++m)
#pragma unroll
                    for (int n = 0; n < 2; ++n) acc[a][b][m][n] = (f32x4){0.f, 0.f, 0.f, 0.f};
        cur = nxt; cA = nA; cB = nB; ++ui;
    }
    PG8_WAIT_V(0);
    if (wr == 0) PG8_BAR;
    PG8_BAR;
#undef PG8_SA
#undef PG8_SB
#undef PG8_STAGE
#undef PG8_LDA
#undef PG8_LDB
#undef PG8_MMA
#undef PG8_WAIT_V
#undef PG8_WAIT_L
#undef PG8_BAR
#undef PG8_SCHED
}
}
#define XB_TMO      128
#define XB_XCNT(j)  (256  + 64 * (j))
#define XB_XSUB(j)  (1280 + 64 * (j))
#define XB_XGEN(j)  (2304 + 64 * (j))
#define XB_TOP      3328
#define XB_TOPGEN   3392
#define XCD_BAR_WORDS 3456
#define XB_SPIN_CAP (1u << 18)

__device__ __forceinline__ unsigned xb_ld(unsigned* p)              { return __hip_atomic_load(p, __ATOMIC_RELAXED, __HIP_MEMORY_SCOPE_AGENT); }
__device__ __forceinline__ unsigned xb_add(unsigned* p, unsigned v) { return __hip_atomic_fetch_add(p, v, __ATOMIC_RELAXED, __HIP_MEMORY_SCOPE_AGENT); }
__device__ __forceinline__ unsigned xb_xcc_id() { return (unsigned)__builtin_amdgcn_s_getreg((3 << 11) | 20) & 0xFu; }
#define XB_SPIN(cond, bar) do { unsigned _sp = 0; while (cond) { __builtin_amdgcn_s_sleep(1); \
    if ((++_sp & 255u) == 0u) { if (xb_ld(&(bar)[XB_TMO])) break; if (_sp > XB_SPIN_CAP) { atomicAdd(&(bar)[XB_TMO], 1u); break; } } } } while (0)

struct XcdBarrier {
    unsigned* bar; unsigned x;
    volatile LAS unsigned* st;
};

__device__ __forceinline__ XcdBarrier xcd_barrier_post(unsigned* bar, volatile LAS unsigned* st) {
    XcdBarrier b; b.bar = bar; b.x = xb_xcc_id(); b.st = st;
    if (threadIdx.x == 0) (void)xb_add(&bar[XB_XCNT(b.x)], 1u);
    return b;
}
__device__ __forceinline__ void xcd_barrier_complete(unsigned* bar, unsigned x, unsigned& nloc, unsigned& nx) {
    const unsigned G = gridDim.x * gridDim.y * gridDim.z;
    unsigned sum, cnt, mine, sp = 0u;
    for (;;) {
        sum = 0u; cnt = 0u; mine = 0u;
#pragma unroll
        for (unsigned j = 0; j < 16; ++j) { const unsigned c = xb_ld(&bar[XB_XCNT(j)]); sum += c; cnt += (c > 0u) ? 1u : 0u; mine = (j == x) ? c : mine; }
        if (sum == G) break;
        __builtin_amdgcn_s_sleep(1);
        if ((++sp & 255u) == 0u) { if (xb_ld(&bar[XB_TMO])) break; if (sp > XB_SPIN_CAP) { atomicAdd(&bar[XB_TMO], 1u); break; } }
    }
    nloc = mine > 0u ? mine : 1u; nx = cnt > 0u ? cnt : 1u;
}

__device__ __forceinline__ void xcd_barrier(const XcdBarrier& b) {
    asm volatile("s_waitcnt vmcnt(0)" ::: "memory");
    __syncthreads();
    if (threadIdx.x == 0) {
        unsigned* bar = b.bar;
        __builtin_amdgcn_s_waitcnt(0);
        unsigned nloc = b.st[0], nx = b.st[1];
        if (nloc == 0u) { xcd_barrier_complete(bar, b.x, nloc, nx); b.st[0] = nloc; b.st[1] = nx; }
        const unsigned old = xb_add(&bar[XB_XSUB(b.x)], 1u);
        const unsigned gen = old / nloc;
        if (old + 1u == (gen + 1u) * nloc) {
            __builtin_amdgcn_fence(__ATOMIC_RELEASE, "agent");
            asm volatile("s_waitcnt vmcnt(0)" ::: "memory");
            const unsigned og = xb_add(&bar[XB_TOP], 1u);
            const unsigned tg = og / nx;
            if (og + 1u == (tg + 1u) * nx) xb_add(&bar[XB_TOPGEN], 1u);
            else XB_SPIN(xb_ld(&bar[XB_TOPGEN]) == tg, bar);
            __builtin_amdgcn_fence(__ATOMIC_ACQUIRE, "agent");
            xb_add(&bar[XB_XGEN(b.x)], 1u);
            asm volatile("s_waitcnt vmcnt(0)" ::: "memory");
        } else {
            XB_SPIN(xb_ld(&bar[XB_XGEN(b.x)]) == gen, bar);
            __builtin_amdgcn_fence(__ATOMIC_ACQUIRE, "agent");
            asm volatile("s_waitcnt vmcnt(0)" ::: "memory");
        }
    }
    __syncthreads();
}

enum { PH_CVT = 0, PH_PRE, PH_NORM1, PH_INPROJ, PH_NA, PH_HYPRE, PH_HYCONV, PH_RET, PH_GNORM, PH_OUT, PH_NORM2, PH_CQ, PH_CKV, PH_XATT, PH_CO, PH_ROUTER, PH_TOPK, PH_GATHER,
       PH_GU, PH_DOWN, PH_COMBINE, N_PHASES };
constexpr int NTHR = 512, NWAVES = 8;
constexpr int LDS_BYTES = 150 * 1024;

struct Ctx { int tid, lane, wave, G, bid; LAS unsigned char* lds; };

__device__ __forceinline__ void cvt_item(const float* colp, size_t stride, int K, bf16_t* WT, LAS float* scr, int k0, int n0, int lane) {
#pragma unroll 8
    for (int i = 0; i < 32; ++i) { const int kk = 2 * i + (lane >> 5); scr[kk * 33 + (lane & 31)] = colp[(size_t)(k0 + kk) * stride]; }
    LDS_WAIT();
    const int c = lane & 7;
#pragma unroll
    for (int j = 0; j < 4; ++j) { const int n = (lane >> 3) + 8 * j; const LAS float* s = scr + (8 * c) * 33 + n;
        u32x4 o; o.x = pk2(s[0 * 33], s[1 * 33]); o.y = pk2(s[2 * 33], s[3 * 33]); o.z = pk2(s[4 * 33], s[5 * 33]); o.w = pk2(s[6 * 33], s[7 * 33]);
        *(u32x4*)(WT + (size_t)(n0 + n) * K + k0 + 8 * c) = o; }
    LDS_WAIT();
}
__device__ __forceinline__ int win_src_col(int n) {
    if (n >= OFF_RQ && n < OFF_RV) { const int base = n & ~127, p = n & 127; return base + (p >> 1) + 64 * (p & 1); }
    return n;
}
__device__ __forceinline__ void ph_cvt(const PD& p, const Ctx& c) {
    LAS float* scr = (LAS float*)(c.lds) + c.wave * (64 * 33);
    const int gw = c.bid * NWAVES + c.wave, NGW = c.G * NWAVES;
    constexpr int I_IN = 32 * (PIN / 32), I_SQ = 32 * (DM / 32), I_KV = 32 * (4096 / 32), I_GU = NE * 32 * (4096 / 32), I_DN = NE * 32 * (DM / 32);
    constexpr int PER_LAYER = I_IN + 3 * I_SQ + I_KV + I_GU + I_DN;
    for (int it = gw; it < DEPTH * PER_LAYER; it += NGW) {
        const int l = it / PER_LAYER; int r = it % PER_LAYER;
        const int ln = c.lane & 31;
        if (r < I_IN) { const int kb = r / (PIN / 32), nb = r % (PIN / 32);
            const float* W = p.in(I_W_IN) + (size_t)l * DM * PIN; bf16_t* WT = (bf16_t*)(p.ws() + WS_WIN) + (size_t)l * PIN * DM;
            cvt_item(W + win_src_col(nb * 32 + ln), PIN, DM, WT, scr, kb * 64, nb * 32, c.lane); continue; }
        r -= I_IN;
        if (r < 3 * I_SQ) { const int which = r / I_SQ; r %= I_SQ; const int kb = r / (DM / 32), nb = r % (DM / 32);
            const size_t wo = which == 0 ? WS_WOUT : (which == 1 ? WS_WCQ : WS_WCO);
            const float* W = (which == 0 ? p.in(I_W_OUT) : (which == 1 ? p.in(I_W_CQ) : p.in(I_W_CO))) + (size_t)l * DM * DM; bf16_t* WT = (bf16_t*)(p.ws() + wo) + (size_t)l * DM * DM;
            cvt_item(W + nb * 32 + ln, DM, DM, WT, scr, kb * 64, nb * 32, c.lane); continue; }
        r -= 3 * I_SQ;
        if (r < I_KV) { const int kb = r / 128, nb = r % 128;
            const float* W = p.in(I_W_CKV) + (size_t)l * DM * 4096; bf16_t* WT = (bf16_t*)(p.ws() + WS_WCKV) + (size_t)l * 4096 * DM;
            cvt_item(W + nb * 32 + ln, 4096, DM, WT, scr, kb * 64, nb * 32, c.lane); continue; }
        r -= I_KV;
        if (r < I_GU) { const int e = r / (32 * 128); r %= (32 * 128); const int kb = r / 128, nb = r % 128;
            const int n0 = nb * 32, j = n0 >> 8, half = (n0 >> 7) & 1, f = 128 * j + (n0 & 127) + ln;
            const float* W = (half ? p.in(I_W_UP) : p.in(I_W_GATE)) + ((size_t)l * NE + e) * DM * FF;
            bf16_t* WT = (bf16_t*)(p.ws() + WS_WGU) + ((size_t)l * NE + e) * 4096 * DM;
            cvt_item(W + f, FF, DM, WT, scr, kb * 64, n0, c.lane); continue; }
        r -= I_GU;
        { const int e = r / (32 * 64); r %= (32 * 64); const int kb = r / 64, nb = r % 64;
            const float* W = p.in(I_W_DOWN) + ((size_t)l * NE + e) * FF * DM; bf16_t* WT = (bf16_t*)(p.ws() + WS_WDN) + ((size_t)l * NE + e) * DM * FF;
            cvt_item(W + nb * 32 + ln, DM, FF, WT, scr, kb * 64, nb * 32, c.lane); }
    }
}

__device__ __forceinline__ void row_load_f32(const float* row, int lane, f32x4 (&v)[8]) {
#pragma unroll
    for (int j = 0; j < 8; ++j) v[j] = *(const f32x4*)(row + 256 * j + 4 * lane);
}
__device__ __forceinline__ float row_ssq(const f32x4 (&v)[8]) {
    float s = 0.f;
#pragma unroll
    for (int j = 0; j < 8; ++j) s += (v[j].x * v[j].x + v[j].y * v[j].y) + (v[j].z * v[j].z + v[j].w * v[j].w);
    return wave_sum(s);
}
__device__ __forceinline__ void row_store_bf16(bf16_t* row, int lane, const f32x4 (&v)[8]) {
#pragma unroll
    for (int j = 0; j < 8; ++j) { u32x2 o; o.x = pk2(v[j].x, v[j].y); o.y = pk2(v[j].z, v[j].w); *(u32x2*)(row + 256 * j + 4 * lane) = o; }
}
__device__ __forceinline__ void rmsnorm_row_to_bf16(const float* xrow, const float* gain, bf16_t* orow, int lane) {
    f32x4 v[8]; row_load_f32(xrow, lane, v);
    const float rstd = rsqrtf(row_ssq(v) * (1.f / DM) + RMS_EPS);
#pragma unroll
    for (int j = 0; j < 8; ++j) { const f32x4 g = *(const f32x4*)(gain + 256 * j + 4 * lane); v[j] = v[j] * rstd * g; }
    row_store_bf16(orow, lane, v);
}

__device__ __forceinline__ void ph_pre(const PD& p, const Ctx& c) {
    const int gw = c.bid * NWAVES + c.wave, NGW = c.G * NWAVES;
    for (int m = gw; m < NB * NMEM; m += NGW) rmsnorm_row_to_bf16(p.in(I_MEM) + (size_t)m * DM, p.in(I_MEM_NORM), (bf16_t*)(p.ws() + WS_MEMN) + (size_t)m * DM, c.lane);
    { const f32x4* s = (const f32x4*)p.in(I_X); f32x4* d = (f32x4*)(p.ws() + WS_XRES);
      for (size_t i = (size_t)c.bid * NTHR + c.tid; i < (size_t)NT * DM / 4; i += (size_t)c.G * NTHR) d[i] = s[i]; }
    { float* ct = (float*)(p.ws() + WS_ROT); float* st = ct + SEQ * 64;
      for (int i = c.bid * NTHR + c.tid; i < SEQ * 64; i += c.G * NTHR) { const int pos = i >> 6, k = i & 63;
          const float lin = (float)k / 63.0f; const float inv = 1.0f / powf(10000.0f, lin); const float ang = (float)pos * inv;
          ct[i] = (float)cos((double)ang); st[i] = (float)sin((double)ang); } }
    LAS float* sm = (LAS float*)c.lds;
    for (int u = c.bid; u < DEPTH * SEQ; u += c.G) {
        const int l = u / SEQ, t = u % SEQ;
        const float t01 = (float)t / (float)(SEQ - 1);
        __syncthreads();
        if (c.tid < 17) { float f;
            if (c.tid == 0) f = t01;
            else { const int i = (c.tid - 1) & 7; const float band = 1e-4f + (float)i * ((7.0f - 1e-4f) / 7.0f);
                   const float ang = (2.0f * 3.14159265358979323846f) * ((float)t / (float)SEQ) * band;
                   f = (c.tid <= 8) ? cosf(ang) : -sinf(ang); }
            sm[c.tid] = f; }
        __syncthreads();
        if (c.tid < 64) { const float* w1 = p.in(I_HY_W1) + (size_t)l * 17 * 64; float a = p.in(I_HY_B1)[l * 64 + c.tid];
            for (int i = 0; i < 17; ++i) a += sm[i] * w1[i * 64 + c.tid];
            sm[32 + c.tid] = sinf(p.in(I_HY_FREQ)[l * 64 + c.tid] * a); }
        __syncthreads();
        if (c.tid < 64) { const float* w2 = p.in(I_HY_W2) + (size_t)l * 64 * 64; float a = p.in(I_HY_B2)[l * 64 + c.tid];
            for (int i = 0; i < 64; ++i) a += sm[32 + i] * w2[i * 64 + c.tid];
            sm[96 + c.tid] = sinf(p.in(I_HY_FREQ)[l * 64 + c.tid] * a); }
        __syncthreads();
        const float* w3 = p.in(I_HY_W3) + (size_t)l * 64 * 2048;
        float* kf = (float*)(p.ws() + WS_KF) + (size_t)l * 2 * 512 * 4096;
        const float min_decay = logf(1e-2f) / 1.5f, max_decay = logf(1e-2f) / 0.3f;
        for (int n = c.tid; n < 2048; n += NTHR) {
            float a = 0.f;
            for (int i = 0; i < 64; ++i) a += sm[96 + i] * w3[i * 2048 + n];
            const int o = n >> 10, dir = (n >> 9) & 1, ch = n & 511;
            const float delta = fabsf(min_decay + (max_decay - min_decay) * ((float)ch / 511.0f));
            a *= expf(-t01 * delta);
            float* kc = kf + ((size_t)o * 512 + ch) * 4096;
            if (dir == 0) kc[2048 + t] = a; else { if (t >= 1) kc[2048 - t] = a; else kc[0] = 0.f; }
        }
    }
}

__device__ __forceinline__ void ph_norm(const PD& p, const Ctx& c, const float* gain) {
    const int gw = c.bid * NWAVES + c.wave, NGW = c.G * NWAVES;
    for (int m = gw; m < NT; m += NGW) rmsnorm_row_to_bf16((const float*)(p.ws() + WS_XRES) + (size_t)m * DM, gain, (bf16_t*)(p.ws() + WS_HN) + (size_t)m * DM, c.lane);
}

struct EpiInProj {
    static constexpr bool PERM = true;
    bf16_t* O; const float* rc; const float* rs;
    __device__ __forceinline__ void operator()(const f32x4 (&acc)[2][2][4][2], const pg8::Unit& u, int wr, int wc, int fr, int fq) const {
        const int row0 = u.pm * 256 + wr * 64 + fr, col0 = u.pn * 256 + wc * 32 + 8 * fq;
        const bool rot = (u.pn >= OFF_RQ / 256) && (u.pn < OFF_RV / 256);
        const float qs = (u.pn < OFF_RK / 256) ? 0.08838834764831845f : 1.0f;
#pragma unroll
        for (int ai = 0; ai < 2; ++ai)
#pragma unroll
            for (int m = 0; m < 4; ++m) { const int row = row0 + ai * 128 + m * 16; bf16_t* rowp = O + (size_t)row * PIN + col0;
#pragma unroll
                for (int bj = 0; bj < 2; ++bj) { f32x4 v0 = acc[ai][bj][m][0], v1 = acc[ai][bj][m][1];
                    if (rot) { const int pos = row & (SEQ - 1); const int i0 = ((col0 + bj * 128) & 127) >> 1;
                        const f32x4 cs = *(const f32x4*)(rc + pos * 64 + i0), sn = *(const f32x4*)(rs + pos * 64 + i0);
                        f32x4 r0, r1;
                        r0.x = (v0.x * cs.x - v0.y * sn.x) * qs; r0.y = (v0.x * sn.x + v0.y * cs.x) * qs;
                        r0.z = (v0.z * cs.y - v0.w * sn.y) * qs; r0.w = (v0.z * sn.y + v0.w * cs.y) * qs;
                        r1.x = (v1.x * cs.z - v1.y * sn.z) * qs; r1.y = (v1.x * sn.z + v1.y * cs.z) * qs;
                        r1.z = (v1.z * cs.w - v1.w * sn.w) * qs; r1.w = (v1.z * sn.w + v1.w * cs.w) * qs;
                        v0 = r0; v1 = r1; }
                    u32x4 w; w.x = cvt_pk_bf16(v0.x, v0.y); w.y = cvt_pk_bf16(v0.z, v0.w); w.z = cvt_pk_bf16(v1.x, v1.y); w.w = cvt_pk_bf16(v1.z, v1.w);
                    *(u32x4*)(rowp + bj * 128) = w; } }
    }
};
struct EpiBf16 {
    static constexpr bool PERM = true;
    bf16_t* O; int ldc;
    __device__ __forceinline__ void operator()(const f32x4 (&acc)[2][2][4][2], const pg8::Unit& u, int wr, int wc, int fr, int fq) const {
        const int row0 = u.pm * 256 + wr * 64 + fr, col0 = u.pn * 256 + wc * 32 + 8 * fq;
#pragma unroll
        for (int ai = 0; ai < 2; ++ai)
#pragma unroll
            for (int m = 0; m < 4; ++m) { bf16_t* rowp = O + (size_t)(row0 + ai * 128 + m * 16) * ldc + col0;
#pragma unroll
                for (int bj = 0; bj < 2; ++bj) { const f32x4 v0 = acc[ai][bj][m][0], v1 = acc[ai][bj][m][1];
                    u32x4 w; w.x = cvt_pk_bf16(v0.x, v0.y); w.y = cvt_pk_bf16(v0.z, v0.w); w.z = cvt_pk_bf16(v1.x, v1.y); w.w = cvt_pk_bf16(v1.z, v1.w);
                    *(u32x4*)(rowp + bj * 128) = w; } }
    }
};
struct EpiResid {
    static constexpr bool PERM = false;
    float* X;
    __device__ __forceinline__ void operator()(const f32x4 (&acc)[2][2][4][2], const pg8::Unit& u, int wr, int wc, int fr, int fq) const {
        const int row0 = u.pm * 256 + wr * 64 + fr, col0 = u.pn * 256 + wc * 32 + 4 * fq;
#pragma unroll
        for (int ai = 0; ai < 2; ++ai)
#pragma unroll
            for (int m = 0; m < 4; ++m) { float* rowp = X + (size_t)(row0 + ai * 128 + m * 16) * DM + col0;
#pragma unroll
                for (int bj = 0; bj < 2; ++bj)
#pragma unroll
                    for (int n = 0; n < 2; ++n) { f32x4* q = (f32x4*)(rowp + bj * 128 + n * 16); *q = *q + acc[ai][bj][m][n]; } }
    }
};
struct EpiGU {
    static constexpr bool PERM = true;
    bf16_t* O; int npn;
    __device__ __forceinline__ void operator()(const f32x4 (&acc)[2][2][4][2], const pg8::Unit& u, int wr, int wc, int fr, int fq) const {
        const int row0 = u.pm * 256 + wr * 64 + fr, col0 = (u.pn % npn) * 128 + wc * 32 + 8 * fq;
#pragma unroll
        for (int ai = 0; ai < 2; ++ai)
#pragma unroll
            for (int m = 0; m < 4; ++m) { bf16_t* rowp = O + (size_t)(row0 + ai * 128 + m * 16) * FF + col0;
                float h[8];
#pragma unroll
                for (int n = 0; n < 2; ++n)
#pragma unroll
                    for (int j = 0; j < 4; ++j) { const float a = acc[ai][0][m][n][j], b = acc[ai][1][m][n][j]; h[n * 4 + j] = a / (1.0f + __expf(-a)) * b; }
                u32x4 w; w.x = cvt_pk_bf16(h[0], h[1]); w.y = cvt_pk_bf16(h[2], h[3]); w.z = cvt_pk_bf16(h[4], h[5]); w.w = cvt_pk_bf16(h[6], h[7]);
                *(u32x4*)rowp = w; }
    }
};
struct EpiDown {
    static constexpr bool PERM = false;
    float* Y; int npn;
    __device__ __forceinline__ void operator()(const f32x4 (&acc)[2][2][4][2], const pg8::Unit& u, int wr, int wc, int fr, int fq) const {
        const int row0 = u.pm * 256 + wr * 64 + fr, col0 = (u.pn % npn) * 256 + wc * 32 + 4 * fq;
#pragma unroll
        for (int ai = 0; ai < 2; ++ai)
#pragma unroll
            for (int m = 0; m < 4; ++m) { float* rowp = Y + (size_t)(row0 + ai * 128 + m * 16) * DM + col0;
#pragma unroll
                for (int bj = 0; bj < 2; ++bj)
#pragma unroll
                    for (int n = 0; n < 2; ++n) *(f32x4*)(rowp + bj * 128 + n * 16) = acc[ai][bj][m][n]; }
    }
};

__device__ __forceinline__ void ph_na(const PD& p, const Ctx& c, int l) {
    const bf16_t* proj = (const bf16_t*)(p.ws() + WS_PROJ); bf16_t* ycat = (bf16_t*)(p.ws() + WS_YCAT);
    LAS float* Pm = (LAS float*)c.lds;
    const float* rpb = p.in(I_NA_RPB) + (size_t)l * NAH * 15 * 31;
    for (int u = c.bid; u < NB * ROWS * NAH; u += c.G) {
        const int h = u % NAH, r = (u / NAH) % ROWS, b = u / (NAH * ROWS);
        const int qc = c.tid >> 3, sub = c.tid & 7;
        const int rs = min(max(r - 4, 0), ROWS - 8), cs = min(max(qc - 8, 0), GW - 16);
        const int tok = b * SEQ + r * GW + qc;
        float q[64];
        { const u32x4* qp = (const u32x4*)(proj + (size_t)tok * PIN + OFF_NAQ + h * 64);
#pragma unroll
          for (int i = 0; i < 8; ++i) { float f[8]; unpack8(qp[i], f);
#pragma unroll
              for (int j = 0; j < 8; ++j) q[i * 8 + j] = f[j] * 0.125f; } }
        const int krow = rs + sub;
        float s[16]; float mx = -INFINITY;
#pragma unroll
        for (int j = 0; j < 16; ++j) { const int kc = cs + j; const u32x4* kp = (const u32x4*)(proj + (size_t)(b * SEQ + krow * GW + kc) * PIN + OFF_NAK + h * 64);
            float d = 0.f;
#pragma unroll
            for (int i = 0; i < 8; ++i) { float f[8]; unpack8(kp[i], f);
#pragma unroll
                for (int jj = 0; jj < 8; ++jj) d += q[i * 8 + jj] * f[jj]; }
            s[j] = d + rpb[(h * 15 + (krow - r + 7)) * 31 + (kc - qc + 15)]; mx = fmaxf(mx, s[j]); }
        mx = fmaxf(mx, __shfl_xor(mx, 1)); mx = fmaxf(mx, __shfl_xor(mx, 2)); mx = fmaxf(mx, __shfl_xor(mx, 4));
        float sum = 0.f;
#pragma unroll
        for (int j = 0; j < 16; ++j) { s[j] = __expf(s[j] - mx); sum += s[j]; }
        sum += __shfl_xor(sum, 1); sum += __shfl_xor(sum, 2); sum += __shfl_xor(sum, 4);
        const float inv = 1.0f / sum;
        __syncthreads();
#pragma unroll
        for (int j = 0; j < 16; ++j) Pm[qc * 129 + sub * 16 + j] = s[j] * inv;
        __syncthreads();
        float o[8];
#pragma unroll
        for (int i = 0; i < 8; ++i) o[i] = 0.f;
        for (int key = 0; key < 128; ++key) { const int kr = rs + (key >> 4), kc = cs + (key & 15);
            const u32x4 vv = *(const u32x4*)(proj + (size_t)(b * SEQ + kr * GW + kc) * PIN + OFF_NAV + h * 64 + sub * 8);
            float f[8]; unpack8(vv, f); const float pr = Pm[qc * 129 + key];
#pragma unroll
            for (int i = 0; i < 8; ++i) o[i] += pr * f[i]; }
        u32x4 w; w.x = pk2(o[0], o[1]); w.y = pk2(o[2], o[3]); w.z = pk2(o[4], o[5]); w.w = pk2(o[6], o[7]);
        *(u32x4*)(ycat + (size_t)tok * DM + h * 64 + sub * 8) = w;
    }
}

__device__ __forceinline__ void ph_hypre(const PD& p, const Ctx& c, int l) {
    const bf16_t* proj = (const bf16_t*)(p.ws() + WS_PROJ); float* hs = (float*)(p.ws() + WS_HS);
    LAS float* U = (LAS float*)c.lds;
    const float* cw = p.in(I_HY_CONV_W) + (size_t)l * 3 * 1536; const float* cb = p.in(I_HY_CONV_B) + (size_t)l * 1536;
    for (int u = c.bid; u < NB * 32 * 24; u += c.G) {
        const int cg = u % 24, tt = (u / 24) % 32, b = u / (24 * 32); const int t0 = tt * 64;
        __syncthreads();
        for (int idx = c.tid; idx < 66 * 64; idx += NTHR) { const int rr = idx >> 6, cc = idx & 63; const int t = t0 - 1 + rr;
            U[rr * 65 + cc] = (t >= 0 && t < SEQ) ? bf2f(proj[(size_t)(b * SEQ + t) * PIN + OFF_HY + cg * 64 + cc]) : 0.f; }
        __syncthreads();
        for (int idx = c.tid; idx < 64 * 64; idx += NTHR) { const int tl = idx & 63, cc = idx >> 6; const int ch = cg * 64 + cc;
            const float s = U[tl * 65 + cc] * cw[ch] + U[(tl + 1) * 65 + cc] * cw[1536 + ch] + U[(tl + 2) * 65 + cc] * cw[3072 + ch] + cb[ch];
            hs[((size_t)b * 1536 + ch) * SEQ + t0 + tl] = s; }
    }
}

__device__ __forceinline__ void ph_hyconv(const PD& p, const Ctx& c, int l) {
    const float* hs = (const float*)(p.ws() + WS_HS); bf16_t* ycat = (bf16_t*)(p.ws() + WS_YCAT);
    LAS float* kf = (LAS float*)c.lds;
    LAS float* z = kf + 4096;
    for (int u = c.bid; u < NB * HYW; u += c.G) {
        const int ch = u % HYW, b = u / HYW;
        __syncthreads();
        for (int t = c.tid; t < SEQ; t += NTHR) z[t] = hs[((size_t)b * 1536 + 1024 + ch) * SEQ + t];
        for (int o = 0; o < 2; ++o) {
            const float* kg = (const float*)(p.ws() + WS_KF) + (((size_t)l * 2 + o) * 512 + ch) * 4096;
            for (int i = c.tid; i < 4096; i += NTHR) kf[i] = kg[i];
            __syncthreads();
            float acc[4] = {0.f, 0.f, 0.f, 0.f};
            for (int s = 0; s < SEQ; ++s) { const float zs = z[s];
#pragma unroll
                for (int q = 0; q < 4; ++q) acc[q] += kf[2048 + c.tid + 512 * q - s] * zs; }
            const float sd = p.in(I_HY_SKIP)[((size_t)l * 2 + o) * HYW + ch];
            float zn[4];
#pragma unroll
            for (int q = 0; q < 4; ++q) { const int t = c.tid + 512 * q; const float gate = hs[((size_t)b * 1536 + o * 512 + ch) * SEQ + t]; zn[q] = gate * (acc[q] + sd * z[t]); }
            __syncthreads();
#pragma unroll
            for (int q = 0; q < 4; ++q) z[c.tid + 512 * q] = zn[q];
            __syncthreads();
        }
        for (int t = c.tid; t < SEQ; t += NTHR) ycat[(size_t)(b * SEQ + t) * DM + NAW + ch] = (bf16_t)f2bf(z[t]);
    }
}

__device__ __forceinline__ void ph_ret(const PD& p, const Ctx& c, int l) {
    const bf16_t* proj = (const bf16_t*)(p.ws() + WS_PROJ); bf16_t* ycat = (bf16_t*)(p.ws() + WS_YCAT);
    LAS float* Q = (LAS float*)c.lds;
    LAS float* Kc = Q + 64 * 129;
    LAS float* Vc = Kc + 64 * 129;
    LAS float* W = Vc + 64 * 128;
    for (int u = c.bid; u < NB * RETH * 32; u += c.G) {
        const int qt = u % 32, h = (u / 32) % RETH, b = u / (32 * RETH); const int t0 = qt * 64;
        const float lgf = log1pf(-exp2f(-5.0f - (float)h)), lgb = log1pf(-exp2f(-5.5f - (float)h));
        __syncthreads();
        for (int idx = c.tid; idx < 64 * 128; idx += NTHR) { const int i = idx >> 7, d = idx & 127; Q[i * 129 + d] = bf2f(proj[(size_t)(b * SEQ + t0 + i) * PIN + OFF_RQ + h * 128 + d]); }
        const int i = c.tid >> 3, g = c.tid & 7;
        float y[16];
#pragma unroll
        for (int e = 0; e < 16; ++e) y[e] = 0.f;
        for (int kc = 0; kc < 32; ++kc) { const int s0 = kc * 64;
            __syncthreads();
            for (int idx = c.tid; idx < 64 * 128; idx += NTHR) { const int j = idx >> 7, d = idx & 127; const size_t rb = (size_t)(b * SEQ + s0 + j) * PIN + h * 128 + d;
                Kc[j * 129 + d] = bf2f(proj[rb + OFF_RK]); Vc[j * 128 + d] = bf2f(proj[rb + OFF_RV]); }
            __syncthreads();
#pragma unroll 2
            for (int jj = 0; jj < 8; ++jj) { const int j = g + 8 * jj; float d = 0.f;
                for (int k = 0; k < 128; ++k) d += Q[i * 129 + k] * Kc[j * 129 + k];
                const int diff = (t0 + i) - (s0 + j);
                const float dec = diff >= 0 ? __expf(lgf * (float)diff) : __expf(lgb * (float)(-diff));
                W[i * 65 + j] = d * dec; }
            __syncthreads();
            for (int j = 0; j < 64; ++j) { const float w = W[i * 65 + j];
#pragma unroll
                for (int e = 0; e < 16; ++e) y[e] += w * Vc[j * 128 + g * 16 + e]; }
        }
        float s = 0.f;
#pragma unroll
        for (int e = 0; e < 16; ++e) s += y[e];
        s += __shfl_xor(s, 1); s += __shfl_xor(s, 2); s += __shfl_xor(s, 4);
        const float mu = s * (1.f / 128.f); float v2 = 0.f;
#pragma unroll
        for (int e = 0; e < 16; ++e) { y[e] -= mu; v2 += y[e] * y[e]; }
        v2 += __shfl_xor(v2, 1); v2 += __shfl_xor(v2, 2); v2 += __shfl_xor(v2, 4);
        const float rstd = rsqrtf(v2 * (1.f / 128.f) + GN_EPS);
        const size_t tok = (size_t)(b * SEQ + t0 + i);
        float gt[16]; { const u32x4* gp = (const u32x4*)(proj + tok * PIN + OFF_RG + h * 128 + g * 16); float f0[8], f1[8]; unpack8(gp[0], f0); unpack8(gp[1], f1);
#pragma unroll
            for (int e = 0; e < 8; ++e) { gt[e] = f0[e]; gt[8 + e] = f1[e]; } }
        unsigned w[8];
#pragma unroll
        for (int e = 0; e < 8; ++e) { const float a0 = gt[2 * e], a1 = gt[2 * e + 1];
            w[e] = pk2(y[2 * e] * rstd * (a0 / (1.0f + __expf(-a0))), y[2 * e + 1] * rstd * (a1 / (1.0f + __expf(-a1)))); }
        u32x4* op = (u32x4*)(ycat + tok * DM + NAW + HYW + h * 128 + g * 16);
        op[0] = (u32x4){w[0], w[1], w[2], w[3]}; op[1] = (u32x4){w[4], w[5], w[6], w[7]};
    }
}

__device__ __forceinline__ void ph_gnorm(const PD& p, const Ctx& c, int l) {
    const int gw = c.bid * NWAVES + c.wave, NGW = c.G * NWAVES;
    const float* gain = p.in(I_BRANCH_NORM) + (size_t)l * DM;
    for (int m = gw; m < NT; m += NGW) {
        const bf16_t* yr = (const bf16_t*)(p.ws() + WS_YCAT) + (size_t)m * DM; bf16_t* orow = (bf16_t*)(p.ws() + WS_YN) + (size_t)m * DM;
        float v[4][8]; float ss[3] = {0.f, 0.f, 0.f};
#pragma unroll
        for (int j = 0; j < 4; ++j) { const int e0 = 512 * j + 8 * c.lane; unpack8(*(const u32x4*)(yr + e0), v[j]);
            float s = 0.f;
#pragma unroll
            for (int i = 0; i < 8; ++i) s += v[j][i] * v[j][i];
            const int grp = e0 < NAW ? 0 : (e0 < NAW + HYW ? 1 : 2);
            ss[0] += grp == 0 ? s : 0.f; ss[1] += grp == 1 ? s : 0.f; ss[2] += grp == 2 ? s : 0.f; }
        const float r0 = rsqrtf(wave_sum(ss[0]) * (1.f / NAW) + RMS_EPS), r1 = rsqrtf(wave_sum(ss[1]) * (1.f / HYW) + RMS_EPS), r2 = rsqrtf(wave_sum(ss[2]) * (1.f / RETW) + RMS_EPS);
#pragma unroll
        for (int j = 0; j < 4; ++j) { const int e0 = 512 * j + 8 * c.lane; const float rr = e0 < NAW ? r0 : (e0 < NAW + HYW ? r1 : r2);
            const f32x4 g0 = *(const f32x4*)(gain + e0), g1 = *(const f32x4*)(gain + e0 + 4);
            u32x4 w; w.x = pk2(v[j][0] * rr * g0.x, v[j][1] * rr * g0.y); w.y = pk2(v[j][2] * rr * g0.z, v[j][3] * rr * g0.w);
            w.z = pk2(v[j][4] * rr * g1.x, v[j][5] * rr * g1.y); w.w = pk2(v[j][6] * rr * g1.z, v[j][7] * rr * g1.w);
            *(u32x4*)(orow + e0) = w; }
    }
}

__device__ __forceinline__ void ph_xatt(const PD& p, const Ctx& c, int l) {
    const bf16_t* qc = (const bf16_t*)(p.ws() + WS_QC); const bf16_t* kv = (const bf16_t*)(p.ws() + WS_KVC) + (size_t)l * 1024 * 4096; bf16_t* oc = (bf16_t*)(p.ws() + WS_OC);
    LAS float* S = (LAS float*)c.lds;
    for (int u = c.bid; u < NB * XH * 32; u += c.G) {
        const int qt = u % 32, h = (u / 32) % XH, b = u / (32 * XH);
        const int i = c.tid >> 3, g = c.tid & 7; const size_t tok = (size_t)b * SEQ + qt * 64 + i;
        float acc[32];
#pragma unroll
        for (int jj = 0; jj < 32; ++jj) acc[jj] = 0.f;
        const u32x4* qp = (const u32x4*)(qc + tok * DM + h * XD);
        for (int dc = 0; dc < 64; ++dc) { float qf[8]; unpack8(qp[dc], qf);
#pragma unroll
            for (int jj = 0; jj < 32; ++jj) { const int j = g + 8 * jj; float kf[8]; unpack8(*(const u32x4*)(kv + (size_t)(b * NMEM + j) * 4096 + h * XD + dc * 8), kf);
#pragma unroll
                for (int e = 0; e < 8; ++e) acc[jj] += qf[e] * kf[e]; } }
        float mx = -INFINITY;
#pragma unroll
        for (int jj = 0; jj < 32; ++jj) { acc[jj] *= 0.04419417382415922f; mx = fmaxf(mx, acc[jj]); }
        mx = fmaxf(mx, __shfl_xor(mx, 1)); mx = fmaxf(mx, __shfl_xor(mx, 2)); mx = fmaxf(mx, __shfl_xor(mx, 4));
        float sum = 0.f;
#pragma unroll
        for (int jj = 0; jj < 32; ++jj) { acc[jj] = __expf(acc[jj] - mx); sum += acc[jj]; }
        sum += __shfl_xor(sum, 1); sum += __shfl_xor(sum, 2); sum += __shfl_xor(sum, 4);
        const float inv = 1.0f / sum;
        __syncthreads();
#pragma unroll
        for (int jj = 0; jj < 32; ++jj) S[i * 257 + g + 8 * jj] = acc[jj] * inv;
        __syncthreads();
        float o[64];
#pragma unroll
        for (int e = 0; e < 64; ++e) o[e] = 0.f;
        for (int j = 0; j < NMEM; ++j) { const float pr = S[i * 257 + j]; const u32x4* vp = (const u32x4*)(kv + (size_t)(b * NMEM + j) * 4096 + 2048 + h * XD + g * 64);
#pragma unroll
            for (int cc = 0; cc < 8; ++cc) { float vf[8]; unpack8(vp[cc], vf);
#pragma unroll
                for (int e = 0; e < 8; ++e) o[cc * 8 + e] += pr * vf[e]; } }
        u32x4* op = (u32x4*)(oc + tok * DM + h * XD + g * 64);
#pragma unroll
        for (int cc = 0; cc < 8; ++cc) { u32x4 w; w.x = pk2(o[cc * 8 + 0], o[cc * 8 + 1]); w.y = pk2(o[cc * 8 + 2], o[cc * 8 + 3]); w.z = pk2(o[cc * 8 + 4], o[cc * 8 + 5]); w.w = pk2(o[cc * 8 + 6], o[cc * 8 + 7]); op[cc] = w; }
    }
}

__device__ __forceinline__ void ph_router(const PD& p, const Ctx& c, int l) {
    const int gw = c.bid * NWAVES + c.wave, NGW = c.G * NWAVES;
    const float* gain = p.in(I_NORM_MOE) + (size_t)l * DM + 32 * c.lane; const float* wr = p.in(I_W_ROUTER) + (size_t)l * DM * NE + (size_t)(32 * c.lane) * NE;
    for (int m = gw; m < NT; m += NGW) {
        const float* xr = (const float*)(p.ws() + WS_XRES) + (size_t)m * DM + 32 * c.lane;
        f32x4 v[8]; float ss = 0.f;
#pragma unroll
        for (int j = 0; j < 8; ++j) { v[j] = *(const f32x4*)(xr + 4 * j); ss += (v[j].x * v[j].x + v[j].y * v[j].y) + (v[j].z * v[j].z + v[j].w * v[j].w); }
        const float rstd = rsqrtf(wave_sum(ss) * (1.f / DM) + RMS_EPS);
        float lg[16];
#pragma unroll
        for (int e = 0; e < 16; ++e) lg[e] = 0.f;
#pragma unroll
        for (int j = 0; j < 8; ++j) { const f32x4 g = *(const f32x4*)(gain + 4 * j); v[j] = v[j] * rstd * g;
#pragma unroll
            for (int q = 0; q < 4; ++q) { const float hv = v[j][q]; const f32x4* wp = (const f32x4*)(wr + (4 * j + q) * NE);
#pragma unroll
                for (int e4 = 0; e4 < 4; ++e4) { const f32x4 w = wp[e4]; lg[e4 * 4 + 0] += hv * w.x; lg[e4 * 4 + 1] += hv * w.y; lg[e4 * 4 + 2] += hv * w.z; lg[e4 * 4 + 3] += hv * w.w; } } }
        { bf16_t* orow = (bf16_t*)(p.ws() + WS_HN) + (size_t)m * DM + 32 * c.lane;
#pragma unroll
          for (int j = 0; j < 4; ++j) { u32x4 o; o.x = pk2(v[2 * j].x, v[2 * j].y); o.y = pk2(v[2 * j].z, v[2 * j].w); o.z = pk2(v[2 * j + 1].x, v[2 * j + 1].y); o.w = pk2(v[2 * j + 1].z, v[2 * j + 1].w);
              *(u32x4*)(orow + 8 * j) = o; } }
        float mx = -INFINITY;
#pragma unroll
        for (int e = 0; e < 16; ++e) { lg[e] = wave_sum(lg[e]); mx = fmaxf(mx, lg[e]); }
        float sum = 0.f;
#pragma unroll
        for (int e = 0; e < 16; ++e) { lg[e] = expf(lg[e] - mx); sum += lg[e]; }
        if (c.lane < 16) { float a = 0.f;
#pragma unroll
            for (int e = 0; e < 16; ++e) a = (c.lane == e) ? lg[e] : a;
            ((float*)(p.ws() + WS_AFF))[(size_t)m * NE + c.lane] = a / sum; }
    }
}

__device__ __forceinline__ void ph_topk(const PD& p, const Ctx& c) {
    LAS float* a = (LAS float*)c.lds;
    const float* aff = (const float*)(p.ws() + WS_AFF); int* idx = (int*)(p.ws() + WS_IDX); float* gs = (float*)(p.ws() + WS_GSEL); int* inv = (int*)(p.ws() + WS_INV);
    for (int u = c.bid; u < NB * NE; u += c.G) {
        const int e = u % NE, b = u / NE;
        __syncthreads();
        for (int t = c.tid; t < SEQ; t += NTHR) a[t] = aff[(size_t)(b * SEQ + t) * NE + e];
        __syncthreads();
        for (int q = 0; q < 4; ++q) { const int i = c.tid + 512 * q; const float ai = a[i]; int rank = 0;
            for (int j = 0; j < SEQ; ++j) { const float aj = a[j]; rank += (aj > ai || (aj == ai && j < i)) ? 1 : 0; }
            if (rank < CAP) { idx[(b * NE + e) * CAP + rank] = i; gs[(b * NE + e) * CAP + rank] = ai; inv[(size_t)(b * SEQ + i) * NE + e] = rank; }
            else inv[(size_t)(b * SEQ + i) * NE + e] = -1; }
    }
}

__device__ __forceinline__ void ph_gather(const PD& p, const Ctx& c) {
    const int gw = c.bid * NWAVES + c.wave, NGW = c.G * NWAVES;
    const int* idx = (const int*)(p.ws() + WS_IDX);
    for (int r = gw; r < NE * NB * CAP; r += NGW) { const int e = r / (NB * CAP), b = (r / CAP) % NB, slot = r % CAP;
        const int t = idx[(b * NE + e) * CAP + slot];
        const u32x4* s = (const u32x4*)((const bf16_t*)(p.ws() + WS_HN) + (size_t)(b * SEQ + t) * DM); u32x4* d = (u32x4*)((bf16_t*)(p.ws() + WS_XE) + (size_t)r * DM);
#pragma unroll
        for (int j = 0; j < 4; ++j) d[64 * j + c.lane] = s[64 * j + c.lane]; }
}

__device__ __forceinline__ void ph_combine(const PD& p, const Ctx& c, int l) {
    const int gw = c.bid * NWAVES + c.wave, NGW = c.G * NWAVES;
    const int* inv = (const int*)(p.ws() + WS_INV); const float* gs = (const float*)(p.ws() + WS_GSEL); const float* ym = (const float*)(p.ws() + WS_YMOE);
    for (int m = gw; m < NT; m += NGW) { const int b = m / SEQ;
        float* xr = (float*)(p.ws() + WS_XRES) + (size_t)m * DM;
        f32x4 v[8]; row_load_f32(xr, c.lane, v);
        for (int e = 0; e < NE; ++e) { const int slot = inv[(size_t)m * NE + e];
            if (slot >= 0) { const float g = gs[(b * NE + e) * CAP + slot]; const float* yr = ym + ((size_t)e * 1024 + b * CAP + slot) * DM;
#pragma unroll
                for (int j = 0; j < 8; ++j) v[j] = v[j] + g * *(const f32x4*)(yr + 256 * j + 4 * c.lane); } }
        if (l == DEPTH - 1) { const float rstd = rsqrtf(row_ssq(v) * (1.f / DM) + RMS_EPS); float* orow = p.out() + (size_t)m * DM; const float* gain = p.in(I_FINAL_NORM);
#pragma unroll
            for (int j = 0; j < 8; ++j) *(f32x4*)(orow + 256 * j + 4 * c.lane) = v[j] * rstd * *(const f32x4*)(gain + 256 * j + 4 * c.lane); }
        else {
#pragma unroll
            for (int j = 0; j < 8; ++j) *(f32x4*)(xr + 256 * j + 4 * c.lane) = v[j]; }
    }
}
template <int PH> __device__ __forceinline__ void run_phase(const Ctx& c_in, int l) {
    asm volatile("; PHASE_MARK %0" :: "n"(PH));
    Ctx c = c_in; { int tz = c_in.tid; asm volatile("" : "+v"(tz)); c.tid = tz; c.lane = tz & 63; }
    PD p; { KArgQ q = (KArgQ)__builtin_amdgcn_kernarg_segment_ptr(); asm volatile("" : "+s"(q)); p.q = q; }
    unsigned char* ws = p.ws();
    if constexpr (PH == PH_CVT) ph_cvt(p, c);
    else if constexpr (PH == PH_PRE) ph_pre(p, c);
    else if constexpr (PH == PH_NORM1) ph_norm(p, c, p.in(I_NORM_MIX) + (size_t)l * DM);
    else if constexpr (PH == PH_NORM2) ph_norm(p, c, p.in(I_NORM_CROSS) + (size_t)l * DM);
    else if constexpr (PH == PH_INPROJ) {
        pg8::Gemm g{(const bf16_t*)(ws + WS_HN), (const bf16_t*)(ws + WS_WIN) + (size_t)l * PIN * DM, DM};
        pg8::StaticOrder S; S.init(NT, PIN, c.G, c.bid);
        EpiInProj E{(bf16_t*)(ws + WS_PROJ), (const float*)(ws + WS_ROT), (const float*)(ws + WS_ROT) + SEQ * 64};
        pg8::gemm_phase(c.lds, c.tid, g, S, E);
    }
    else if constexpr (PH == PH_NA) ph_na(p, c, l);
    else if constexpr (PH == PH_HYPRE) ph_hypre(p, c, l);
    else if constexpr (PH == PH_HYCONV) ph_hyconv(p, c, l);
    else if constexpr (PH == PH_RET) ph_ret(p, c, l);
    else if constexpr (PH == PH_GNORM) ph_gnorm(p, c, l);
    else if constexpr (PH == PH_OUT) {
        pg8::Gemm g{(const bf16_t*)(ws + WS_YN), (const bf16_t*)(ws + WS_WOUT) + (size_t)l * DM * DM, DM};
        pg8::StaticOrder S; S.init(NT, DM, c.G, c.bid);
        EpiResid E{(float*)(ws + WS_XRES)};
        pg8::gemm_phase(c.lds, c.tid, g, S, E);
    }
    else if constexpr (PH == PH_CQ) {
        pg8::Gemm g{(const bf16_t*)(ws + WS_HN), (const bf16_t*)(ws + WS_WCQ) + (size_t)l * DM * DM, DM};
        pg8::StaticOrder S; S.init(NT, DM, c.G, c.bid);
        EpiBf16 E{(bf16_t*)(ws + WS_QC), DM};
        pg8::gemm_phase(c.lds, c.tid, g, S, E);
    }
    else if constexpr (PH == PH_CKV) {
        pg8::Gemm g{(const bf16_t*)(ws + WS_MEMN), (const bf16_t*)(ws + WS_WCKV) + (size_t)l * 4096 * DM, DM};
        pg8::StaticOrder S; S.init(NB * NMEM, 4096, c.G, c.bid);
        EpiBf16 E{(bf16_t*)(ws + WS_KVC) + (size_t)l * 1024 * 4096, 4096};
        pg8::gemm_phase(c.lds, c.tid, g, S, E);
    }
    else if constexpr (PH == PH_XATT) ph_xatt(p, c, l);
    else if constexpr (PH == PH_CO) {
        pg8::Gemm g{(const bf16_t*)(ws + WS_OC), (const bf16_t*)(ws + WS_WCO) + (size_t)l * DM * DM, DM};
        pg8::StaticOrder S; S.init(NT, DM, c.G, c.bid);
        EpiResid E{(float*)(ws + WS_XRES)};
        pg8::gemm_phase(c.lds, c.tid, g, S, E);
    }
    else if constexpr (PH == PH_ROUTER) ph_router(p, c, l);
    else if constexpr (PH == PH_TOPK) ph_topk(p, c);
    else if constexpr (PH == PH_GATHER) ph_gather(p, c);
    else if constexpr (PH == PH_GU) {
        pg8::Gemm g{(const bf16_t*)(ws + WS_XE), (const bf16_t*)(ws + WS_WGU) + (size_t)l * NE * 4096 * DM, DM};
        pg8::MoeOrder S; S.init(16, c.G, c.bid);
        EpiGU E{(bf16_t*)(ws + WS_ACT), 16};
        pg8::gemm_phase(c.lds, c.tid, g, S, E);
    }
    else if constexpr (PH == PH_DOWN) {
        pg8::Gemm g{(const bf16_t*)(ws + WS_ACT), (const bf16_t*)(ws + WS_WDN) + (size_t)l * NE * DM * FF, FF};
        pg8::MoeOrder S; S.init(8, c.G, c.bid);
        EpiDown E{(float*)(ws + WS_YMOE), 8};
        pg8::gemm_phase(c.lds, c.tid, g, S, E);
    }
    else if constexpr (PH == PH_COMBINE) ph_combine(p, c, l);
}

__global__ void __launch_bounds__(NTHR, 2) mega_fwd(P p) {
    extern __shared__ __attribute__((aligned(16))) unsigned char lds_raw[];
    Ctx c; c.tid = threadIdx.x; c.lane = c.tid & 63; c.wave = __builtin_amdgcn_readfirstlane(c.tid >> 6); c.G = gridDim.x; c.bid = blockIdx.x; c.lds = (LAS unsigned char*)lds_raw;
    volatile LAS unsigned* st = (volatile LAS unsigned*)(c.lds + LDS_BYTES - 16);
    if (c.tid < 4) st[c.tid] = 0u;
    __syncthreads();
    XcdBarrier bar = xcd_barrier_post((unsigned*)(p.ws + WS_CTL), st);
#define GRID_BAR() xcd_barrier(bar)
    run_phase<PH_CVT>(c, 0);
    run_phase<PH_PRE>(c, 0);
    GRID_BAR();
    run_phase<PH_NORM1>(c, 0);
    GRID_BAR();
    for (int l = 0; l < DEPTH; ++l) {
        run_phase<PH_INPROJ>(c, l);
        run_phase<PH_CKV>(c, l);
        GRID_BAR();
        run_phase<PH_HYPRE>(c, l);
        run_phase<PH_NA>(c, l);
        GRID_BAR();
        run_phase<PH_HYCONV>(c, l);
        run_phase<PH_RET>(c, l);
        GRID_BAR();
        run_phase<PH_GNORM>(c, l);
        GRID_BAR();
        run_phase<PH_OUT>(c, l);
        GRID_BAR();
        run_phase<PH_NORM2>(c, l);
        GRID_BAR();
        run_phase<PH_CQ>(c, l);
        GRID_BAR();
        run_phase<PH_XATT>(c, l);
        GRID_BAR();
        run_phase<PH_CO>(c, l);
        GRID_BAR();
        run_phase<PH_ROUTER>(c, l);
        GRID_BAR();
        run_phase<PH_TOPK>(c, l);
        GRID_BAR();
        run_phase<PH_GATHER>(c, l);
        GRID_BAR();
        run_phase<PH_GU>(c, l);
        GRID_BAR();
        run_phase<PH_DOWN>(c, l);
        GRID_BAR();
        run_phase<PH_COMBINE>(c, l);
        if (l + 1 < DEPTH) { run_phase<PH_NORM1>(c, l + 1); GRID_BAR(); }
    }
}

extern "C" void kernel_launch(void* const* d_in, const int* in_sizes, int n_in, void* d_out, int out_size, void* d_ws, size_t ws_size, hipStream_t stream) {
    if (n_in != N_IN || out_size != NT * DM || ws_size < WS_END) { fprintf(stderr, "kernel_launch: unexpected shapes (n_in %d, out %d, ws %zu < %zu); nothing launched\n", n_in, out_size, ws_size, (size_t)WS_END); return; }
    static int grid = 0;
    if (!grid) {
        int dev = 0, cus = 0, per_cu = 0;
        if (hipGetDevice(&dev) != hipSuccess || hipDeviceGetAttribute(&cus, hipDeviceAttributeMultiprocessorCount, dev) != hipSuccess) { fprintf(stderr, "kernel_launch: device query failed\n"); return; }
        if (hipFuncSetAttribute((const void*)mega_fwd, hipFuncAttributeMaxDynamicSharedMemorySize, LDS_BYTES) != hipSuccess) { fprintf(stderr, "kernel_launch: hipFuncSetAttribute failed\n"); return; }
        if (hipOccupancyMaxActiveBlocksPerMultiprocessor(&per_cu, (const void*)mega_fwd, NTHR, LDS_BYTES) != hipSuccess || per_cu < 1) fprintf(stderr, "kernel_launch: occupancy query reports %d workgroups per CU\n", per_cu);
        grid = cus;
    }
    P p{};
    for (int i = 0; i < N_IN; ++i) p.in[i] = (const float*)d_in[i];
    p.out = (float*)d_out; p.ws = (unsigned char*)d_ws;
    if (hipMemsetAsync((char*)d_ws + WS_CTL, 0, XCD_BAR_WORDS * sizeof(unsigned), stream) != hipSuccess) { fprintf(stderr, "kernel_launch: memset failed\n"); return; }
    hipLaunchKernelGGL(mega_fwd, dim3(grid), dim3(NTHR), LDS_BYTES, stream, p);
    hipError_t le = hipGetLastError();
    if (le != hipSuccess) fprintf(stderr, "kernel_launch: launch failed: %s\n", hipGetErrorName(le));
}
```

```cpp
#include <hip/hip_runtime.h>
#include <cstdio>
#include <cstdint>
#include <cmath>

#define LAS __attribute__((address_space(3)))
#define GAS __attribute__((address_space(1)))
typedef unsigned short bf16_t;
typedef short bf16x8 __attribute__((ext_vector_type(8)));
typedef float f32x4 __attribute__((ext_vector_type(4)));
typedef float f32x2 __attribute__((ext_vector_type(2)));
typedef unsigned u32x4 __attribute__((ext_vector_type(4)));
typedef unsigned u32x2 __attribute__((ext_vector_type(2)));

constexpr int NB = 4, SEQ = 2048, DM = 2048, NT = NB * SEQ, DEPTH = 2;
constexpr int NMEM = 256, GW = 64, ROWS = SEQ / GW;
constexpr int NAW = 768, NAH = 12, NADH = 64;
constexpr int HYW = 512, HYFF = 64;
constexpr int RETW = 768, RETH = 6, RETD = 128;
constexpr int PIN = 6912;
constexpr int OFF_NAQ = 0, OFF_NAK = 768, OFF_NAV = 1536, OFF_HY = 2304, OFF_RQ = 3840, OFF_RK = 4608, OFF_RV = 5376, OFF_RG = 6144;
constexpr int XH = 4, XD = 512;
constexpr int NE = 16, FF = 2048, CAP = 256;
constexpr float RMS_EPS = 1e-6f, GN_EPS = 1e-5f;

enum { I_X = 0, I_MEM, I_NORM_MIX, I_W_IN, I_NA_RPB, I_HY_CONV_W, I_HY_CONV_B, I_HY_W1, I_HY_B1, I_HY_W2, I_HY_B2, I_HY_W3, I_HY_FREQ, I_HY_SKIP,
       I_BRANCH_NORM, I_W_OUT, I_NORM_CROSS, I_MEM_NORM, I_W_CQ, I_W_CKV, I_W_CO, I_NORM_MOE, I_W_ROUTER, I_W_GATE, I_W_UP, I_W_DOWN, I_FINAL_NORM, N_IN };

constexpr size_t MiB = (size_t)1 << 20;
constexpr size_t WS_CTL   = 0;
constexpr size_t WS_XRES  = 1 * MiB;
constexpr size_t WS_HN    = WS_XRES + 64 * MiB;
constexpr size_t WS_PROJ  = WS_HN + 32 * MiB;
constexpr size_t WS_YCAT  = WS_PROJ + 108 * MiB;
constexpr size_t WS_YN    = WS_YCAT + 32 * MiB;
constexpr size_t WS_QC    = WS_YN + 32 * MiB;
constexpr size_t WS_KVC   = WS_QC + 32 * MiB;
constexpr size_t WS_OC    = WS_KVC + 16 * MiB;
constexpr size_t WS_MEMN  = WS_OC + 32 * MiB;
constexpr size_t WS_AFF   = WS_MEMN + 4 * MiB;
constexpr size_t WS_IDX   = WS_AFF + 1 * MiB;
constexpr size_t WS_GSEL  = WS_IDX + 1 * MiB;
constexpr size_t WS_INV   = WS_GSEL + 1 * MiB;
constexpr size_t WS_XE    = WS_INV + 1 * MiB;
constexpr size_t WS_ACT   = WS_XE + 64 * MiB;
constexpr size_t WS_YMOE  = WS_ACT + 64 * MiB;
constexpr size_t WS_ROT   = WS_YMOE + 128 * MiB;
constexpr size_t WS_KF    = WS_ROT + 1 * MiB;
constexpr size_t WS_HS    = WS_KF + 32 * MiB;
constexpr size_t WS_WIN   = WS_HS + 48 * MiB;
constexpr size_t WS_WOUT  = WS_WIN + 54 * MiB;
constexpr size_t WS_WCQ   = WS_WOUT + 16 * MiB;
constexpr size_t WS_WCKV  = WS_WCQ + 16 * MiB;
constexpr size_t WS_WCO   = WS_WCKV + 32 * MiB;
constexpr size_t WS_WGU   = WS_WCO + 16 * MiB;
constexpr size_t WS_WDN   = WS_WGU + 512 * MiB;
constexpr size_t WS_KFB   = WS_WDN + 256 * MiB;
constexpr size_t WS_END   = WS_KFB + 68 * MiB;
constexpr int KFC = 4128;

struct P { const float* in[N_IN]; float* out; unsigned char* ws; };
typedef const __attribute__((address_space(4))) unsigned long long* KArgQ;
struct PD { KArgQ q;
    __device__ __forceinline__ const float* in(int i) const { return (const float*)(const GAS float*)q[i]; }
    __device__ __forceinline__ float* out() const { return (float*)(GAS float*)q[N_IN]; }
    __device__ __forceinline__ unsigned char* ws() const { return (unsigned char*)(GAS unsigned char*)q[N_IN + 1]; } };

__device__ __forceinline__ float bf2f(unsigned v) { return __uint_as_float(v << 16); }
__device__ __forceinline__ unsigned f2bf(float f) { unsigned u = __float_as_uint(f); u += 0x7fffu + ((u >> 16) & 1u); return u >> 16; }
typedef __bf16 bf16x2_t __attribute__((ext_vector_type(2)));
__device__ __forceinline__ unsigned cvt_pk_bf16(float lo, float hi) { union { bf16x2_t b; unsigned u; } x; x.b = __builtin_convertvector((f32x2){lo, hi}, bf16x2_t); return x.u; }
__device__ __forceinline__ unsigned pk2(float lo, float hi) { return cvt_pk_bf16(lo, hi); }
__device__ __forceinline__ void unpack8(const u32x4 w, float (&f)[8]) {
    f[0] = bf2f(w.x & 0xffffu); f[1] = bf2f(w.x >> 16); f[2] = bf2f(w.y & 0xffffu); f[3] = bf2f(w.y >> 16);
    f[4] = bf2f(w.z & 0xffffu); f[5] = bf2f(w.z >> 16); f[6] = bf2f(w.w & 0xffffu); f[7] = bf2f(w.w >> 16);
}
__device__ __forceinline__ float wave_sum(float v) {
#pragma unroll
    for (int o = 1; o < 64; o <<= 1) v += __shfl_xor(v, o);
    return v;
}
#define LDS_WAIT() asm volatile("s_waitcnt lgkmcnt(0)" ::: "memory")
namespace pg8 {
constexpr int BM = 256, BK = 64, HALF = 128, HTB = HALF * BK * 2  , STAGE_BYTES = 8 * HTB, NXCD = 8, WGM = 8;

__host__ __device__ __forceinline__ int lds_byte(int r, int c) { const int st = (r >> 4) * 2 + (c >> 5), rr = r & 15, cc = c & 31, ob = rr * 64 + cc * 2; return st * 1024 + (ob ^ (((ob >> 9) & 1) << 5)); }
__host__ __device__ __forceinline__ void stage_rc(int b, int& R, int& C) { const int st = b / 1024, sb = b % 1024, swz = sb ^ (((sb >> 9) & 1) << 5); R = (st >> 1) * 16 + swz / 64; C = (st & 1) * 32 + (swz % 64) / 2; }
__host__ __device__ __forceinline__ int perm32(int rho) { const int n = rho >> 4, i = rho & 15; return 8 * (i >> 2) + 4 * n + (i & 3); }

struct Unit { int pm, pn; };
struct Gemm { const bf16_t* A; const bf16_t* Bt; int K; };

struct StaticOrder {
    int nM, nN, nwg, G, c;
    __device__ void init(int M, int N, int G_, int c_) { nM = M / BM; nN = N / BM; nwg = nM * nN; G = G_; c = c_; }
    __device__ bool next(int i, Unit& u) const {
        const long L = (long)i * G + c; if (L >= nwg) return false;
        int wgid = (int)L; { const int q = nwg / NXCD, r = nwg % NXCD, xcd = wgid % NXCD, off = wgid / NXCD; wgid = (xcd < r ? xcd * (q + 1) : r * (q + 1) + (xcd - r) * q) + off; }
        const int nig = WGM * nN, gid = wgid / nig, fm = gid * WGM, gsz = (nM - fm) < WGM ? (nM - fm) : WGM;
        u.pm = fm + ((wgid % nig) % gsz); u.pn = (wgid % nig) / gsz; return true;
    }
};
struct MoeOrder {
    int npn, G, c;
    __device__ void init(int npn_, int G_, int c_) { npn = npn_; G = G_; c = c_; }
    __device__ bool next(int i, Unit& u) const {
        const int L = i * G + c; const int per_e = 4 * npn; if (L >= 16 * per_e) return false;
        const int e = L / per_e, r = L % per_e; u.pm = e * 4 + (r & 3); u.pn = e * npn + (r >> 2); return true;
    }
};

template <class Epi, class Sched>
__device__ __forceinline__ void gemm_phase(LAS unsigned char* lds, const int tid, const Gemm g, const Sched& S, const Epi& E) {
    const int wid = __builtin_amdgcn_readfirstlane(tid >> 6), lane = tid & 63, wr = wid >> 2, wc = wid & 3, fr = lane & 15, fq = lane >> 4;
    const int K = g.K, nt = K / BK;
    unsigned voffA[2], voffB[2];
#pragma unroll
    for (int i = 0; i < 2; ++i) { int R, C; stage_rc(tid * 16 + i * 8192, R, C); const int Rb = Epi::PERM ? ((R & ~31) + perm32(R & 31)) : R;
        voffA[i] = (unsigned)(R * K + C) * 2u; voffB[i] = (unsigned)(Rb * K + C) * 2u; }
    const size_t kstep = (size_t)(BK * 2);
    const size_t hstep = (size_t)HALF * K * 2;
    const size_t tstep = 2 * hstep;
    const unsigned ldsw = (unsigned)wid * 1024u;
    const int aoff = lds_byte(wr * 64 + fr, fq * 8), boff = lds_byte(wc * 32 + fr, fq * 8);
#define PG8_SA(b, h) (((b) * 2 + (h)) * HTB)
#define PG8_SB(b, h) ((4 + (b) * 2 + (h)) * HTB)
#define PG8_STAGE(bufoff, gbase, voff) do { _Pragma("unroll") for (int _i = 0; _i < 2; ++_i) \
        __builtin_amdgcn_global_load_lds((const unsigned*)((const char*)(gbase) + (voff)[_i]), (LAS unsigned*)(lds + (bufoff) + ldsw + _i * 8192), 16, 0, 0); } while (0)
#define PG8_LDA(dst, b, h) do { _Pragma("unroll") for (int m = 0; m < 4; ++m) _Pragma("unroll") for (int k = 0; k < 2; ++k) dst[m][k] = *(const LAS bf16x8*)(lds + PG8_SA(b, h) + aoff + m * 2048 + k * 1024); } while (0)
#define PG8_LDB(dst, b, h) do { _Pragma("unroll") for (int n = 0; n < 2; ++n) _Pragma("unroll") for (int k = 0; k < 2; ++k) dst[n][k] = *(const LAS bf16x8*)(lds + PG8_SB(b, h) + boff + n * 2048 + k * 1024); } while (0)
#define PG8_MMA(ai, bj, At, Bt) do { __builtin_amdgcn_s_setprio(1); _Pragma("unroll") for (int m = 0; m < 4; ++m) _Pragma("unroll") for (int n = 0; n < 2; ++n) _Pragma("unroll") for (int k = 0; k < 2; ++k) \
        acc[ai][bj][m][n] = __builtin_amdgcn_mfma_f32_16x16x32_bf16(Bt[n][k], At[m][k], acc[ai][bj][m][n], 0, 0, 0); __builtin_amdgcn_s_setprio(0); } while (0)
#define PG8_WAIT_V(n) asm volatile("s_waitcnt vmcnt(" #n ")" ::: "memory")
#define PG8_WAIT_L(n) asm volatile("s_waitcnt lgkmcnt(" #n ")" ::: "memory")
#define PG8_BAR __builtin_amdgcn_s_barrier()
#define PG8_SCHED __builtin_amdgcn_sched_barrier(0)
    Unit cur, nxt; int ui = 0;
    if (!S.next(0, cur)) return;
    f32x4 acc[2][2][4][2];
#pragma unroll
    for (int a = 0; a < 2; ++a)
#pragma unroll
        for (int b = 0; b < 2; ++b)
#pragma unroll
            for (int m = 0; m < 4; ++m)
#pragma unroll
                for (int n = 0; n < 2; ++n) acc[a][b][m][n] = (f32x4){0.f, 0.f, 0.f, 0.f};
    bf16x8 At[4][2], B0[2][2], B1[2][2];
    const char* cA = (const char*)g.A + (size_t)cur.pm * tstep; const char* cB = (const char*)g.Bt + (size_t)cur.pn * tstep;
    PG8_STAGE(PG8_SB(0, 0), cB, voffB); PG8_STAGE(PG8_SA(0, 0), cA, voffA); PG8_STAGE(PG8_SB(0, 1), cB + hstep, voffB); PG8_STAGE(PG8_SA(0, 1), cA + hstep, voffA);
    if (wr == 1) PG8_BAR;
    PG8_WAIT_V(4); PG8_BAR;
    PG8_STAGE(PG8_SB(1, 0), cB + kstep, voffB); PG8_STAGE(PG8_SA(1, 0), cA + kstep, voffA); PG8_STAGE(PG8_SB(1, 1), cB + hstep + kstep, voffB);
    PG8_WAIT_V(6); PG8_BAR;
    for (;;) {
        const bool has_next = S.next(ui + 1, nxt);
        const char* nA = has_next ? (const char*)g.A + (size_t)nxt.pm * tstep : cA; const char* nB = has_next ? (const char*)g.Bt + (size_t)nxt.pn * tstep : cB;
        for (int t = 0; t < nt; t += 2) {
            const bool last = (t == nt - 2);
            const char* a1 = cA + (size_t)(t + 1) * kstep;
            const char* a2 = last ? nA : cA + (size_t)(t + 2) * kstep; const char* b2 = last ? nB : cB + (size_t)(t + 2) * kstep;
            const char* a3 = a2 + kstep; const char* b3 = b2 + kstep;
            PG8_LDB(B0, 0, 0); PG8_SCHED; PG8_LDA(At, 0, 0); PG8_STAGE(PG8_SA(1, 1), a1 + hstep, voffA);
            PG8_WAIT_L(8); PG8_BAR; PG8_WAIT_L(0); PG8_MMA(0, 0, At, B0); PG8_BAR; PG8_SCHED;
            PG8_LDB(B1, 0, 1); PG8_STAGE(PG8_SB(0, 0), b2, voffB);
            PG8_BAR; PG8_WAIT_L(0); PG8_MMA(0, 1, At, B1); PG8_BAR;
            PG8_LDA(At, 0, 1); PG8_STAGE(PG8_SA(0, 0), a2, voffA);
            PG8_BAR; PG8_WAIT_L(0); PG8_MMA(1, 0, At, B0); PG8_BAR; PG8_SCHED;
            PG8_STAGE(PG8_SB(0, 1), b2 + hstep, voffB);
            PG8_WAIT_V(6); PG8_BAR; PG8_MMA(1, 1, At, B1); PG8_BAR;
            PG8_LDB(B0, 1, 0); PG8_SCHED; PG8_LDA(At, 1, 0); PG8_STAGE(PG8_SA(0, 1), a2 + hstep, voffA);
            PG8_WAIT_L(8); PG8_BAR; PG8_WAIT_L(0); PG8_MMA(0, 0, At, B0); PG8_BAR; PG8_SCHED;
            PG8_LDB(B1, 1, 1); PG8_STAGE(PG8_SB(1, 0), b3, voffB);
            PG8_BAR; PG8_WAIT_L(0); PG8_MMA(0, 1, At, B1); PG8_BAR;
            PG8_LDA(At, 1, 1); PG8_STAGE(PG8_SA(1, 0), a3, voffA);
            PG8_BAR; PG8_WAIT_L(0); PG8_MMA(1, 0, At, B0); PG8_BAR; PG8_SCHED;
            PG8_STAGE(PG8_SB(1, 1), b3 + hstep, voffB);
            PG8_WAIT_V(6); PG8_BAR; PG8_MMA(1, 1, At, B1); PG8_BAR;
        }
        E(acc, cur, wr, wc, fr, fq);
        if (!has_next) break;
#pragma unroll
        for (int a = 0; a < 2; ++a)
#pragma unroll
            for (int b = 0; b < 2; ++b)
#pragma unroll
                for (int m = 0; m < 4; ++m)
#pragma unroll
                    for (int n = 0; n < 2; ++n) acc[a][b][m][n] = (f32x4){0.f, 0.f, 0.f, 0.f};
        cur = nxt; cA = nA; cB = nB; ++ui;
    }
    PG8_WAIT_V(0);
    if (wr == 0) PG8_BAR;
    PG8_BAR;
#undef PG8_SA
#undef PG8_SB
#undef PG8_STAGE
#undef PG8_LDA
#undef PG8_LDB
#undef PG8_MMA
#undef PG8_WAIT_V
#undef PG8_WAIT_L
#undef PG8_BAR
#undef PG8_SCHED
}
}
#define XB_TMO      128
#define XB_XCNT(j)  (256  + 64 * (j))
#define XB_XSUB(j)  (1280 + 64 * (j))
#define XB_XGEN(j)  (2304 + 64 * (j))
#define XB_TOP      3328
#define XB_TOPGEN   3392
#define XCD_BAR_WORDS 3456
#define XB_SPIN_CAP (1u << 18)

__device__ __forceinline__ unsigned xb_ld(unsigned* p)              { return __hip_atomic_load(p, __ATOMIC_RELAXED, __HIP_MEMORY_SCOPE_AGENT); }
__device__ __forceinline__ unsigned xb_add(unsigned* p, unsigned v) { return __hip_atomic_fetch_add(p, v, __ATOMIC_RELAXED, __HIP_MEMORY_SCOPE_AGENT); }
__device__ __forceinline__ unsigned xb_xcc_id() { return (unsigned)__builtin_amdgcn_s_getreg((3 << 11) | 20) & 0xFu; }
#define XB_SPIN(cond, bar) do { unsigned _sp = 0; while (cond) { __builtin_amdgcn_s_sleep(1); \
    if ((++_sp & 255u) == 0u) { if (xb_ld(&(bar)[XB_TMO])) break; if (_sp > XB_SPIN_CAP) { atomicAdd(&(bar)[XB_TMO], 1u); break; } } } } while (0)

struct XcdBarrier {
    unsigned* bar; unsigned x;
    volatile LAS unsigned* st;
};

__device__ __forceinline__ XcdBarrier xcd_barrier_post(unsigned* bar, volatile LAS unsigned* st) {
    XcdBarrier b; b.bar = bar; b.x = xb_xcc_id(); b.st = st;
    if (threadIdx.x == 0) (void)xb_add(&bar[XB_XCNT(b.x)], 1u);
    return b;
}
__device__ __forceinline__ void xcd_barrier_complete(unsigned* bar, unsigned x, unsigned& nloc, unsigned& nx) {
    const unsigned G = gridDim.x * gridDim.y * gridDim.z;
    unsigned sum, cnt, mine, sp = 0u;
    for (;;) {
        sum = 0u; cnt = 0u; mine = 0u;
#pragma unroll
        for (unsigned j = 0; j < 16; ++j) { const unsigned c = xb_ld(&bar[XB_XCNT(j)]); sum += c; cnt += (c > 0u) ? 1u : 0u; mine = (j == x) ? c : mine; }
        if (sum == G) break;
        __builtin_amdgcn_s_sleep(1);
        if ((++sp & 255u) == 0u) { if (xb_ld(&bar[XB_TMO])) break; if (sp > XB_SPIN_CAP) { atomicAdd(&bar[XB_TMO], 1u); break; } }
    }
    nloc = mine > 0u ? mine : 1u; nx = cnt > 0u ? cnt : 1u;
}

__device__ __forceinline__ void xcd_barrier(const XcdBarrier& b) {
    asm volatile("s_waitcnt vmcnt(0)" ::: "memory");
    __syncthreads();
    if (threadIdx.x == 0) {
        unsigned* bar = b.bar;
        __builtin_amdgcn_s_waitcnt(0);
        unsigned nloc = b.st[0], nx = b.st[1];
        if (nloc == 0u) { xcd_barrier_complete(bar, b.x, nloc, nx); b.st[0] = nloc; b.st[1] = nx; }
        const unsigned old = xb_add(&bar[XB_XSUB(b.x)], 1u);
        const unsigned gen = old / nloc;
        if (old + 1u == (gen + 1u) * nloc) {
            __builtin_amdgcn_fence(__ATOMIC_RELEASE, "agent");
            asm volatile("s_waitcnt vmcnt(0)" ::: "memory");
            const unsigned og = xb_add(&bar[XB_TOP], 1u);
            const unsigned tg = og / nx;
            if (og + 1u == (tg + 1u) * nx) xb_add(&bar[XB_TOPGEN], 1u);
            else XB_SPIN(xb_ld(&bar[XB_TOPGEN]) == tg, bar);
            __builtin_amdgcn_fence(__ATOMIC_ACQUIRE, "agent");
            xb_add(&bar[XB_XGEN(b.x)], 1u);
            asm volatile("s_waitcnt vmcnt(0)" ::: "memory");
        } else {
            XB_SPIN(xb_ld(&bar[XB_XGEN(b.x)]) == gen, bar);
            __builtin_amdgcn_fence(__ATOMIC_ACQUIRE, "agent");
            asm volatile("s_waitcnt vmcnt(0)" ::: "memory");
        }
    }
    __syncthreads();
}

enum { PH_CVT = 0, PH_PRE, PH_NORM1, PH_INPROJ, PH_NA, PH_HYPRE, PH_HYCONV, PH_RET, PH_GNORM, PH_OUT, PH_NORM2, PH_CQ, PH_CKV, PH_XATT, PH_CO, PH_ROUTER, PH_TOPK, PH_GATHER,
       PH_GU, PH_DOWN, PH_COMBINE, PH_KCOPY, N_PHASES };
constexpr int NTHR = 512, NWAVES = 8;
constexpr int LDS_BYTES = 150 * 1024;

struct Ctx { int tid, lane, wave, G, bid; LAS unsigned char* lds; };

__device__ __forceinline__ void cvt_item(const float* src, size_t stride, int cd0, int cds, int K, bf16_t* WT, LAS float* scr, int k0, int n0, int lane) {
    f32x4 v[16];
    const float* s0 = src + (size_t)(k0 + (lane >> 4)) * stride;
#pragma unroll
    for (int i = 0; i < 16; ++i) v[i] = __builtin_nontemporal_load((const f32x4*)(s0 + (size_t)(4 * i) * stride));
#pragma unroll
    for (int i = 0; i < 16; ++i) { LAS float* d = scr + ((lane >> 4) + 4 * i) * 65 + cd0;
        d[0] = v[i].x; d[cds] = v[i].y; d[2 * cds] = v[i].z; d[3 * cds] = v[i].w; }
    LDS_WAIT();
    const int c = lane >> 3, ns = lane & 7;
#pragma unroll
    for (int j = 0; j < 8; ++j) { const LAS float* s = scr + (8 * c) * 65 + ns + 8 * j;
        u32x4 o; o.x = pk2(s[0 * 65], s[1 * 65]); o.y = pk2(s[2 * 65], s[3 * 65]); o.z = pk2(s[4 * 65], s[5 * 65]); o.w = pk2(s[6 * 65], s[7 * 65]);
        *(u32x4*)(WT + (size_t)(n0 + ns + 8 * j) * K + k0 + 8 * c) = o; }
    LDS_WAIT();
}
__device__ __forceinline__ void ph_cvt(const PD& p, const Ctx& c) {
    LAS float* scr = (LAS float*)(c.lds) + c.wave * (64 * 65);
    const int gw = c.bid * NWAVES + c.wave, NGW = c.G * NWAVES;
    constexpr int I_IN = 32 * (PIN / 64), I_SQ = 32 * (DM / 64), I_KV = 32 * (4096 / 64), I_GU = NE * 32 * (4096 / 64), I_DN = NE * 32 * (DM / 64);
    constexpr int PER_LAYER = I_IN + 3 * I_SQ + I_KV + I_GU + I_DN;
    const int m = c.lane & 15;
    for (int it = gw; it < DEPTH * PER_LAYER; it += NGW) {
        const int l = it / PER_LAYER; int r = it % PER_LAYER;
        if (r < I_IN) { const int kb = r / (PIN / 64), nb = r % (PIN / 64); const int n0 = nb * 64;
            const float* W = p.in(I_W_IN) + (size_t)l * DM * PIN; bf16_t* WT = (bf16_t*)(p.ws() + WS_WIN) + (size_t)l * PIN * DM;
            if (n0 >= OFF_RQ && n0 < OFF_RV) {
                const int base = n0 & ~127, i0 = (n0 & 127) >> 1, s = m >> 3, mm = m & 7;
                cvt_item(W + base + 64 * s + i0 + 4 * mm, PIN, 8 * mm + s, 2, DM, WT, scr, kb * 64, n0, c.lane);
            } else cvt_item(W + n0 + 4 * m, PIN, 4 * m, 1, DM, WT, scr, kb * 64, n0, c.lane);
            continue; }
        r -= I_IN;
        if (r < 3 * I_SQ) { const int which = r / I_SQ; r %= I_SQ; const int kb = r / (DM / 64), nb = r % (DM / 64);
            const size_t wo = which == 0 ? WS_WOUT : (which == 1 ? WS_WCQ : WS_WCO);
            const float* W = (which == 0 ? p.in(I_W_OUT) : (which == 1 ? p.in(I_W_CQ) : p.in(I_W_CO))) + (size_t)l * DM * DM; bf16_t* WT = (bf16_t*)(p.ws() + wo) + (size_t)l * DM * DM;
            cvt_item(W + nb * 64 + 4 * m, DM, 4 * m, 1, DM, WT, scr, kb * 64, nb * 64, c.lane); continue; }
        r -= 3 * I_SQ;
        if (r < I_KV) { const int kb = r / 64, nb = r % 64;
            const float* W = p.in(I_W_CKV) + (size_t)l * DM * 4096; bf16_t* WT = (bf16_t*)(p.ws() + WS_WCKV) + (size_t)l * 4096 * DM;
            cvt_item(W + nb * 64 + 4 * m, 4096, 4 * m, 1, DM, WT, scr, kb * 64, nb * 64, c.lane); continue; }
        r -= I_KV;
        if (r < I_GU) { const int e = r / (32 * 64); r %= (32 * 64); const int kb = r / 64, nb = r % 64;
            const int n0 = nb * 64, j = n0 >> 8, half = (n0 >> 7) & 1, f = 128 * j + (n0 & 127);
            const float* W = (half ? p.in(I_W_UP) : p.in(I_W_GATE)) + ((size_t)l * NE + e) * DM * FF;
            bf16_t* WT = (bf16_t*)(p.ws() + WS_WGU) + ((size_t)l * NE + e) * 4096 * DM;
            cvt_item(W + f + 4 * m, FF, 4 * m, 1, DM, WT, scr, kb * 64, n0, c.lane); continue; }
        r -= I_GU;
        { const int e = r / (32 * 32); r %= (32 * 32); const int kb = r / 32, nb = r % 32;
            const float* W = p.in(I_W_DOWN) + ((size_t)l * NE + e) * FF * DM; bf16_t* WT = (bf16_t*)(p.ws() + WS_WDN) + ((size_t)l * NE + e) * DM * FF;
            cvt_item(W + nb * 64 + 4 * m, DM, 4 * m, 1, FF, WT, scr, kb * 64, nb * 64, c.lane); }
    }
}

__device__ __forceinline__ void row_load_f32(const float* row, int lane, f32x4 (&v)[8]) {
#pragma unroll
    for (int j = 0; j < 8; ++j) v[j] = *(const f32x4*)(row + 256 * j + 4 * lane);
}
__device__ __forceinline__ float row_ssq(const f32x4 (&v)[8]) {
    float s = 0.f;
#pragma unroll
    for (int j = 0; j < 8; ++j) s += (v[j].x * v[j].x + v[j].y * v[j].y) + (v[j].z * v[j].z + v[j].w * v[j].w);
    return wave_sum(s);
}
__device__ __forceinline__ void row_store_bf16(bf16_t* row, int lane, const f32x4 (&v)[8]) {
#pragma unroll
    for (int j = 0; j < 8; ++j) { u32x2 o; o.x = pk2(v[j].x, v[j].y); o.y = pk2(v[j].z, v[j].w); *(u32x2*)(row + 256 * j + 4 * lane) = o; }
}
__device__ __forceinline__ void rmsnorm_row_to_bf16(const float* xrow, const float* gain, bf16_t* orow, int lane) {
    f32x4 v[8]; row_load_f32(xrow, lane, v);
    const float rstd = rsqrtf(row_ssq(v) * (1.f / DM) + RMS_EPS);
#pragma unroll
    for (int j = 0; j < 8; ++j) { const f32x4 g = *(const f32x4*)(gain + 256 * j + 4 * lane); v[j] = v[j] * rstd * g; }
    row_store_bf16(orow, lane, v);
}

__device__ __forceinline__ void ph_pre(const PD& p, const Ctx& c) {
    const int gw = c.bid * NWAVES + c.wave, NGW = c.G * NWAVES;
    for (int m = gw; m < NB * NMEM; m += NGW) rmsnorm_row_to_bf16(p.in(I_MEM) + (size_t)m * DM, p.in(I_MEM_NORM), (bf16_t*)(p.ws() + WS_MEMN) + (size_t)m * DM, c.lane);
    { const f32x4* s = (const f32x4*)p.in(I_X); f32x4* d = (f32x4*)(p.ws() + WS_XRES);
      for (size_t i = (size_t)c.bid * NTHR + c.tid; i < (size_t)NT * DM / 4; i += (size_t)c.G * NTHR) d[i] = s[i]; }
    { float* ct = (float*)(p.ws() + WS_ROT); float* st = ct + SEQ * 64;
      for (int i = c.bid * NTHR + c.tid; i < SEQ * 64; i += c.G * NTHR) { const int pos = i >> 6, k = i & 63;
          const float lin = (float)k / 63.0f; const float inv = 1.0f / powf(10000.0f, lin); const float ang = (float)pos * inv;
          ct[i] = (float)cos((double)ang); st[i] = (float)sin((double)ang); } }
    LAS float* sm = (LAS float*)c.lds;
    for (int u = c.bid; u < DEPTH * SEQ; u += c.G) {
        const int l = u / SEQ, t = u % SEQ;
        const float t01 = (float)t / (float)(SEQ - 1);
        __syncthreads();
        if (c.tid < 17) { float f;
            if (c.tid == 0) f = t01;
            else { const int i = (c.tid - 1) & 7; const float band = 1e-4f + (float)i * ((7.0f - 1e-4f) / 7.0f);
                   const float ang = (2.0f * 3.14159265358979323846f) * ((float)t / (float)SEQ) * band;
                   f = (c.tid <= 8) ? cosf(ang) : -sinf(ang); }
            sm[c.tid] = f; }
        __syncthreads();
        if (c.tid < 64) { const float* w1 = p.in(I_HY_W1) + (size_t)l * 17 * 64; float a = p.in(I_HY_B1)[l * 64 + c.tid];
            for (int i = 0; i < 17; ++i) a += sm[i] * w1[i * 64 + c.tid];
            sm[32 + c.tid] = sinf(p.in(I_HY_FREQ)[l * 64 + c.tid] * a); }
        __syncthreads();
        if (c.tid < 64) { const float* w2 = p.in(I_HY_W2) + (size_t)l * 64 * 64; float a = p.in(I_HY_B2)[l * 64 + c.tid];
            for (int i = 0; i < 64; ++i) a += sm[32 + i] * w2[i * 64 + c.tid];
            sm[96 + c.tid] = sinf(p.in(I_HY_FREQ)[l * 64 + c.tid] * a); }
        __syncthreads();
        const float* w3 = p.in(I_HY_W3) + (size_t)l * 64 * 2048;
        float* kf = (float*)(p.ws() + WS_KF) + (size_t)l * 2 * 512 * 4096;
        const float min_decay = logf(1e-2f) / 1.5f, max_decay = logf(1e-2f) / 0.3f;
        for (int n = c.tid; n < 2048; n += NTHR) {
            float a = 0.f;
            for (int i = 0; i < 64; ++i) a += sm[96 + i] * w3[i * 2048 + n];
            const int o = n >> 10, dir = (n >> 9) & 1, ch = n & 511;
            const float delta = fabsf(min_decay + (max_decay - min_decay) * ((float)ch / 511.0f));
            a *= expf(-t01 * delta);
            float* kc = kf + ((size_t)o * 512 + ch) * 4096;
            if (dir == 0) kc[2048 + t] = a; else { if (t >= 1) kc[2048 - t] = a; else kc[0] = 0.f; }
        }
    }
}

__device__ __forceinline__ void ph_norm(const PD& p, const Ctx& c, const float* gain) {
    const int gw = c.bid * NWAVES + c.wave, NGW = c.G * NWAVES;
    for (int m = gw; m < NT; m += NGW) rmsnorm_row_to_bf16((const float*)(p.ws() + WS_XRES) + (size_t)m * DM, gain, (bf16_t*)(p.ws() + WS_HN) + (size_t)m * DM, c.lane);
}

struct EpiInProj {
    static constexpr bool PERM = true;
    bf16_t* O; const float* rc; const float* rs;
    __device__ __forceinline__ void operator()(const f32x4 (&acc)[2][2][4][2], const pg8::Unit& u, int wr, int wc, int fr, int fq) const {
        const int row0 = u.pm * 256 + wr * 64 + fr, col0 = u.pn * 256 + wc * 32 + 8 * fq;
        const bool rot = (u.pn >= OFF_RQ / 256) && (u.pn < OFF_RV / 256);
        const float qs = (u.pn < OFF_RK / 256) ? 0.08838834764831845f : 1.0f;
#pragma unroll
        for (int ai = 0; ai < 2; ++ai)
#pragma unroll
            for (int m = 0; m < 4; ++m) { const int row = row0 + ai * 128 + m * 16; bf16_t* rowp = O + (size_t)row * PIN + col0;
#pragma unroll
                for (int bj = 0; bj < 2; ++bj) { f32x4 v0 = acc[ai][bj][m][0], v1 = acc[ai][bj][m][1];
                    if (rot) { const int pos = row & (SEQ - 1); const int i0 = ((col0 + bj * 128) & 127) >> 1;
                        const f32x4 cs = *(const f32x4*)(rc + pos * 64 + i0), sn = *(const f32x4*)(rs + pos * 64 + i0);
                        f32x4 r0, r1;
                        r0.x = (v0.x * cs.x - v0.y * sn.x) * qs; r0.y = (v0.x * sn.x + v0.y * cs.x) * qs;
                        r0.z = (v0.z * cs.y - v0.w * sn.y) * qs; r0.w = (v0.z * sn.y + v0.w * cs.y) * qs;
                        r1.x = (v1.x * cs.z - v1.y * sn.z) * qs; r1.y = (v1.x * sn.z + v1.y * cs.z) * qs;
                        r1.z = (v1.z * cs.w - v1.w * sn.w) * qs; r1.w = (v1.z * sn.w + v1.w * cs.w) * qs;
                        v0 = r0; v1 = r1; }
                    u32x4 w; w.x = cvt_pk_bf16(v0.x, v0.y); w.y = cvt_pk_bf16(v0.z, v0.w); w.z = cvt_pk_bf16(v1.x, v1.y); w.w = cvt_pk_bf16(v1.z, v1.w);
                    *(u32x4*)(rowp + bj * 128) = w; } }
    }
};
struct EpiBf16 {
    static constexpr bool PERM = true;
    bf16_t* O; int ldc;
    __device__ __forceinline__ void operator()(const f32x4 (&acc)[2][2][4][2], const pg8::Unit& u, int wr, int wc, int fr, int fq) const {
        const int row0 = u.pm * 256 + wr * 64 + fr, col0 = u.pn * 256 + wc * 32 + 8 * fq;
#pragma unroll
        for (int ai = 0; ai < 2; ++ai)
#pragma unroll
            for (int m = 0; m < 4; ++m) { bf16_t* rowp = O + (size_t)(row0 + ai * 128 + m * 16) * ldc + col0;
#pragma unroll
                for (int bj = 0; bj < 2; ++bj) { const f32x4 v0 = acc[ai][bj][m][0], v1 = acc[ai][bj][m][1];
                    u32x4 w; w.x = cvt_pk_bf16(v0.x, v0.y); w.y = cvt_pk_bf16(v0.z, v0.w); w.z = cvt_pk_bf16(v1.x, v1.y); w.w = cvt_pk_bf16(v1.z, v1.w);
                    *(u32x4*)(rowp + bj * 128) = w; } }
    }
};
struct EpiResid {
    static constexpr bool PERM = false;
    float* X;
    __device__ __forceinline__ void operator()(const f32x4 (&acc)[2][2][4][2], const pg8::Unit& u, int wr, int wc, int fr, int fq) const {
        const int row0 = u.pm * 256 + wr * 64 + fr, col0 = u.pn * 256 + wc * 32 + 4 * fq;
#pragma unroll
        for (int ai = 0; ai < 2; ++ai)
#pragma unroll
            for (int m = 0; m < 4; ++m) { float* rowp = X + (size_t)(row0 + ai * 128 + m * 16) * DM + col0;
#pragma unroll
                for (int bj = 0; bj < 2; ++bj)
#pragma unroll
                    for (int n = 0; n < 2; ++n) { f32x4* q = (f32x4*)(rowp + bj * 128 + n * 16); *q = *q + acc[ai][bj][m][n]; } }
    }
};
struct EpiGU {
    static constexpr bool PERM = true;
    bf16_t* O; int npn;
    __device__ __forceinline__ void operator()(const f32x4 (&acc)[2][2][4][2], const pg8::Unit& u, int wr, int wc, int fr, int fq) const {
        const int row0 = u.pm * 256 + wr * 64 + fr, col0 = (u.pn % npn) * 128 + wc * 32 + 8 * fq;
#pragma unroll
        for (int ai = 0; ai < 2; ++ai)
#pragma unroll
            for (int m = 0; m < 4; ++m) { bf16_t* rowp = O + (size_t)(row0 + ai * 128 + m * 16) * FF + col0;
                float h[8];
#pragma unroll
                for (int n = 0; n < 2; ++n)
#pragma unroll
                    for (int j = 0; j < 4; ++j) { const float a = acc[ai][0][m][n][j], b = acc[ai][1][m][n][j]; h[n * 4 + j] = a / (1.0f + __expf(-a)) * b; }
                u32x4 w; w.x = cvt_pk_bf16(h[0], h[1]); w.y = cvt_pk_bf16(h[2], h[3]); w.z = cvt_pk_bf16(h[4], h[5]); w.w = cvt_pk_bf16(h[6], h[7]);
                *(u32x4*)rowp = w; }
    }
};
struct EpiDown {
    static constexpr bool PERM = false;
    float* Y; int npn;
    __device__ __forceinline__ void operator()(const f32x4 (&acc)[2][2][4][2], const pg8::Unit& u, int wr, int wc, int fr, int fq) const {
        const int row0 = u.pm * 256 + wr * 64 + fr, col0 = (u.pn % npn) * 256 + wc * 32 + 4 * fq;
#pragma unroll
        for (int ai = 0; ai < 2; ++ai)
#pragma unroll
            for (int m = 0; m < 4; ++m) { float* rowp = Y + (size_t)(row0 + ai * 128 + m * 16) * DM + col0;
#pragma unroll
                for (int bj = 0; bj < 2; ++bj)
#pragma unroll
                    for (int n = 0; n < 2; ++n) *(f32x4*)(rowp + bj * 128 + n * 16) = acc[ai][bj][m][n]; }
    }
};

__device__ __forceinline__ void ph_na(const PD& p, const Ctx& c, int l) {
    const bf16_t* proj = (const bf16_t*)(p.ws() + WS_PROJ); bf16_t* ycat = (bf16_t*)(p.ws() + WS_YCAT);
    LAS float* Pm = (LAS float*)c.lds;
    const float* rpb = p.in(I_NA_RPB) + (size_t)l * NAH * 15 * 31;
    for (int u = c.bid; u < NB * ROWS * NAH; u += c.G) {
        const int h = u % NAH, r = (u / NAH) % ROWS, b = u / (NAH * ROWS);
        const int qc = c.tid >> 3, sub = c.tid & 7;
        const int rs = min(max(r - 4, 0), ROWS - 8), cs = min(max(qc - 8, 0), GW - 16);
        const int tok = b * SEQ + r * GW + qc;
        float q[64];
        { const u32x4* qp = (const u32x4*)(proj + (size_t)tok * PIN + OFF_NAQ + h * 64);
#pragma unroll
          for (int i = 0; i < 8; ++i) { float f[8]; unpack8(qp[i], f);
#pragma unroll
              for (int j = 0; j < 8; ++j) q[i * 8 + j] = f[j] * 0.125f; } }
        const int krow = rs + sub;
        float s[16]; float mx = -INFINITY;
#pragma unroll
        for (int j = 0; j < 16; ++j) { const int kc = cs + j; const u32x4* kp = (const u32x4*)(proj + (size_t)(b * SEQ + krow * GW + kc) * PIN + OFF_NAK + h * 64);
            float d = 0.f;
#pragma unroll
            for (int i = 0; i < 8; ++i) { float f[8]; unpack8(kp[i], f);
#pragma unroll
                for (int jj = 0; jj < 8; ++jj) d += q[i * 8 + jj] * f[jj]; }
            s[j] = d + rpb[(h * 15 + (krow - r + 7)) * 31 + (kc - qc + 15)]; mx = fmaxf(mx, s[j]); }
        mx = fmaxf(mx, __shfl_xor(mx, 1)); mx = fmaxf(mx, __shfl_xor(mx, 2)); mx = fmaxf(mx, __shfl_xor(mx, 4));
        float sum = 0.f;
#pragma unroll
        for (int j = 0; j < 16; ++j) { s[j] = __expf(s[j] - mx); sum += s[j]; }
        sum += __shfl_xor(sum, 1); sum += __shfl_xor(sum, 2); sum += __shfl_xor(sum, 4);
        const float inv = 1.0f / sum;
        __syncthreads();
#pragma unroll
        for (int j = 0; j < 16; ++j) Pm[qc * 129 + sub * 16 + j] = s[j] * inv;
        __syncthreads();
        float o[8];
#pragma unroll
        for (int i = 0; i < 8; ++i) o[i] = 0.f;
        for (int key = 0; key < 128; ++key) { const int kr = rs + (key >> 4), kc = cs + (key & 15);
            const u32x4 vv = *(const u32x4*)(proj + (size_t)(b * SEQ + kr * GW + kc) * PIN + OFF_NAV + h * 64 + sub * 8);
            float f[8]; unpack8(vv, f); const float pr = Pm[qc * 129 + key];
#pragma unroll
            for (int i = 0; i < 8; ++i) o[i] += pr * f[i]; }
        u32x4 w; w.x = pk2(o[0], o[1]); w.y = pk2(o[2], o[3]); w.z = pk2(o[4], o[5]); w.w = pk2(o[6], o[7]);
        *(u32x4*)(ycat + (size_t)tok * DM + h * 64 + sub * 8) = w;
    }
}

__device__ __forceinline__ void ph_hypre(const PD& p, const Ctx& c, int l) {
    const bf16_t* proj = (const bf16_t*)(p.ws() + WS_PROJ); bf16_t* hs = (bf16_t*)(p.ws() + WS_HS);
    LAS float* U = (LAS float*)c.lds;
    const float* cw = p.in(I_HY_CONV_W) + (size_t)l * 3 * 1536; const float* cb = p.in(I_HY_CONV_B) + (size_t)l * 1536;
    for (int u = c.bid; u < NB * 32 * 24; u += c.G) {
        const int cg = u % 24, tt = (u / 24) % 32, b = u / (24 * 32); const int t0 = tt * 64;
        __syncthreads();
        for (int idx = c.tid; idx < 66 * 64; idx += NTHR) { const int rr = idx >> 6, cc = idx & 63; const int t = t0 - 1 + rr;
            U[rr * 65 + cc] = (t >= 0 && t < SEQ) ? bf2f(proj[(size_t)(b * SEQ + t) * PIN + OFF_HY + cg * 64 + cc]) : 0.f; }
        __syncthreads();
        for (int idx = c.tid; idx < 64 * 64; idx += NTHR) { const int tl = idx & 63, cc = idx >> 6; const int ch = cg * 64 + cc;
            const float s = U[tl * 65 + cc] * cw[ch] + U[(tl + 1) * 65 + cc] * cw[1536 + ch] + U[(tl + 2) * 65 + cc] * cw[3072 + ch] + cb[ch];
            hs[((size_t)b * 1536 + ch) * SEQ + t0 + tl] = (bf16_t)f2bf(s); }
    }
}

typedef float f32x16 __attribute__((ext_vector_type(16)));
typedef short s16x4 __attribute__((ext_vector_type(4)));
__device__ __forceinline__ bf16x8 as_bf16x8(const u32x4 v) { union { u32x4 u; bf16x8 b; } x; x.u = v; return x.b; }
__device__ __forceinline__ bf16x8 tr_pair(const LAS unsigned char* a0, const LAS unsigned char* a1) {
    const s16x4 lo = __builtin_amdgcn_ds_read_tr16_b64_v4i16((LAS s16x4*)a0), hi = __builtin_amdgcn_ds_read_tr16_b64_v4i16((LAS s16x4*)a1);
    return (bf16x8){lo.x, lo.y, lo.z, lo.w, hi.x, hi.y, hi.z, hi.w};
}
__device__ __forceinline__ void ph_kcopy(const PD& p, const Ctx& c) {
    LAS float* kf = (LAS float*)c.lds;
    for (int u = c.bid; u < DEPTH * 2 * HYW; u += c.G) {
        const float* src = (const float*)(p.ws() + WS_KF) + (size_t)u * 4096; bf16_t* dst = (bf16_t*)(p.ws() + WS_KFB) + (size_t)u * 4 * KFC;
        __syncthreads();
        for (int i = c.tid; i < 1024; i += NTHR) *(LAS f32x4*)(kf + 4 * i) = *(const f32x4*)(src + 4 * i);
        __syncthreads();
        for (int q = c.tid; q < 4 * (KFC / 8); q += NTHR) { const int rho = q / (KFC / 8), x0 = (q % (KFC / 8)) * 8; float v[8];
#pragma unroll
            for (int e = 0; e < 8; ++e) { const int x = x0 + e - rho; v[e] = (x >= 1 && x <= 4095) ? kf[4096 - x] : 0.f; }
            u32x4 o; o.x = pk2(v[0], v[1]); o.y = pk2(v[2], v[3]); o.z = pk2(v[4], v[5]); o.w = pk2(v[6], v[7]);
            *(u32x4*)(dst + rho * KFC + x0) = o; }
    }
}

constexpr int HY_ZP = 2496, HY_ZPB = HY_ZP * 2 + 16;
constexpr int HY_KRB = KFC * 2;
constexpr int HY_LDS_KR0 = 0, HY_LDS_KR1 = 4 * HY_KRB, HY_LDS_Z = 8 * HY_KRB;
__device__ __forceinline__ void ph_hyconv(const PD& p, const Ctx& c, int l) {
    const bf16_t* hs = (const bf16_t*)(p.ws() + WS_HS); bf16_t* ycat = (bf16_t*)(p.ws() + WS_YCAT);
    LAS unsigned char* L = c.lds;
    const int lane = c.lane, w = c.wave, a = lane & 31, hh = lane >> 5, nb = a >> 3, il = a & 7;
    const int laneA = (a & 3) * HY_KRB + 2 * (2048 + 8 * hh - 4 * (a >> 2));
    const int laneB = HY_LDS_Z + nb * HY_ZPB + 2 * (224 + 32 * (8 * w + il) + 8 * hh);
    for (int u = c.bid; u < HYW; u += c.G) {
        const int ch = u;
        __syncthreads();
        { const u32x4* s0 = (const u32x4*)((const bf16_t*)(p.ws() + WS_KFB) + (((size_t)l * 2 + 0) * HYW + ch) * 4 * KFC);
          const u32x4* s1 = (const u32x4*)((const bf16_t*)(p.ws() + WS_KFB) + (((size_t)l * 2 + 1) * HYW + ch) * 4 * KFC);
          for (int i = c.tid; i < 4 * HY_KRB / 16; i += NTHR) { *(LAS u32x4*)(L + HY_LDS_KR0 + 16 * i) = s0[i]; *(LAS u32x4*)(L + HY_LDS_KR1 + 16 * i) = s1[i]; }
          for (int i = c.tid; i < NB * (SEQ / 8); i += NTHR) { const int b = i >> 8, t8 = i & 255;
              *(LAS u32x4*)(L + HY_LDS_Z + b * HY_ZPB + 2 * (224 + 8 * t8)) = *(const u32x4*)(hs + ((size_t)b * 1536 + 1024 + ch) * SEQ + 8 * t8); }
          for (int i = c.tid; i < NB * 2 * 28; i += NTHR) { const int b = i / 56, r = i % 56; const int e0 = r < 28 ? 8 * r : 224 + SEQ + 8 * (r - 28);
              *(LAS u32x4*)(L + HY_LDS_Z + b * HY_ZPB + 2 * e0) = (u32x4){0u, 0u, 0u, 0u}; } }
        __syncthreads();
#pragma unroll 1
        for (int o = 0; o < 2; ++o) {
            const LAS unsigned char* KR = L + (o ? HY_LDS_KR1 : HY_LDS_KR0) + laneA;
            f32x16 acc;
#pragma unroll
            for (int r = 0; r < 16; ++r) acc[r] = 0.f;
            asm volatile("" : "+v"(acc));
            const int d_lo = 8 * w - 63, d_hi = 8 * w + 7;
#pragma unroll 2
            for (int delta = d_lo; delta <= d_hi; ++delta) {
                const LAS unsigned char* ka = KR - 64 * delta; const LAS unsigned char* zb = L + laneB - 64 * delta;
#pragma unroll
                for (int sp = 0; sp < 2; ++sp) {
                    const u32x2 a0 = *(const LAS u32x2*)(ka + 32 * sp), a1 = *(const LAS u32x2*)(ka + 32 * sp + 8);
                    const bf16x8 av = as_bf16x8((u32x4){a0.x, a0.y, a1.x, a1.y});
                    const bf16x8 bv = *(const LAS bf16x8*)(zb + 32 * sp);
                    acc = __builtin_amdgcn_mfma_f32_32x32x16_bf16(av, bv, acc, 0, 0, 0); } }
            __syncthreads();
            const float sd = p.in(I_HY_SKIP)[((size_t)l * 2 + o) * HYW + ch];
            const int tb = 32 * (8 * w + il) + 4 * hh;
            const bf16_t* gsrc = hs + ((size_t)nb * 1536 + o * 512 + ch) * SEQ + tb;
            LAS unsigned char* zrow = L + HY_LDS_Z + nb * HY_ZPB + 2 * (224 + tb);
#pragma unroll
            for (int i4 = 0; i4 < 4; ++i4) { const u32x2 gv = *(const u32x2*)(gsrc + 8 * i4); const u32x2 zv = *(const LAS u32x2*)(zrow + 16 * i4);
                const float g0 = bf2f(gv.x & 0xffffu), g1 = bf2f(gv.x >> 16), g2 = bf2f(gv.y & 0xffffu), g3 = bf2f(gv.y >> 16);
                const float z0 = bf2f(zv.x & 0xffffu), z1 = bf2f(zv.x >> 16), z2 = bf2f(zv.y & 0xffffu), z3 = bf2f(zv.y >> 16);
                const float r0 = g0 * (acc[4 * i4 + 0] + sd * z0), r1 = g1 * (acc[4 * i4 + 1] + sd * z1), r2 = g2 * (acc[4 * i4 + 2] + sd * z2), r3 = g3 * (acc[4 * i4 + 3] + sd * z3);
                if (o == 0) { u32x2 wv; wv.x = cvt_pk_bf16(r0, r1); wv.y = cvt_pk_bf16(r2, r3); *(LAS u32x2*)(zrow + 16 * i4) = wv; }
                else { bf16_t* yo = ycat + (size_t)(nb * SEQ + tb + 8 * i4) * DM + NAW + ch;
                    yo[0] = (bf16_t)f2bf(r0); yo[DM] = (bf16_t)f2bf(r1); yo[2 * DM] = (bf16_t)f2bf(r2); yo[3 * DM] = (bf16_t)f2bf(r3); } }
            __syncthreads();
        }
    }
}

__device__ __forceinline__ void ph_ret(const PD& p, const Ctx& c, int l) {
    const bf16_t* proj = (const bf16_t*)(p.ws() + WS_PROJ); bf16_t* ycat = (bf16_t*)(p.ws() + WS_YCAT);
    LAS unsigned char* L = c.lds;
    const int lane = c.lane, cc = lane & 31, hh = lane >> 5, w = c.wave;
    const int tq = (lane & 15) >> 2, tp = lane & 3, tblk = (lane >> 4) & 1;
    int lbV[4];
#pragma unroll
    for (int c4 = 0; c4 < 4; ++c4) lbV[c4] = 256 * (4 * hh + tq) + 16 * (((c4 ^ tq) << 2) | (2 * tblk + (tp >> 1))) + 8 * (tp & 1);
    const int kA = cc * 256, kX = cc & 15;
    const int g_row0 = w * 4 + (lane >> 4), g_ps = lane & 15;
    for (int u = c.bid; u < NB * RETH * 8; u += c.G) {
        const int qt = u & 7, h = (u >> 3) % RETH, b = u / (8 * RETH);
        const int tw0 = qt * 256 + 32 * w;
        const float lf2 = log2f(1.0f - exp2f(-5.0f - (float)h)), lb2 = log2f(1.0f - exp2f(-5.5f - (float)h));
        float Gf1[4], Gf8[4], Gb1[4], Gb8[4];
#pragma unroll
        for (int j = 0; j < 4; ++j) { Gf1[j] = exp2f(-lf2 * (float)j); Gf8[j] = exp2f(-lf2 * (float)(8 * j)); Gb1[j] = exp2f(lb2 * (float)j); Gb8[j] = exp2f(lb2 * (float)(8 * j)); }
        const bf16_t* kvb = proj + (size_t)(b * SEQ) * PIN + h * RETD;
#define RT_ISSUE(kt) do { _Pragma("unroll") for (int _i = 0; _i < 2; ++_i) { const int _row = g_row0 + 32 * _i; const bf16_t* _r = kvb + (size_t)(64 * (kt) + _row) * PIN; \
            __builtin_amdgcn_global_load_lds((const GAS unsigned*)(_r + OFF_RK + 8 * (g_ps ^ (_row & 15))), (LAS unsigned*)(L + ((kt) & 1) * 32768 + (8 * _i + w) * 1024), 16, 0, 0); \
            __builtin_amdgcn_global_load_lds((const GAS unsigned*)(_r + OFF_RV + 8 * (g_ps ^ ((_row & 3) << 2))), (LAS unsigned*)(L + ((kt) & 1) * 32768 + 16384 + (8 * _i + w) * 1024), 16, 0, 0); } } while (0)
        __syncthreads();
        RT_ISSUE(0);
        const size_t tok = (size_t)b * SEQ + tw0 + cc;
        bf16x8 qf[8];
        { const bf16_t* qrow = proj + tok * PIN + OFF_RQ + h * RETD + 8 * hh;
#pragma unroll
          for (int ks = 0; ks < 8; ++ks) qf[ks] = as_bf16x8(*(const u32x4*)(qrow + 16 * ks)); }
        f32x16 o[4];
#pragma unroll
        for (int c4 = 0; c4 < 4; ++c4) {
#pragma unroll
            for (int r = 0; r < 16; ++r) o[c4][r] = 0.f;
            asm volatile("" : "+v"(o[c4])); }
        asm volatile("s_waitcnt vmcnt(0)" ::: "memory");
        __syncthreads();
#pragma unroll 1
        for (int kt = 0; kt < SEQ / 64; ++kt) {
            if (kt + 1 < SEQ / 64) RT_ISSUE(kt + 1);
            const LAS unsigned char* Kt = L + (kt & 1) * 32768; const LAS unsigned char* Vt = Kt + 16384;
            f32x16 s[2];
#pragma unroll
            for (int kb = 0; kb < 2; ++kb) {
#pragma unroll
                for (int r = 0; r < 16; ++r) s[kb][r] = 0.f;
                asm volatile("" : "+v"(s[kb])); }
#pragma unroll
            for (int ks = 0; ks < 8; ++ks) { const LAS unsigned char* Ka = Kt + kA + 16 * ((2 * ks + hh) ^ kX);
#pragma unroll
                for (int kb = 0; kb < 2; ++kb) s[kb] = __builtin_amdgcn_mfma_f32_32x32x16_bf16(*(const LAS bf16x8*)(Ka + kb * 8192), qf[ks], s[kb], 0, 0, 0); }
            const int s0 = 64 * kt;
            if (s0 + 63 <= tw0) {
#pragma unroll
                for (int kb = 0; kb < 2; ++kb) { const float E = __builtin_amdgcn_exp2f(lf2 * (float)(tw0 + cc - (s0 + 32 * kb + 4 * hh)));
#pragma unroll
                    for (int i4 = 0; i4 < 4; ++i4) { const float e8 = E * Gf8[i4];
#pragma unroll
                        for (int j = 0; j < 4; ++j) s[kb][4 * i4 + j] *= e8 * Gf1[j]; } }
            } else if (s0 > tw0 + 31) {
#pragma unroll
                for (int kb = 0; kb < 2; ++kb) { const float E = __builtin_amdgcn_exp2f(lb2 * (float)((s0 + 32 * kb + 4 * hh) - (tw0 + cc)));
#pragma unroll
                    for (int i4 = 0; i4 < 4; ++i4) { const float e8 = E * Gb8[i4];
#pragma unroll
                        for (int j = 0; j < 4; ++j) s[kb][4 * i4 + j] *= e8 * Gb1[j]; } }
            } else {
#pragma unroll
                for (int kb = 0; kb < 2; ++kb)
#pragma unroll
                    for (int r = 0; r < 16; ++r) { const int diff = (tw0 + cc) - (s0 + 32 * kb + 4 * hh + (r & 3) + 8 * (r >> 2));
                        s[kb][r] *= __builtin_amdgcn_exp2f((diff >= 0 ? lf2 : -lb2) * (float)diff); }
            }
            bf16x8 pb[2][2];
#pragma unroll
            for (int kb = 0; kb < 2; ++kb)
#pragma unroll
                for (int sx = 0; sx < 2; ++sx) { u32x4 wv;
                    wv.x = cvt_pk_bf16(s[kb][8 * sx + 0], s[kb][8 * sx + 1]); wv.y = cvt_pk_bf16(s[kb][8 * sx + 2], s[kb][8 * sx + 3]);
                    wv.z = cvt_pk_bf16(s[kb][8 * sx + 4], s[kb][8 * sx + 5]); wv.w = cvt_pk_bf16(s[kb][8 * sx + 6], s[kb][8 * sx + 7]);
                    pb[kb][sx] = as_bf16x8(wv); }
#pragma unroll
            for (int kb = 0; kb < 2; ++kb)
#pragma unroll
                for (int sx = 0; sx < 2; ++sx) { const int rb = (32 * kb + 16 * sx) * 256;
#pragma unroll
                    for (int c4 = 0; c4 < 4; ++c4) { const bf16x8 a = tr_pair(Vt + lbV[c4] + rb, Vt + lbV[c4] + rb + 8 * 256);
                        o[c4] = __builtin_amdgcn_mfma_f32_32x32x16_bf16(a, pb[kb][sx], o[c4], 0, 0, 0); } }
            asm volatile("s_waitcnt vmcnt(0)" ::: "memory");
            __syncthreads();
        }
#undef RT_ISSUE
        float sm = 0.f;
#pragma unroll
        for (int c4 = 0; c4 < 4; ++c4)
#pragma unroll
            for (int r = 0; r < 16; ++r) sm += o[c4][r];
        sm += __shfl_xor(sm, 32);
        const float mu = sm * (1.f / RETD); float v2 = 0.f;
#pragma unroll
        for (int c4 = 0; c4 < 4; ++c4)
#pragma unroll
            for (int r = 0; r < 16; ++r) { const float d = o[c4][r] - mu; o[c4][r] = d; v2 += d * d; }
        v2 += __shfl_xor(v2, 32);
        const float rstd = rsqrtf(v2 * (1.f / RETD) + GN_EPS);
        const bf16_t* grow = proj + tok * PIN + OFF_RG + h * RETD + 4 * hh; bf16_t* yrow = ycat + tok * DM + NAW + HYW + h * RETD + 4 * hh;
#pragma unroll
        for (int c4 = 0; c4 < 4; ++c4)
#pragma unroll
            for (int i4 = 0; i4 < 4; ++i4) { const u32x2 gv = *(const u32x2*)(grow + 32 * c4 + 8 * i4);
                const float g0 = bf2f(gv.x & 0xffffu), g1 = bf2f(gv.x >> 16), g2 = bf2f(gv.y & 0xffffu), g3 = bf2f(gv.y >> 16);
                u32x2 wv; wv.x = cvt_pk_bf16(o[c4][4 * i4 + 0] * rstd * (g0 / (1.0f + __expf(-g0))), o[c4][4 * i4 + 1] * rstd * (g1 / (1.0f + __expf(-g1))));
                wv.y = cvt_pk_bf16(o[c4][4 * i4 + 2] * rstd * (g2 / (1.0f + __expf(-g2))), o[c4][4 * i4 + 3] * rstd * (g3 / (1.0f + __expf(-g3))));
                *(u32x2*)(yrow + 32 * c4 + 8 * i4) = wv; }
    }
}

__device__ __forceinline__ void ph_gnorm(const PD& p, const Ctx& c, int l) {
    const int gw = c.bid * NWAVES + c.wave, NGW = c.G * NWAVES;
    const float* gain = p.in(I_BRANCH_NORM) + (size_t)l * DM;
    for (int m = gw; m < NT; m += NGW) {
        const bf16_t* yr = (const bf16_t*)(p.ws() + WS_YCAT) + (size_t)m * DM; bf16_t* orow = (bf16_t*)(p.ws() + WS_YN) + (size_t)m * DM;
        float v[4][8]; float ss[3] = {0.f, 0.f, 0.f};
#pragma unroll
        for (int j = 0; j < 4; ++j) { const int e0 = 512 * j + 8 * c.lane; unpack8(*(const u32x4*)(yr + e0), v[j]);
            float s = 0.f;
#pragma unroll
            for (int i = 0; i < 8; ++i) s += v[j][i] * v[j][i];
            const int grp = e0 < NAW ? 0 : (e0 < NAW + HYW ? 1 : 2);
            ss[0] += grp == 0 ? s : 0.f; ss[1] += grp == 1 ? s : 0.f; ss[2] += grp == 2 ? s : 0.f; }
        const float r0 = rsqrtf(wave_sum(ss[0]) * (1.f / NAW) + RMS_EPS), r1 = rsqrtf(wave_sum(ss[1]) * (1.f / HYW) + RMS_EPS), r2 = rsqrtf(wave_sum(ss[2]) * (1.f / RETW) + RMS_EPS);
#pragma unroll
        for (int j = 0; j < 4; ++j) { const int e0 = 512 * j + 8 * c.lane; const float rr = e0 < NAW ? r0 : (e0 < NAW + HYW ? r1 : r2);
            const f32x4 g0 = *(const f32x4*)(gain + e0), g1 = *(const f32x4*)(gain + e0 + 4);
            u32x4 w; w.x = pk2(v[j][0] * rr * g0.x, v[j][1] * rr * g0.y); w.y = pk2(v[j][2] * rr * g0.z, v[j][3] * rr * g0.w);
            w.z = pk2(v[j][4] * rr * g1.x, v[j][5] * rr * g1.y); w.w = pk2(v[j][6] * rr * g1.z, v[j][7] * rr * g1.w);
            *(u32x4*)(orow + e0) = w; }
    }
}

__device__ __forceinline__ void ph_xatt(const PD& p, const Ctx& c, int l) {
    const bf16_t* qc = (const bf16_t*)(p.ws() + WS_QC); const bf16_t* kv = (const bf16_t*)(p.ws() + WS_KVC) + (size_t)l * 1024 * 4096; bf16_t* oc = (bf16_t*)(p.ws() + WS_OC);
    LAS unsigned char* L = c.lds;
    const int lane = c.lane, cc = lane & 31, hh = lane >> 5;
    const int fK = (cc >> 1) & 7;
    const int tq = (lane & 15) >> 2, tp = lane & 3, tblk = (lane >> 4) & 1, fV = ((tq >> 1) & 1) << 2;
    const int lbV0 = (4 * hh + tq) * 128 + 16 * (fV + 2 * tblk + (tp >> 1)) + 8 * (tp & 1);
    const int lbV1 = (4 * hh + tq) * 128 + 16 * ((4 ^ fV) + 2 * tblk + (tp >> 1)) + 8 * (tp & 1);
    for (int u = c.bid; u < NB * XH * 8; u += c.G) {
        const int qt = u & 7, h = (u >> 3) & 3, b = u >> 5;
        const bf16_t* kbase = kv + (size_t)(b * NMEM) * 4096 + h * XD;
        const size_t tok = (size_t)b * SEQ + qt * 256 + c.wave * 32 + cc;
        const bf16_t* qrow = qc + tok * DM + h * XD + 8 * hh;
        const int g_row0 = c.wave * 8 + (lane >> 3), g_ps = lane & 7;
#define XA_ISSUE(ci) do { const bf16_t* _src = kbase + ((ci) < 8 ? 64 * (ci) : 2048 + 64 * ((ci) - 8)); \
        _Pragma("unroll") for (int _i = 0; _i < 4; ++_i) { const int _row = g_row0 + 64 * _i; const int _f = (ci) < 8 ? ((_row >> 1) & 7) : (((_row >> 1) & 1) << 2); \
            __builtin_amdgcn_global_load_lds((const GAS unsigned*)(_src + (size_t)_row * 4096 + 8 * (g_ps ^ _f)), (LAS unsigned*)(L + ((ci) & 1) * 32768 + (8 * _i + c.wave) * 1024), 16, 0, 0); } } while (0)
#define XA_COMMIT(ci) asm volatile("s_waitcnt vmcnt(0)" ::: "memory")
        __syncthreads();
        XA_ISSUE(0); XA_COMMIT(0);
        bf16x8 qf[4], qn[4];
#pragma unroll
        for (int ks = 0; ks < 4; ++ks) qf[ks] = as_bf16x8(*(const u32x4*)(qrow + 16 * ks));
        __syncthreads();
        f32x16 acc[8];
#pragma unroll
        for (int kb = 0; kb < 8; ++kb)
#pragma unroll
            for (int r = 0; r < 16; ++r) acc[kb][r] = 0.f;
#pragma unroll 1
        for (int ci = 0; ci < 8; ++ci) {
            XA_ISSUE(ci + 1);
            if (ci + 1 < 8) {
#pragma unroll
                for (int ks = 0; ks < 4; ++ks) qn[ks] = as_bf16x8(*(const u32x4*)(qrow + 64 * (ci + 1) + 16 * ks)); }
            const LAS unsigned char* S = L + (ci & 1) * 32768 + cc * 128;
#pragma unroll
            for (int ks = 0; ks < 4; ++ks) { const LAS unsigned char* Sk = S + 16 * ((2 * ks + hh) ^ fK);
#pragma unroll
                for (int kb = 0; kb < 8; ++kb) { const bf16x8 a = *(const LAS bf16x8*)(Sk + kb * 4096);
                    acc[kb] = __builtin_amdgcn_mfma_f32_32x32x16_bf16(a, qf[ks], acc[kb], 0, 0, 0);
                    if ((kb & 3) == 3) __builtin_amdgcn_sched_barrier(0); } }
            XA_COMMIT(ci + 1);
#pragma unroll
            for (int ks = 0; ks < 4; ++ks) qf[ks] = qn[ks];
            __syncthreads();
        }
        bf16x8 pb[8][2];
        { float m = -INFINITY;
#pragma unroll
          for (int kb = 0; kb < 8; ++kb)
#pragma unroll
              for (int r = 0; r < 16; ++r) m = fmaxf(m, acc[kb][r]);
          m = fmaxf(m, __shfl_xor(m, 32));
          const float sc = 0.04419417382415922f * 1.4426950408889634f; const float ms = m * sc; float sum = 0.f;
#pragma unroll
          for (int kb = 0; kb < 8; ++kb)
#pragma unroll
              for (int r = 0; r < 16; ++r) { const float e = __builtin_amdgcn_exp2f(acc[kb][r] * sc - ms); acc[kb][r] = e; sum += e; }
          sum += __shfl_xor(sum, 32);
          const float inv = 1.0f / sum;
#pragma unroll
          for (int kb = 0; kb < 8; ++kb)
#pragma unroll
              for (int s = 0; s < 2; ++s) { u32x4 w;
                  w.x = cvt_pk_bf16(acc[kb][8 * s + 0] * inv, acc[kb][8 * s + 1] * inv); w.y = cvt_pk_bf16(acc[kb][8 * s + 2] * inv, acc[kb][8 * s + 3] * inv);
                  w.z = cvt_pk_bf16(acc[kb][8 * s + 4] * inv, acc[kb][8 * s + 5] * inv); w.w = cvt_pk_bf16(acc[kb][8 * s + 6] * inv, acc[kb][8 * s + 7] * inv);
                  pb[kb][s] = as_bf16x8(w); } }
        bf16_t* orow = oc + tok * DM + h * XD + 4 * hh;
#pragma unroll 1
        for (int ci = 8; ci < 16; ++ci) {
            if (ci + 1 < 16) XA_ISSUE(ci + 1);
            const LAS unsigned char* S = L + (ci & 1) * 32768;
            f32x16 o[2];
#pragma unroll
            for (int db = 0; db < 2; ++db) {
#pragma unroll
                for (int r = 0; r < 16; ++r) o[db][r] = 0.f;
                asm volatile("" : "+v"(o[db])); }
#pragma unroll
            for (int kb = 0; kb < 8; ++kb)
#pragma unroll
                for (int s = 0; s < 2; ++s) {
                    const bf16x8 a0 = tr_pair(S + lbV0 + (32 * kb + 16 * s) * 128, S + lbV0 + (32 * kb + 16 * s + 8) * 128);
                    const bf16x8 a1 = tr_pair(S + lbV1 + (32 * kb + 16 * s) * 128, S + lbV1 + (32 * kb + 16 * s + 8) * 128);
                    o[0] = __builtin_amdgcn_mfma_f32_32x32x16_bf16(a0, pb[kb][s], o[0], 0, 0, 0);
                    o[1] = __builtin_amdgcn_mfma_f32_32x32x16_bf16(a1, pb[kb][s], o[1], 0, 0, 0); }
#pragma unroll
            for (int db = 0; db < 2; ++db)
#pragma unroll
                for (int i4 = 0; i4 < 4; ++i4) { u32x2 w; w.x = cvt_pk_bf16(o[db][4 * i4 + 0], o[db][4 * i4 + 1]); w.y = cvt_pk_bf16(o[db][4 * i4 + 2], o[db][4 * i4 + 3]);
                    *(u32x2*)(orow + 64 * (ci - 8) + 32 * db + 8 * i4) = w; }
            if (ci + 1 < 16) XA_COMMIT(ci + 1);
            __syncthreads();
        }
#undef XA_ISSUE
#undef XA_COMMIT
    }
}

__device__ __forceinline__ void ph_router(const PD& p, const Ctx& c, int l) {
    const int gw = c.bid * NWAVES + c.wave, NGW = c.G * NWAVES;
    const float* gain = p.in(I_NORM_MOE) + (size_t)l * DM + 32 * c.lane; const float* wr = p.in(I_W_ROUTER) + (size_t)l * DM * NE + (size_t)(32 * c.lane) * NE;
    for (int m = gw; m < NT; m += NGW) {
        const float* xr = (const float*)(p.ws() + WS_XRES) + (size_t)m * DM + 32 * c.lane;
        f32x4 v[8]; float ss = 0.f;
#pragma unroll
        for (int j = 0; j < 8; ++j) { v[j] = *(const f32x4*)(xr + 4 * j); ss += (v[j].x * v[j].x + v[j].y * v[j].y) + (v[j].z * v[j].z + v[j].w * v[j].w); }
        const float rstd = rsqrtf(wave_sum(ss) * (1.f / DM) + RMS_EPS);
        float lg[16];
#pragma unroll
        for (int e = 0; e < 16; ++e) lg[e] = 0.f;
#pragma unroll
        for (int j = 0; j < 8; ++j) { const f32x4 g = *(const f32x4*)(gain + 4 * j); v[j] = v[j] * rstd * g;
#pragma unroll
            for (int q = 0; q < 4; ++q) { const float hv = v[j][q]; const f32x4* wp = (const f32x4*)(wr + (4 * j + q) * NE);
#pragma unroll
                for (int e4 = 0; e4 < 4; ++e4) { const f32x4 w = wp[e4]; lg[e4 * 4 + 0] += hv * w.x; lg[e4 * 4 + 1] += hv * w.y; lg[e4 * 4 + 2] += hv * w.z; lg[e4 * 4 + 3] += hv * w.w; } } }
        { bf16_t* orow = (bf16_t*)(p.ws() + WS_HN) + (size_t)m * DM + 32 * c.lane;
#pragma unroll
          for (int j = 0; j < 4; ++j) { u32x4 o; o.x = pk2(v[2 * j].x, v[2 * j].y); o.y = pk2(v[2 * j].z, v[2 * j].w); o.z = pk2(v[2 * j + 1].x, v[2 * j + 1].y); o.w = pk2(v[2 * j + 1].z, v[2 * j + 1].w);
              *(u32x4*)(orow + 8 * j) = o; } }
        float mx = -INFINITY;
#pragma unroll
        for (int e = 0; e < 16; ++e) { lg[e] = wave_sum(lg[e]); mx = fmaxf(mx, lg[e]); }
        float sum = 0.f;
#pragma unroll
        for (int e = 0; e < 16; ++e) { lg[e] = expf(lg[e] - mx); sum += lg[e]; }
        if (c.lane < 16) { float a = 0.f;
#pragma unroll
            for (int e = 0; e < 16; ++e) a = (c.lane == e) ? lg[e] : a;
            ((float*)(p.ws() + WS_AFF))[(size_t)m * NE + c.lane] = a / sum; }
    }
}

__device__ __forceinline__ void ph_topk(const PD& p, const Ctx& c) {
    LAS float* a = (LAS float*)c.lds;
    const float* aff = (const float*)(p.ws() + WS_AFF); int* idx = (int*)(p.ws() + WS_IDX); float* gs = (float*)(p.ws() + WS_GSEL); int* inv = (int*)(p.ws() + WS_INV);
    for (int u = c.bid; u < NB * NE; u += c.G) {
        const int e = u % NE, b = u / NE;
        __syncthreads();
        for (int t = c.tid; t < SEQ; t += NTHR) a[t] = aff[(size_t)(b * SEQ + t) * NE + e];
        __syncthreads();
        for (int q = 0; q < 4; ++q) { const int i = c.tid + 512 * q; const float ai = a[i]; int rank = 0;
            for (int j = 0; j < SEQ; ++j) { const float aj = a[j]; rank += (aj > ai || (aj == ai && j < i)) ? 1 : 0; }
            if (rank < CAP) { idx[(b * NE + e) * CAP + rank] = i; gs[(b * NE + e) * CAP + rank] = ai; inv[(size_t)(b * SEQ + i) * NE + e] = rank; }
            else inv[(size_t)(b * SEQ + i) * NE + e] = -1; }
    }
}

__device__ __forceinline__ void ph_gather(const PD& p, const Ctx& c) {
    const int gw = c.bid * NWAVES + c.wave, NGW = c.G * NWAVES;
    const int* idx = (const int*)(p.ws() + WS_IDX);
    for (int r = gw; r < NE * NB * CAP; r += NGW) { const int e = r / (NB * CAP), b = (r / CAP) % NB, slot = r % CAP;
        const int t = idx[(b * NE + e) * CAP + slot];
        const u32x4* s = (const u32x4*)((const bf16_t*)(p.ws() + WS_HN) + (size_t)(b * SEQ + t) * DM); u32x4* d = (u32x4*)((bf16_t*)(p.ws() + WS_XE) + (size_t)r * DM);
#pragma unroll
        for (int j = 0; j < 4; ++j) d[64 * j + c.lane] = s[64 * j + c.lane]; }
}

__device__ __forceinline__ void ph_combine(const PD& p, const Ctx& c, int l) {
    const int gw = c.bid * NWAVES + c.wave, NGW = c.G * NWAVES;
    const int* inv = (const int*)(p.ws() + WS_INV); const float* gs = (const float*)(p.ws() + WS_GSEL); const float* ym = (const float*)(p.ws() + WS_YMOE);
    for (int m = gw; m < NT; m += NGW) { const int b = m / SEQ;
        float* xr = (float*)(p.ws() + WS_XRES) + (size_t)m * DM;
        f32x4 v[8]; row_load_f32(xr, c.lane, v);
        for (int e = 0; e < NE; ++e) { const int slot = inv[(size_t)m * NE + e];
            if (slot >= 0) { const float g = gs[(b * NE + e) * CAP + slot]; const float* yr = ym + ((size_t)e * 1024 + b * CAP + slot) * DM;
#pragma unroll
                for (int j = 0; j < 8; ++j) v[j] = v[j] + g * *(const f32x4*)(yr + 256 * j + 4 * c.lane); } }
        if (l == DEPTH - 1) { const float rstd = rsqrtf(row_ssq(v) * (1.f / DM) + RMS_EPS); float* orow = p.out() + (size_t)m * DM; const float* gain = p.in(I_FINAL_NORM);
#pragma unroll
            for (int j = 0; j < 8; ++j) *(f32x4*)(orow + 256 * j + 4 * c.lane) = v[j] * rstd * *(const f32x4*)(gain + 256 * j + 4 * c.lane); }
        else {
#pragma unroll
            for (int j = 0; j < 8; ++j) *(f32x4*)(xr + 256 * j + 4 * c.lane) = v[j]; }
    }
}
template <int PH> __device__ __forceinline__ void run_phase(const Ctx& c_in, int l) {
    asm volatile("; PHASE_MARK %0" :: "n"(PH));
    Ctx c = c_in; { int ln; asm volatile("v_mbcnt_lo_u32_b32 %0, -1, 0\n\tv_mbcnt_hi_u32_b32 %0, -1, %0" : "=v"(ln)); c.lane = ln; c.tid = c_in.wave * 64 + ln; }
    PD p; { KArgQ q = (KArgQ)__builtin_amdgcn_kernarg_segment_ptr(); asm volatile("" : "+s"(q)); p.q = q; }
    unsigned char* ws = p.ws();
    if constexpr (PH == PH_CVT) ph_cvt(p, c);
    else if constexpr (PH == PH_PRE) ph_pre(p, c);
    else if constexpr (PH == PH_NORM1) ph_norm(p, c, p.in(I_NORM_MIX) + (size_t)l * DM);
    else if constexpr (PH == PH_NORM2) ph_norm(p, c, p.in(I_NORM_CROSS) + (size_t)l * DM);
    else if constexpr (PH == PH_INPROJ) {
        pg8::Gemm g{(const bf16_t*)(ws + WS_HN), (const bf16_t*)(ws + WS_WIN) + (size_t)l * PIN * DM, DM};
        pg8::StaticOrder S; S.init(NT, PIN, c.G, c.bid);
        EpiInProj E{(bf16_t*)(ws + WS_PROJ), (const float*)(ws + WS_ROT), (const float*)(ws + WS_ROT) + SEQ * 64};
        pg8::gemm_phase(c.lds, c.tid, g, S, E);
    }
    else if constexpr (PH == PH_NA) ph_na(p, c, l);
    else if constexpr (PH == PH_HYPRE) ph_hypre(p, c, l);
    else if constexpr (PH == PH_HYCONV) ph_hyconv(p, c, l);
    else if constexpr (PH == PH_RET) ph_ret(p, c, l);
    else if constexpr (PH == PH_GNORM) ph_gnorm(p, c, l);
    else if constexpr (PH == PH_OUT) {
        pg8::Gemm g{(const bf16_t*)(ws + WS_YN), (const bf16_t*)(ws + WS_WOUT) + (size_t)l * DM * DM, DM};
        pg8::StaticOrder S; S.init(NT, DM, c.G, c.bid);
        EpiResid E{(float*)(ws + WS_XRES)};
        pg8::gemm_phase(c.lds, c.tid, g, S, E);
    }
    else if constexpr (PH == PH_CQ) {
        pg8::Gemm g{(const bf16_t*)(ws + WS_HN), (const bf16_t*)(ws + WS_WCQ) + (size_t)l * DM * DM, DM};
        pg8::StaticOrder S; S.init(NT, DM, c.G, c.bid);
        EpiBf16 E{(bf16_t*)(ws + WS_QC), DM};
        pg8::gemm_phase(c.lds, c.tid, g, S, E);
    }
    else if constexpr (PH == PH_CKV) {
        pg8::Gemm g{(const bf16_t*)(ws + WS_MEMN), (const bf16_t*)(ws + WS_WCKV) + (size_t)l * 4096 * DM, DM};
        pg8::StaticOrder S; S.init(NB * NMEM, 4096, c.G, c.bid);
        EpiBf16 E{(bf16_t*)(ws + WS_KVC) + (size_t)l * 1024 * 4096, 4096};
        pg8::gemm_phase(c.lds, c.tid, g, S, E);
    }
    else if constexpr (PH == PH_XATT) ph_xatt(p, c, l);
    else if constexpr (PH == PH_CO) {
        pg8::Gemm g{(const bf16_t*)(ws + WS_OC), (const bf16_t*)(ws + WS_WCO) + (size_t)l * DM * DM, DM};
        pg8::StaticOrder S; S.init(NT, DM, c.G, c.bid);
        EpiResid E{(float*)(ws + WS_XRES)};
        pg8::gemm_phase(c.lds, c.tid, g, S, E);
    }
    else if constexpr (PH == PH_ROUTER) ph_router(p, c, l);
    else if constexpr (PH == PH_TOPK) ph_topk(p, c);
    else if constexpr (PH == PH_GATHER) ph_gather(p, c);
    else if constexpr (PH == PH_GU) {
        pg8::Gemm g{(const bf16_t*)(ws + WS_XE), (const bf16_t*)(ws + WS_WGU) + (size_t)l * NE * 4096 * DM, DM};
        pg8::MoeOrder S; S.init(16, c.G, c.bid);
        EpiGU E{(bf16_t*)(ws + WS_ACT), 16};
        pg8::gemm_phase(c.lds, c.tid, g, S, E);
    }
    else if constexpr (PH == PH_DOWN) {
        pg8::Gemm g{(const bf16_t*)(ws + WS_ACT), (const bf16_t*)(ws + WS_WDN) + (size_t)l * NE * DM * FF, FF};
        pg8::MoeOrder S; S.init(8, c.G, c.bid);
        EpiDown E{(float*)(ws + WS_YMOE), 8};
        pg8::gemm_phase(c.lds, c.tid, g, S, E);
    }
    else if constexpr (PH == PH_COMBINE) ph_combine(p, c, l);
    else if constexpr (PH == PH_KCOPY) ph_kcopy(p, c);
}

__global__ void __launch_bounds__(NTHR, 2) mega_fwd(P p) {
    extern __shared__ __attribute__((aligned(16))) unsigned char lds_raw[];
    Ctx c; c.tid = 0; c.lane = 0; c.wave = __builtin_amdgcn_readfirstlane((int)threadIdx.x >> 6); c.G = gridDim.x; c.bid = blockIdx.x; c.lds = (LAS unsigned char*)lds_raw;
    volatile LAS unsigned* st = (volatile LAS unsigned*)(c.lds + LDS_BYTES - 16);
    if (threadIdx.x < 4) st[threadIdx.x] = 0u;
    __syncthreads();
    (void)xcd_barrier_post((unsigned*)((unsigned char*)(GAS unsigned char*)p.ws + WS_CTL), st);
#ifndef PROBE_MASK
#define PROBE_MASK 0
#endif
#define RUNP(PH, ...) do { run_phase<PH>(__VA_ARGS__); if ((PROBE_MASK >> (PH)) & 1) { GRID_BAR(); run_phase<PH>(__VA_ARGS__); } } while (0)
#define GRID_BAR() do { PD _p; { KArgQ _q = (KArgQ)__builtin_amdgcn_kernarg_segment_ptr(); asm volatile("" : "+s"(_q)); _p.q = _q; } \
        XcdBarrier _b; _b.bar = (unsigned*)(_p.ws() + WS_CTL); _b.x = xb_xcc_id(); _b.st = (volatile LAS unsigned*)(c.lds + LDS_BYTES - 16); xcd_barrier(_b); } while (0)
    RUNP(PH_CVT, c, 0);
    RUNP(PH_PRE, c, 0);
    GRID_BAR();
    RUNP(PH_NORM1, c, 0);
    RUNP(PH_KCOPY, c, 0);
    GRID_BAR();
    for (int l = 0; l < DEPTH; ++l) {
        RUNP(PH_INPROJ, c, l);
        RUNP(PH_CKV, c, l);
        GRID_BAR();
        RUNP(PH_HYPRE, c, l);
        RUNP(PH_NA, c, l);
        GRID_BAR();
        RUNP(PH_HYCONV, c, l);
        RUNP(PH_RET, c, l);
        GRID_BAR();
        RUNP(PH_GNORM, c, l);
        GRID_BAR();
        RUNP(PH_OUT, c, l);
        GRID_BAR();
        RUNP(PH_NORM2, c, l);
        GRID_BAR();
        RUNP(PH_CQ, c, l);
        GRID_BAR();
        RUNP(PH_XATT, c, l);
        GRID_BAR();
        RUNP(PH_CO, c, l);
        GRID_BAR();
        RUNP(PH_ROUTER, c, l);
        GRID_BAR();
        RUNP(PH_TOPK, c, l);
        GRID_BAR();
        RUNP(PH_GATHER, c, l);
        GRID_BAR();
        RUNP(PH_GU, c, l);
        GRID_BAR();
        RUNP(PH_DOWN, c, l);
        GRID_BAR();
        RUNP(PH_COMBINE, c, l);
        if (l + 1 < DEPTH) { RUNP(PH_NORM1, c, l + 1); GRID_BAR(); }
    }
}

extern "C" void kernel_launch(void* const* d_in, const int* in_sizes, int n_in, void* d_out, int out_size, void* d_ws, size_t ws_size, hipStream_t stream) {
    if (n_in != N_IN || out_size != NT * DM || ws_size < WS_END) { fprintf(stderr, "kernel_launch: unexpected shapes (n_in %d, out %d, ws %zu < %zu); nothing launched\n", n_in, out_size, ws_size, (size_t)WS_END); return; }
    static int grid = 0;
    if (!grid) {
        int dev = 0, cus = 0, per_cu = 0;
        if (hipGetDevice(&dev) != hipSuccess || hipDeviceGetAttribute(&cus, hipDeviceAttributeMultiprocessorCount, dev) != hipSuccess) { fprintf(stderr, "kernel_launch: device query failed\n"); return; }
        if (hipFuncSetAttribute((const void*)mega_fwd, hipFuncAttributeMaxDynamicSharedMemorySize, LDS_BYTES) != hipSuccess) { fprintf(stderr, "kernel_launch: hipFuncSetAttribute failed\n"); return; }
        if (hipOccupancyMaxActiveBlocksPerMultiprocessor(&per_cu, (const void*)mega_fwd, NTHR, LDS_BYTES) != hipSuccess || per_cu < 1) fprintf(stderr, "kernel_launch: occupancy query reports %d workgroups per CU\n", per_cu);
        grid = cus;
    }
    P p{};
    for (int i = 0; i < N_IN; ++i) p.in[i] = (const float*)d_in[i];
    p.out = (float*)d_out; p.ws = (unsigned char*)d_ws;
    if (hipMemsetAsync((char*)d_ws + WS_CTL, 0, XCD_BAR_WORDS * sizeof(unsigned), stream) != hipSuccess) { fprintf(stderr, "kernel_launch: memset failed\n"); return; }
    hipLaunchKernelGGL(mega_fwd, dim3(grid), dim3(NTHR), LDS_BYTES, stream, p);
    hipError_t le = hipGetLastError();
    if (le != hipSuccess) fprintf(stderr, "kernel_launch: launch failed: %s\n", hipGetErrorName(le));
}
```

```cpp
#include <hip/hip_runtime.h>
#include <cstdio>
#include <cstdint>
#include <cmath>

#define LAS __attribute__((address_space(3)))
#define GAS __attribute__((address_space(1)))
typedef unsigned short bf16_t;
typedef short bf16x8 __attribute__((ext_vector_type(8)));
typedef float f32x4 __attribute__((ext_vector_type(4)));
typedef float f32x2 __attribute__((ext_vector_type(2)));
typedef unsigned u32x4 __attribute__((ext_vector_type(4)));
typedef unsigned u32x2 __attribute__((ext_vector_type(2)));

constexpr int NB = 4, SEQ = 2048, DM = 2048, NT = NB * SEQ, DEPTH = 2;
constexpr int NMEM = 256, GW = 64, ROWS = SEQ / GW;
constexpr int NAW = 768, NAH = 12, NADH = 64;
constexpr int HYW = 512, HYFF = 64;
constexpr int RETW = 768, RETH = 6, RETD = 128;
constexpr int PIN = 6912;
constexpr int OFF_NAQ = 0, OFF_NAK = 768, OFF_NAV = 1536, OFF_HY = 2304, OFF_RQ = 3840, OFF_RK = 4608, OFF_RV = 5376, OFF_RG = 6144;
constexpr int XH = 4, XD = 512;
constexpr int NE = 16, FF = 2048, CAP = 256;
constexpr float RMS_EPS = 1e-6f, GN_EPS = 1e-5f;

enum { I_X = 0, I_MEM, I_NORM_MIX, I_W_IN, I_NA_RPB, I_HY_CONV_W, I_HY_CONV_B, I_HY_W1, I_HY_B1, I_HY_W2, I_HY_B2, I_HY_W3, I_HY_FREQ, I_HY_SKIP,
       I_BRANCH_NORM, I_W_OUT, I_NORM_CROSS, I_MEM_NORM, I_W_CQ, I_W_CKV, I_W_CO, I_NORM_MOE, I_W_ROUTER, I_W_GATE, I_W_UP, I_W_DOWN, I_FINAL_NORM, N_IN };

constexpr size_t MiB = (size_t)1 << 20;
constexpr size_t WS_CTL   = 0;
constexpr size_t WS_XRES  = 1 * MiB;
constexpr size_t WS_HN    = WS_XRES + 64 * MiB;
constexpr size_t WS_PROJ  = WS_HN + 32 * MiB;
constexpr size_t WS_YCAT  = WS_PROJ + 108 * MiB;
constexpr size_t WS_YN    = WS_YCAT + 32 * MiB;
constexpr size_t WS_QC    = WS_YN + 32 * MiB;
constexpr size_t WS_KVC   = WS_QC + 32 * MiB;
constexpr size_t WS_OC    = WS_KVC + 16 * MiB;
constexpr size_t WS_MEMN  = WS_OC + 32 * MiB;
constexpr size_t WS_AFF   = WS_MEMN + 4 * MiB;
constexpr size_t WS_IDX   = WS_AFF + 1 * MiB;
constexpr size_t WS_GSEL  = WS_IDX + 1 * MiB;
constexpr size_t WS_INV   = WS_GSEL + 1 * MiB;
constexpr size_t WS_XE    = WS_INV + 1 * MiB;
constexpr size_t WS_ACT   = WS_XE + 64 * MiB;
constexpr size_t WS_YMOE  = WS_ACT + 64 * MiB;
constexpr size_t WS_ROT   = WS_YMOE + 128 * MiB;
constexpr size_t WS_KF    = WS_ROT + 1 * MiB;
constexpr size_t WS_HS    = WS_KF + 32 * MiB;
constexpr size_t WS_WIN   = WS_HS + 48 * MiB;
constexpr size_t WS_WOUT  = WS_WIN + 54 * MiB;
constexpr size_t WS_WCQ   = WS_WOUT + 16 * MiB;
constexpr size_t WS_WCKV  = WS_WCQ + 16 * MiB;
constexpr size_t WS_WCO   = WS_WCKV + 32 * MiB;
constexpr size_t WS_WGU   = WS_WCO + 16 * MiB;
constexpr size_t WS_WDN   = WS_WGU + 512 * MiB;
constexpr size_t WS_KFB   = WS_WDN + 256 * MiB;
constexpr size_t WS_END   = WS_KFB + 68 * MiB;
constexpr int KFC = 4128;

struct P { const float* in[N_IN]; float* out; unsigned char* ws; };
typedef const __attribute__((address_space(4))) unsigned long long* KArgQ;
struct PD { KArgQ q;
    __device__ __forceinline__ const float* in(int i) const { return (const float*)(const GAS float*)q[i]; }
    __device__ __forceinline__ float* out() const { return (float*)(GAS float*)q[N_IN]; }
    __device__ __forceinline__ unsigned char* ws() const { return (unsigned char*)(GAS unsigned char*)q[N_IN + 1]; } };

__device__ __forceinline__ float bf2f(unsigned v) { return __uint_as_float(v << 16); }
__device__ __forceinline__ unsigned f2bf(float f) { unsigned u = __float_as_uint(f); u += 0x7fffu + ((u >> 16) & 1u); return u >> 16; }
typedef __bf16 bf16x2_t __attribute__((ext_vector_type(2)));
__device__ __forceinline__ unsigned cvt_pk_bf16(float lo, float hi) { union { bf16x2_t b; unsigned u; } x; x.b = __builtin_convertvector((f32x2){lo, hi}, bf16x2_t); return x.u; }
__device__ __forceinline__ unsigned pk2(float lo, float hi) { return cvt_pk_bf16(lo, hi); }
__device__ __forceinline__ void unpack8(const u32x4 w, float (&f)[8]) {
    f[0] = bf2f(w.x & 0xffffu); f[1] = bf2f(w.x >> 16); f[2] = bf2f(w.y & 0xffffu); f[3] = bf2f(w.y >> 16);
    f[4] = bf2f(w.z & 0xffffu); f[5] = bf2f(w.z >> 16); f[6] = bf2f(w.w & 0xffffu); f[7] = bf2f(w.w >> 16);
}
__device__ __forceinline__ float wave_sum(float v) {
#pragma unroll
    for (int o = 1; o < 64; o <<= 1) v += __shfl_xor(v, o);
    return v;
}
#define LDS_WAIT() asm volatile("s_waitcnt lgkmcnt(0)" ::: "memory")
namespace pg8 {
constexpr int BM = 256, BK = 64, HALF = 128, HTB = HALF * BK * 2  , STAGE_BYTES = 8 * HTB, NXCD = 8, WGM = 8;

__host__ __device__ __forceinline__ int lds_byte(int r, int c) { const int st = (r >> 4) * 2 + (c >> 5), rr = r & 15, cc = c & 31, ob = rr * 64 + cc * 2; return st * 1024 + (ob ^ (((ob >> 9) & 1) << 5)); }
__host__ __device__ __forceinline__ void stage_rc(int b, int& R, int& C) { const int st = b / 1024, sb = b % 1024, swz = sb ^ (((sb >> 9) & 1) << 5); R = (st >> 1) * 16 + swz / 64; C = (st & 1) * 32 + (swz % 64) / 2; }
__host__ __device__ __forceinline__ int perm32(int rho) { const int n = rho >> 4, i = rho & 15; return 8 * (i >> 2) + 4 * n + (i & 3); }

struct Unit { int pm, pn; };
struct Gemm { const bf16_t* A; const bf16_t* Bt; int K; };

struct StaticOrder {
    int nM, nN, nwg, G, c;
    __device__ void init(int M, int N, int G_, int c_) { nM = M / BM; nN = N / BM; nwg = nM * nN; G = G_; c = c_; }
    __device__ bool next(int i, Unit& u) const {
        const long L = (long)i * G + c; if (L >= nwg) return false;
        int wgid = (int)L; { const int q = nwg / NXCD, r = nwg % NXCD, xcd = wgid % NXCD, off = wgid / NXCD; wgid = (xcd < r ? xcd * (q + 1) : r * (q + 1) + (xcd - r) * q) + off; }
        const int nig = WGM * nN, gid = wgid / nig, fm = gid * WGM, gsz = (nM - fm) < WGM ? (nM - fm) : WGM;
        u.pm = fm + ((wgid % nig) % gsz); u.pn = (wgid % nig) / gsz; return true;
    }
};
struct MoeOrder {
    int npn, G, x, s;
    __device__ void init(int npn_, int G_, int c_) { npn = npn_; G = G_; x = c_ & 7; s = c_ >> 3; }
    __device__ bool next(int i, Unit& u) const {
        if (G != 256) { const int L = i * G + (s * 8 + x); const int per_e = 4 * npn; if (L >= 16 * per_e) return false;
            const int e = L / per_e, r = L % per_e; u.pm = e * 4 + (r & 3); u.pn = e * npn + (r >> 2); return true; }
        const int q = i * 8 + x;
        const int nch = 16 * npn / 8; if (q >= nch) return false;
        const int e = q / (npn / 8), half = q % (npn / 8);
        u.pm = e * 4 + (s & 3); u.pn = e * npn + 8 * half + (s >> 2); return true;
    }
};

template <class Epi, class Sched, bool ALIGN_EPI = true, bool SP2 = true>
__device__ __forceinline__ void gemm_phase(LAS unsigned char* lds, const int tid, const Gemm g, const Sched& S, const Epi& E) {
    const int wid = __builtin_amdgcn_readfirstlane(tid >> 6), lane = tid & 63, wr = wid >> 2, wc = wid & 3, fr = lane & 15, fq = lane >> 4;
    const int K = g.K, nt = K / BK;
    unsigned voffA[2], voffB[2];
#pragma unroll
    for (int i = 0; i < 2; ++i) { int R, C; stage_rc(tid * 16 + i * 8192, R, C); const int Rb = Epi::PERM ? ((R & ~31) + perm32(R & 31)) : R;
        voffA[i] = (unsigned)(R * K + C) * 2u; voffB[i] = (unsigned)(Rb * K + C) * 2u; }
    const size_t kstep = (size_t)(BK * 2);
    const size_t hstep = (size_t)HALF * K * 2;
    const size_t tstep = 2 * hstep;
    const unsigned ldsw = (unsigned)wid * 1024u;
    const int aoff = lds_byte(wr * 64 + fr, fq * 8), boff = lds_byte(wc * 32 + fr, fq * 8);
#define PG8_SA(b, h) (((b) * 2 + (h)) * HTB)
#define PG8_SB(b, h) ((4 + (b) * 2 + (h)) * HTB)
#define PG8_STAGE(bufoff, gbase, voff) do { _Pragma("unroll") for (int _i = 0; _i < 2; ++_i) \
        __builtin_amdgcn_global_load_lds((const unsigned*)((const char*)(gbase) + (voff)[_i]), (LAS unsigned*)(lds + (bufoff) + ldsw + _i * 8192), 16, 0, 0); } while (0)
#define PG8_LDA(dst, b, h) do { _Pragma("unroll") for (int m = 0; m < 4; ++m) _Pragma("unroll") for (int k = 0; k < 2; ++k) dst[m][k] = *(const LAS bf16x8*)(lds + PG8_SA(b, h) + aoff + m * 2048 + k * 1024); } while (0)
#define PG8_LDB(dst, b, h) do { _Pragma("unroll") for (int n = 0; n < 2; ++n) _Pragma("unroll") for (int k = 0; k < 2; ++k) dst[n][k] = *(const LAS bf16x8*)(lds + PG8_SB(b, h) + boff + n * 2048 + k * 1024); } while (0)
#define PG8_MMA(ai, bj, At, Bt) do { __builtin_amdgcn_s_setprio(1); _Pragma("unroll") for (int m = 0; m < 4; ++m) _Pragma("unroll") for (int n = 0; n < 2; ++n) _Pragma("unroll") for (int k = 0; k < 2; ++k) \
        acc[ai][bj][m][n] = __builtin_amdgcn_mfma_f32_16x16x32_bf16(Bt[n][k], At[m][k], acc[ai][bj][m][n], 0, 0, 0); __builtin_amdgcn_s_setprio(0); } while (0)
#define PG8_WAIT_V(n) asm volatile("s_waitcnt vmcnt(" #n ")" ::: "memory")
#define PG8_WAIT_L(n) asm volatile("s_waitcnt lgkmcnt(" #n ")" ::: "memory")
#define PG8_BAR __builtin_amdgcn_s_barrier()
#define PG8_SCHED __builtin_amdgcn_sched_barrier(0)
    Unit cur, nxt; int ui = 0;
    if (!S.next(0, cur)) return;
    f32x4 acc[2][2][4][2];
#pragma unroll
    for (int a = 0; a < 2; ++a)
#pragma unroll
        for (int b = 0; b < 2; ++b)
#pragma unroll
            for (int m = 0; m < 4; ++m)
#pragma unroll
                for (int n = 0; n < 2; ++n) acc[a][b][m][n] = (f32x4){0.f, 0.f, 0.f, 0.f};
    bf16x8 At[4][2], B0[2][2], B1[2][2];
    const char* cA = (const char*)g.A + (size_t)cur.pm * tstep; const char* cB = (const char*)g.Bt + (size_t)cur.pn * tstep;
    if constexpr (SP2) {
        PG8_STAGE(PG8_SB(0, 0), cB, voffB); PG8_STAGE(PG8_SB(0, 1), cB + hstep, voffB); PG8_STAGE(PG8_SA(0, 0), cA, voffA); PG8_STAGE(PG8_SA(0, 1), cA + hstep, voffA);
        if (wr == 1) PG8_BAR;
        PG8_WAIT_V(2); PG8_BAR;
        PG8_STAGE(PG8_SB(1, 0), cB + kstep, voffB); PG8_STAGE(PG8_SA(1, 0), cA + kstep, voffA); PG8_STAGE(PG8_SB(1, 1), cB + hstep + kstep, voffB);
        PG8_WAIT_V(6); PG8_BAR;
    } else {
        PG8_STAGE(PG8_SB(0, 0), cB, voffB); PG8_STAGE(PG8_SA(0, 0), cA, voffA); PG8_STAGE(PG8_SB(0, 1), cB + hstep, voffB); PG8_STAGE(PG8_SA(0, 1), cA + hstep, voffA);
        if (wr == 1) PG8_BAR;
        PG8_WAIT_V(4); PG8_BAR;
        PG8_STAGE(PG8_SB(1, 0), cB + kstep, voffB); PG8_STAGE(PG8_SA(1, 0), cA + kstep, voffA); PG8_STAGE(PG8_SB(1, 1), cB + hstep + kstep, voffB);
        PG8_WAIT_V(6); PG8_BAR;
    }
    for (;;) {
        const bool has_next = S.next(ui + 1, nxt);
        const char* nA = has_next ? (const char*)g.A + (size_t)nxt.pm * tstep : cA; const char* nB = has_next ? (const char*)g.Bt + (size_t)nxt.pn * tstep : cB;
        for (int t = 0; t < nt; t += 2) {
            const bool last = (t == nt - 2);
            const char* a1 = cA + (size_t)(t + 1) * kstep;
            const char* a2 = last ? nA : cA + (size_t)(t + 2) * kstep; const char* b2 = last ? nB : cB + (size_t)(t + 2) * kstep;
            const char* a3 = a2 + kstep; const char* b3 = b2 + kstep;
            if constexpr (SP2) {
            PG8_LDB(B0, 0, 0); PG8_LDB(B1, 0, 1); PG8_SCHED; PG8_LDA(At, 0, 0); PG8_STAGE(PG8_SA(1, 1), a1 + hstep, voffA);
            PG8_WAIT_V(8); PG8_WAIT_L(0); PG8_BAR; PG8_MMA(0, 0, At, B0); PG8_MMA(0, 1, At, B1); PG8_BAR; PG8_SCHED;
            PG8_LDA(At, 0, 1); PG8_STAGE(PG8_SB(0, 0), b2, voffB); PG8_STAGE(PG8_SB(0, 1), b2 + hstep, voffB); PG8_STAGE(PG8_SA(0, 0), a2, voffA);
            PG8_WAIT_V(8); PG8_WAIT_L(0); PG8_BAR; PG8_MMA(1, 0, At, B0); PG8_MMA(1, 1, At, B1); PG8_BAR; PG8_SCHED;
            PG8_LDB(B0, 1, 0); PG8_LDB(B1, 1, 1); PG8_SCHED; PG8_LDA(At, 1, 0); PG8_STAGE(PG8_SA(0, 1), a2 + hstep, voffA);
            PG8_WAIT_V(8); PG8_WAIT_L(0); PG8_BAR; PG8_MMA(0, 0, At, B0); PG8_MMA(0, 1, At, B1); PG8_BAR; PG8_SCHED;
            PG8_LDA(At, 1, 1); PG8_STAGE(PG8_SB(1, 0), b3, voffB); PG8_STAGE(PG8_SB(1, 1), b3 + hstep, voffB); PG8_STAGE(PG8_SA(1, 0), a3, voffA);
            PG8_WAIT_V(8); PG8_WAIT_L(0); PG8_BAR; PG8_MMA(1, 0, At, B0); PG8_MMA(1, 1, At, B1); PG8_BAR; PG8_SCHED;
            } else {
            PG8_LDB(B0, 0, 0); PG8_SCHED; PG8_LDA(At, 0, 0); PG8_STAGE(PG8_SA(1, 1), a1 + hstep, voffA);
            PG8_WAIT_L(8); PG8_BAR; PG8_WAIT_L(0); PG8_MMA(0, 0, At, B0); PG8_BAR; PG8_SCHED;
            PG8_LDB(B1, 0, 1); PG8_STAGE(PG8_SB(0, 0), b2, voffB);
            PG8_BAR; PG8_WAIT_L(0); PG8_MMA(0, 1, At, B1); PG8_BAR;
            PG8_LDA(At, 0, 1); PG8_STAGE(PG8_SA(0, 0), a2, voffA);
            PG8_BAR; PG8_WAIT_L(0); PG8_MMA(1, 0, At, B0); PG8_BAR; PG8_SCHED;
            PG8_STAGE(PG8_SB(0, 1), b2 + hstep, voffB);
            PG8_WAIT_V(6); PG8_BAR; PG8_MMA(1, 1, At, B1); PG8_BAR;
            PG8_LDB(B0, 1, 0); PG8_SCHED; PG8_LDA(At, 1, 0); PG8_STAGE(PG8_SA(0, 1), a2 + hstep, voffA);
            PG8_WAIT_L(8); PG8_BAR; PG8_WAIT_L(0); PG8_MMA(0, 0, At, B0); PG8_BAR; PG8_SCHED;
            PG8_LDB(B1, 1, 1); PG8_STAGE(PG8_SB(1, 0), b3, voffB);
            PG8_BAR; PG8_WAIT_L(0); PG8_MMA(0, 1, At, B1); PG8_BAR;
            PG8_LDA(At, 1, 1); PG8_STAGE(PG8_SA(1, 0), a3, voffA);
            PG8_BAR; PG8_WAIT_L(0); PG8_MMA(1, 0, At, B0); PG8_BAR; PG8_SCHED;
            PG8_STAGE(PG8_SB(1, 1), b3 + hstep, voffB);
            PG8_WAIT_V(6); PG8_BAR; PG8_MMA(1, 1, At, B1); PG8_BAR;

            }
        }
        if constexpr (ALIGN_EPI) { if (wr == 0) PG8_BAR; }
        E(acc, cur, wr, wc, fr, fq);
        if (!has_next) break;
#pragma unroll
        for (int a = 0; a < 2; ++a)
#pragma unroll
            for (int b = 0; b < 2; ++b)
#pragma unroll
                for (int m = 0; m < 4; ++m)
#pragma unroll
                    for (int n = 0; n < 2; ++n) acc[a][b][m][n] = (f32x4){0.f, 0.f, 0.f, 0.f};
        cur = nxt; cA = nA; cB = nB; ++ui;
        if constexpr (ALIGN_EPI) { if (wr == 1) PG8_BAR; }
    }
    PG8_WAIT_V(0);
    if constexpr (!ALIGN_EPI) { if (wr == 0) PG8_BAR; }
    PG8_BAR;
#undef PG8_SA
#undef PG8_SB
#undef PG8_STAGE
#undef PG8_LDA
#undef PG8_LDB
#undef PG8_MMA
#undef PG8_WAIT_V
#undef PG8_WAIT_L
#undef PG8_BAR
#undef PG8_SCHED
}
}
#define XB_TMO      128
#define XB_XCNT(j)  (256  + 64 * (j))
#define XB_XSUB(j)  (1280 + 64 * (j))
#define XB_XGEN(j)  (2304 + 64 * (j))
#define XB_TOP      3328
#define XB_TOPGEN   3392
#define XCD_BAR_WORDS 3456
#define XB_SPIN_CAP (1u << 18)

__device__ __forceinline__ unsigned xb_ld(unsigned* p)              { return __hip_atomic_load(p, __ATOMIC_RELAXED, __HIP_MEMORY_SCOPE_AGENT); }
__device__ __forceinline__ unsigned xb_add(unsigned* p, unsigned v) { return __hip_atomic_fetch_add(p, v, __ATOMIC_RELAXED, __HIP_MEMORY_SCOPE_AGENT); }
__device__ __forceinline__ unsigned xb_xcc_id() { return (unsigned)__builtin_amdgcn_s_getreg((3 << 11) | 20) & 0xFu; }
#define XB_SPIN(cond, bar) do { unsigned _sp = 0; while (cond) { __builtin_amdgcn_s_sleep(1); \
    if ((++_sp & 255u) == 0u) { if (xb_ld(&(bar)[XB_TMO])) break; if (_sp > XB_SPIN_CAP) { atomicAdd(&(bar)[XB_TMO], 1u); break; } } } } while (0)

struct XcdBarrier {
    unsigned* bar; unsigned x;
    volatile LAS unsigned* st;
};

__device__ __forceinline__ XcdBarrier xcd_barrier_post(unsigned* bar, volatile LAS unsigned* st) {
    XcdBarrier b; b.bar = bar; b.x = xb_xcc_id(); b.st = st;
    if (threadIdx.x == 0) (void)xb_add(&bar[XB_XCNT(b.x)], 1u);
    return b;
}
__device__ __forceinline__ void xcd_barrier_complete(unsigned* bar, unsigned x, unsigned& nloc, unsigned& nx) {
    const unsigned G = gridDim.x * gridDim.y * gridDim.z;
    unsigned sum, cnt, mine, sp = 0u;
    for (;;) {
        sum = 0u; cnt = 0u; mine = 0u;
#pragma unroll
        for (unsigned j = 0; j < 16; ++j) { const unsigned c = xb_ld(&bar[XB_XCNT(j)]); sum += c; cnt += (c > 0u) ? 1u : 0u; mine = (j == x) ? c : mine; }
        if (sum == G) break;
        __builtin_amdgcn_s_sleep(1);
        if ((++sp & 255u) == 0u) { if (xb_ld(&bar[XB_TMO])) break; if (sp > XB_SPIN_CAP) { atomicAdd(&bar[XB_TMO], 1u); break; } }
    }
    nloc = mine > 0u ? mine : 1u; nx = cnt > 0u ? cnt : 1u;
}

__device__ __forceinline__ void xcd_barrier(const XcdBarrier& b) {
    asm volatile("s_waitcnt vmcnt(0)" ::: "memory");
    __syncthreads();
    if (threadIdx.x == 0) {
        unsigned* bar = b.bar;
        __builtin_amdgcn_s_waitcnt(0);
        unsigned nloc = b.st[0], nx = b.st[1];
        if (nloc == 0u) { xcd_barrier_complete(bar, b.x, nloc, nx); b.st[0] = nloc; b.st[1] = nx; }
        const unsigned old = xb_add(&bar[XB_XSUB(b.x)], 1u);
        const unsigned gen = old / nloc;
        if (old + 1u == (gen + 1u) * nloc) {
            __builtin_amdgcn_fence(__ATOMIC_RELEASE, "agent");
            asm volatile("s_waitcnt vmcnt(0)" ::: "memory");
            const unsigned og = xb_add(&bar[XB_TOP], 1u);
            const unsigned tg = og / nx;
            if (og + 1u == (tg + 1u) * nx) xb_add(&bar[XB_TOPGEN], 1u);
            else XB_SPIN(xb_ld(&bar[XB_TOPGEN]) == tg, bar);
            __builtin_amdgcn_fence(__ATOMIC_ACQUIRE, "agent");
            xb_add(&bar[XB_XGEN(b.x)], 1u);
            asm volatile("s_waitcnt vmcnt(0)" ::: "memory");
        } else {
            XB_SPIN(xb_ld(&bar[XB_XGEN(b.x)]) == gen, bar);
            __builtin_amdgcn_fence(__ATOMIC_ACQUIRE, "agent");
            asm volatile("s_waitcnt vmcnt(0)" ::: "memory");
        }
    }
    __syncthreads();
}

enum { PH_CVT = 0, PH_PRE, PH_NORM1, PH_INPROJ, PH_NA, PH_HYPRE, PH_HYCONV, PH_RET, PH_GNORM, PH_OUT, PH_NORM2, PH_CQ, PH_CKV, PH_XATT, PH_CO, PH_ROUTER, PH_TOPK, PH_GATHER,
       PH_GU, PH_DOWN, PH_COMBINE, PH_KCOPY, N_PHASES };
constexpr int NTHR = 512, NWAVES = 8;
constexpr int LDS_BYTES = 150 * 1024;

struct Ctx { int tid, lane, wave, G, bid; LAS unsigned char* lds; };

__device__ __forceinline__ void cvt_item(const float* src, size_t stride, int cd0, int cds, int K, bf16_t* WT, LAS float* scr, int k0, int n0, int lane) {
    f32x4 v[16];
    const float* s0 = src + (size_t)(k0 + (lane >> 4)) * stride;
#pragma unroll
    for (int i = 0; i < 16; ++i) v[i] = __builtin_nontemporal_load((const f32x4*)(s0 + (size_t)(4 * i) * stride));
#pragma unroll
    for (int i = 0; i < 16; ++i) { LAS float* d = scr + ((lane >> 4) + 4 * i) * 65 + cd0;
        d[0] = v[i].x; d[cds] = v[i].y; d[2 * cds] = v[i].z; d[3 * cds] = v[i].w; }
    LDS_WAIT();
    const int c = lane >> 3, ns = lane & 7;
#pragma unroll
    for (int j = 0; j < 8; ++j) { const LAS float* s = scr + (8 * c) * 65 + ns + 8 * j;
        u32x4 o; o.x = pk2(s[0 * 65], s[1 * 65]); o.y = pk2(s[2 * 65], s[3 * 65]); o.z = pk2(s[4 * 65], s[5 * 65]); o.w = pk2(s[6 * 65], s[7 * 65]);
        *(u32x4*)(WT + (size_t)(n0 + ns + 8 * j) * K + k0 + 8 * c) = o; }
    LDS_WAIT();
}
__device__ __forceinline__ void ph_cvt(const PD& p, const Ctx& c) {
    LAS float* scr = (LAS float*)(c.lds) + c.wave * (64 * 65);
    const int gw = c.bid * NWAVES + c.wave, NGW = c.G * NWAVES;
    constexpr int I_IN = 32 * (PIN / 64), I_SQ = 32 * (DM / 64), I_KV = 32 * (4096 / 64), I_GU = NE * 32 * (4096 / 64), I_DN = NE * 32 * (DM / 64);
    constexpr int PER_LAYER = I_IN + 3 * I_SQ + I_KV + I_GU + I_DN;
    const int m = c.lane & 15;
    for (int it = gw; it < DEPTH * PER_LAYER; it += NGW) {
        const int l = it / PER_LAYER; int r = it % PER_LAYER;
        if (r < I_IN) { const int kb = r / (PIN / 64), nb = r % (PIN / 64); const int n0 = nb * 64;
            const float* W = p.in(I_W_IN) + (size_t)l * DM * PIN; bf16_t* WT = (bf16_t*)(p.ws() + WS_WIN) + (size_t)l * PIN * DM;
            if (n0 >= OFF_RQ && n0 < OFF_RV) {
                const int base = n0 & ~127, i0 = (n0 & 127) >> 1, s = m >> 3, mm = m & 7;
                cvt_item(W + base + 64 * s + i0 + 4 * mm, PIN, 8 * mm + s, 2, DM, WT, scr, kb * 64, n0, c.lane);
            } else cvt_item(W + n0 + 4 * m, PIN, 4 * m, 1, DM, WT, scr, kb * 64, n0, c.lane);
            continue; }
        r -= I_IN;
        if (r < 3 * I_SQ) { const int which = r / I_SQ; r %= I_SQ; const int kb = r / (DM / 64), nb = r % (DM / 64);
            const size_t wo = which == 0 ? WS_WOUT : (which == 1 ? WS_WCQ : WS_WCO);
            const float* W = (which == 0 ? p.in(I_W_OUT) : (which == 1 ? p.in(I_W_CQ) : p.in(I_W_CO))) + (size_t)l * DM * DM; bf16_t* WT = (bf16_t*)(p.ws() + wo) + (size_t)l * DM * DM;
            cvt_item(W + nb * 64 + 4 * m, DM, 4 * m, 1, DM, WT, scr, kb * 64, nb * 64, c.lane); continue; }
        r -= 3 * I_SQ;
        if (r < I_KV) { const int kb = r / 64, nb = r % 64;
            const float* W = p.in(I_W_CKV) + (size_t)l * DM * 4096; bf16_t* WT = (bf16_t*)(p.ws() + WS_WCKV) + (size_t)l * 4096 * DM;
            cvt_item(W + nb * 64 + 4 * m, 4096, 4 * m, 1, DM, WT, scr, kb * 64, nb * 64, c.lane); continue; }
        r -= I_KV;
        if (r < I_GU) { const int e = r / (32 * 64); r %= (32 * 64); const int kb = r / 64, nb = r % 64;
            const int n0 = nb * 64, j = n0 >> 8, half = (n0 >> 7) & 1, f = 128 * j + (n0 & 127);
            const float* W = (half ? p.in(I_W_UP) : p.in(I_W_GATE)) + ((size_t)l * NE + e) * DM * FF;
            bf16_t* WT = (bf16_t*)(p.ws() + WS_WGU) + ((size_t)l * NE + e) * 4096 * DM;
            cvt_item(W + f + 4 * m, FF, 4 * m, 1, DM, WT, scr, kb * 64, n0, c.lane); continue; }
        r -= I_GU;
        { const int e = r / (32 * 32); r %= (32 * 32); const int kb = r / 32, nb = r % 32;
            const float* W = p.in(I_W_DOWN) + ((size_t)l * NE + e) * FF * DM; bf16_t* WT = (bf16_t*)(p.ws() + WS_WDN) + ((size_t)l * NE + e) * DM * FF;
            cvt_item(W + nb * 64 + 4 * m, DM, 4 * m, 1, FF, WT, scr, kb * 64, nb * 64, c.lane); }
    }
}

__device__ __forceinline__ void row_load_f32(const float* row, int lane, f32x4 (&v)[8]) {
#pragma unroll
    for (int j = 0; j < 8; ++j) v[j] = *(const f32x4*)(row + 256 * j + 4 * lane);
}
__device__ __forceinline__ float row_ssq(const f32x4 (&v)[8]) {
    float s = 0.f;
#pragma unroll
    for (int j = 0; j < 8; ++j) s += (v[j].x * v[j].x + v[j].y * v[j].y) + (v[j].z * v[j].z + v[j].w * v[j].w);
    return wave_sum(s);
}
__device__ __forceinline__ void row_store_bf16(bf16_t* row, int lane, const f32x4 (&v)[8]) {
#pragma unroll
    for (int j = 0; j < 8; ++j) { u32x2 o; o.x = pk2(v[j].x, v[j].y); o.y = pk2(v[j].z, v[j].w); *(u32x2*)(row + 256 * j + 4 * lane) = o; }
}
__device__ __forceinline__ void rmsnorm_row_to_bf16(const float* xrow, const float* gain, bf16_t* orow, int lane) {
    f32x4 v[8]; row_load_f32(xrow, lane, v);
    const float rstd = rsqrtf(row_ssq(v) * (1.f / DM) + RMS_EPS);
#pragma unroll
    for (int j = 0; j < 8; ++j) { const f32x4 g = *(const f32x4*)(gain + 256 * j + 4 * lane); v[j] = v[j] * rstd * g; }
    row_store_bf16(orow, lane, v);
}

__device__ __forceinline__ void ph_pre(const PD& p, const Ctx& c) {
    const int gw = c.bid * NWAVES + c.wave, NGW = c.G * NWAVES;
    for (int m = gw; m < NB * NMEM; m += NGW) rmsnorm_row_to_bf16(p.in(I_MEM) + (size_t)m * DM, p.in(I_MEM_NORM), (bf16_t*)(p.ws() + WS_MEMN) + (size_t)m * DM, c.lane);
    { const f32x4* s = (const f32x4*)p.in(I_X); f32x4* d = (f32x4*)(p.ws() + WS_XRES);
      for (size_t i = (size_t)c.bid * NTHR + c.tid; i < (size_t)NT * DM / 4; i += (size_t)c.G * NTHR) d[i] = s[i]; }
    { float* ct = (float*)(p.ws() + WS_ROT); float* st = ct + SEQ * 64;
      for (int i = c.bid * NTHR + c.tid; i < SEQ * 64; i += c.G * NTHR) { const int pos = i >> 6, k = i & 63;
          const float lin = (float)k / 63.0f; const float inv = 1.0f / powf(10000.0f, lin); const float ang = (float)pos * inv;
          ct[i] = (float)cos((double)ang); st[i] = (float)sin((double)ang); } }
    LAS float* sm = (LAS float*)c.lds;
    for (int u = c.bid; u < DEPTH * (SEQ / 16); u += c.G) {
        const int l = u / (SEQ / 16), t0 = (u % (SEQ / 16)) * 16;
        __syncthreads();
        if (c.tid < 16 * 17) { const int tt = c.tid / 17, k = c.tid % 17; const int t = t0 + tt; float f;
            if (k == 0) f = (float)t / (float)(SEQ - 1);
            else { const int i = (k - 1) & 7; const float band = 1e-4f + (float)i * ((7.0f - 1e-4f) / 7.0f);
                   const float ang = (2.0f * 3.14159265358979323846f) * ((float)t / (float)SEQ) * band;
                   f = (k <= 8) ? cosf(ang) : -sinf(ang); }
            sm[tt * 20 + k] = f; }
        __syncthreads();
        for (int q = c.tid; q < 16 * 64; q += NTHR) { const int tt = q >> 6, jj = q & 63; const float* w1 = p.in(I_HY_W1) + (size_t)l * 17 * 64; float a = p.in(I_HY_B1)[l * 64 + jj];
            for (int i = 0; i < 17; ++i) a += sm[tt * 20 + i] * w1[i * 64 + jj];
            sm[512 + q] = sinf(p.in(I_HY_FREQ)[l * 64 + jj] * a); }
        __syncthreads();
        for (int q = c.tid; q < 16 * 64; q += NTHR) { const int tt = q >> 6, jj = q & 63; const float* w2 = p.in(I_HY_W2) + (size_t)l * 64 * 64; float a = p.in(I_HY_B2)[l * 64 + jj];
            for (int i = 0; i < 64; ++i) a += sm[512 + tt * 64 + i] * w2[i * 64 + jj];
            sm[2048 + q] = sinf(p.in(I_HY_FREQ)[l * 64 + jj] * a); }
        __syncthreads();
        const float* w3 = p.in(I_HY_W3) + (size_t)l * 64 * 2048;
        float* kf = (float*)(p.ws() + WS_KF) + (size_t)l * 2 * 512 * 4096;
        const float min_decay = logf(1e-2f) / 1.5f, max_decay = logf(1e-2f) / 0.3f;
#pragma unroll 1
        for (int q = 0; q < 4; ++q) { const int n = c.tid + NTHR * q;
            float acc[16];
#pragma unroll
            for (int tt = 0; tt < 16; ++tt) acc[tt] = 0.f;
            for (int i = 0; i < 64; ++i) { const float wv = w3[i * 2048 + n];
#pragma unroll
                for (int tt = 0; tt < 16; ++tt) acc[tt] += sm[2048 + tt * 64 + i] * wv; }
            const int o = n >> 10, dir = (n >> 9) & 1, ch = n & 511;
            const float delta = fabsf(min_decay + (max_decay - min_decay) * ((float)ch / 511.0f));
            float* kc = kf + ((size_t)o * 512 + ch) * 4096;
#pragma unroll
            for (int tt = 0; tt < 16; ++tt) { const int t = t0 + tt; const float a = acc[tt] * expf(-((float)t / (float)(SEQ - 1)) * delta);
                if (dir == 0) kc[2048 + t] = a; else { if (t >= 1) kc[2048 - t] = a; else kc[0] = 0.f; } } }
    }
}

__device__ __forceinline__ void ph_norm(const PD& p, const Ctx& c, const float* gain) {
    const int gw = c.bid * NWAVES + c.wave, NGW = c.G * NWAVES;
    for (int m = gw; m < NT; m += NGW) rmsnorm_row_to_bf16((const float*)(p.ws() + WS_XRES) + (size_t)m * DM, gain, (bf16_t*)(p.ws() + WS_HN) + (size_t)m * DM, c.lane);
}

struct EpiInProj {
    static constexpr bool PERM = true;
    bf16_t* O; const float* rc; const float* rs;
    __device__ __forceinline__ void operator()(const f32x4 (&acc)[2][2][4][2], const pg8::Unit& u, int wr, int wc, int fr, int fq) const {
        const int row0 = u.pm * 256 + wr * 64 + fr, col0 = u.pn * 256 + wc * 32 + 8 * fq;
        const bool rot = (u.pn >= OFF_RQ / 256) && (u.pn < OFF_RV / 256);
        const float qs = (u.pn < OFF_RK / 256) ? 0.08838834764831845f : 1.0f;
#pragma unroll
        for (int ai = 0; ai < 2; ++ai)
#pragma unroll
            for (int m = 0; m < 4; ++m) { const int row = row0 + ai * 128 + m * 16; bf16_t* rowp = O + (size_t)row * PIN + col0;
#pragma unroll
                for (int bj = 0; bj < 2; ++bj) { f32x4 v0 = acc[ai][bj][m][0], v1 = acc[ai][bj][m][1];
                    if (rot) { const int pos = row & (SEQ - 1); const int i0 = ((col0 + bj * 128) & 127) >> 1;
                        const f32x4 cs = *(const f32x4*)(rc + pos * 64 + i0), sn = *(const f32x4*)(rs + pos * 64 + i0);
                        f32x4 r0, r1;
                        r0.x = (v0.x * cs.x - v0.y * sn.x) * qs; r0.y = (v0.x * sn.x + v0.y * cs.x) * qs;
                        r0.z = (v0.z * cs.y - v0.w * sn.y) * qs; r0.w = (v0.z * sn.y + v0.w * cs.y) * qs;
                        r1.x = (v1.x * cs.z - v1.y * sn.z) * qs; r1.y = (v1.x * sn.z + v1.y * cs.z) * qs;
                        r1.z = (v1.z * cs.w - v1.w * sn.w) * qs; r1.w = (v1.z * sn.w + v1.w * cs.w) * qs;
                        v0 = r0; v1 = r1; }
                    u32x4 w; w.x = cvt_pk_bf16(v0.x, v0.y); w.y = cvt_pk_bf16(v0.z, v0.w); w.z = cvt_pk_bf16(v1.x, v1.y); w.w = cvt_pk_bf16(v1.z, v1.w);
                    *(u32x4*)(rowp + bj * 128) = w; } }
    }
};
struct EpiBf16 {
    static constexpr bool PERM = true;
    bf16_t* O; int ldc;
    __device__ __forceinline__ void operator()(const f32x4 (&acc)[2][2][4][2], const pg8::Unit& u, int wr, int wc, int fr, int fq) const {
        const int row0 = u.pm * 256 + wr * 64 + fr, col0 = u.pn * 256 + wc * 32 + 8 * fq;
#pragma unroll
        for (int ai = 0; ai < 2; ++ai)
#pragma unroll
            for (int m = 0; m < 4; ++m) { bf16_t* rowp = O + (size_t)(row0 + ai * 128 + m * 16) * ldc + col0;
#pragma unroll
                for (int bj = 0; bj < 2; ++bj) { const f32x4 v0 = acc[ai][bj][m][0], v1 = acc[ai][bj][m][1];
                    u32x4 w; w.x = cvt_pk_bf16(v0.x, v0.y); w.y = cvt_pk_bf16(v0.z, v0.w); w.z = cvt_pk_bf16(v1.x, v1.y); w.w = cvt_pk_bf16(v1.z, v1.w);
                    *(u32x4*)(rowp + bj * 128) = w; } }
    }
};
struct EpiResid {
    static constexpr bool PERM = false;
    float* X;
    __device__ __forceinline__ void operator()(const f32x4 (&acc)[2][2][4][2], const pg8::Unit& u, int wr, int wc, int fr, int fq) const {
        const int row0 = u.pm * 256 + wr * 64 + fr, col0 = u.pn * 256 + wc * 32 + 4 * fq;
#pragma unroll
        for (int ai = 0; ai < 2; ++ai)
#pragma unroll
            for (int m = 0; m < 4; ++m) { float* rowp = X + (size_t)(row0 + ai * 128 + m * 16) * DM + col0;
#pragma unroll
                for (int bj = 0; bj < 2; ++bj)
#pragma unroll
                    for (int n = 0; n < 2; ++n) { f32x4* q = (f32x4*)(rowp + bj * 128 + n * 16); *q = *q + acc[ai][bj][m][n]; } }
    }
};
struct EpiGU {
    static constexpr bool PERM = true;
    bf16_t* O; int npn;
    __device__ __forceinline__ void operator()(const f32x4 (&acc)[2][2][4][2], const pg8::Unit& u, int wr, int wc, int fr, int fq) const {
        const int row0 = u.pm * 256 + wr * 64 + fr, col0 = (u.pn % npn) * 128 + wc * 32 + 8 * fq;
#pragma unroll
        for (int ai = 0; ai < 2; ++ai)
#pragma unroll
            for (int m = 0; m < 4; ++m) { bf16_t* rowp = O + (size_t)(row0 + ai * 128 + m * 16) * FF + col0;
                float h[8];
#pragma unroll
                for (int n = 0; n < 2; ++n)
#pragma unroll
                    for (int j = 0; j < 4; ++j) { const float a = acc[ai][0][m][n][j], b = acc[ai][1][m][n][j]; h[n * 4 + j] = a / (1.0f + __expf(-a)) * b; }
                u32x4 w; w.x = cvt_pk_bf16(h[0], h[1]); w.y = cvt_pk_bf16(h[2], h[3]); w.z = cvt_pk_bf16(h[4], h[5]); w.w = cvt_pk_bf16(h[6], h[7]);
                *(u32x4*)rowp = w; }
    }
};
struct EpiDown {
    static constexpr bool PERM = false;
    float* Y; int npn;
    __device__ __forceinline__ void operator()(const f32x4 (&acc)[2][2][4][2], const pg8::Unit& u, int wr, int wc, int fr, int fq) const {
        const int row0 = u.pm * 256 + wr * 64 + fr, col0 = (u.pn % npn) * 256 + wc * 32 + 4 * fq;
#pragma unroll
        for (int ai = 0; ai < 2; ++ai)
#pragma unroll
            for (int m = 0; m < 4; ++m) { float* rowp = Y + (size_t)(row0 + ai * 128 + m * 16) * DM + col0;
#pragma unroll
                for (int bj = 0; bj < 2; ++bj)
#pragma unroll
                    for (int n = 0; n < 2; ++n) *(f32x4*)(rowp + bj * 128 + n * 16) = acc[ai][bj][m][n]; }
    }
};

typedef float f32x16 __attribute__((ext_vector_type(16)));
typedef short s16x4 __attribute__((ext_vector_type(4)));
__device__ __forceinline__ bf16x8 as_bf16x8(const u32x4 v) { union { u32x4 u; bf16x8 b; } x; x.u = v; return x.b; }
__device__ __forceinline__ bf16x8 tr_pair(const LAS unsigned char* a0, const LAS unsigned char* a1) {
    const s16x4 lo = __builtin_amdgcn_ds_read_tr16_b64_v4i16((LAS s16x4*)a0), hi = __builtin_amdgcn_ds_read_tr16_b64_v4i16((LAS s16x4*)a1);
    return (bf16x8){lo.x, lo.y, lo.z, lo.w, hi.x, hi.y, hi.z, hi.w};
}
constexpr int NA_TILE_B = 9 * 64 * 128;
__device__ __forceinline__ void ph_na(const PD& p, const Ctx& c, int l) {
    const bf16_t* proj = (const bf16_t*)(p.ws() + WS_PROJ); bf16_t* ycat = (bf16_t*)(p.ws() + WS_YCAT);
    LAS unsigned char* L = c.lds; LAS float* Brp = (LAS float*)(L + 2 * NA_TILE_B);
    const int lane = c.lane, w = c.wave, qc = lane & 15, g = lane >> 4, j = w & 3;
    const int tq = (lane & 15) >> 2, tp = lane & 3, fvh = 2 * (g & 1) + (tq >> 1);
    const int kc0 = min(max(16 * j - 8, 0), 32);
    int lbV[4];
#pragma unroll
    for (int db = 0; db < 4; ++db) lbV[db] = NA_TILE_B + (4 * g + tq) * 128 + 16 * (2 * (db ^ fvh) + (tp >> 1)) + 8 * (tp & 1);
    const int qcol = 16 * j + qc, cs = min(max(qcol - 8, 0), 48);
    for (int u = c.bid; u < NB * NAH * (ROWS / 2); u += c.G) {
        const int rp = u % (ROWS / 2), h = (u / (ROWS / 2)) % NAH, b = u / ((ROWS / 2) * NAH);
        const int r0 = 2 * rp, R0 = min(max(r0 - 4, 0), ROWS - 8), nvalid = min(9, ROWS - R0) * 64;
        const int rr = r0 + (w >> 2), rsw = min(max(rr - 4, 0), ROWS - 8);
        const size_t tok0 = (size_t)b * SEQ + R0 * 64;
        __syncthreads();
#pragma unroll
        for (int i = 0; i < 9; ++i) { const int idx = (8 * i + w) * 8 + (lane >> 3), ps = lane & 7; const int isrc = min(idx, nvalid - 1);
            const bf16_t* rsrc = proj + (tok0 + isrc) * PIN + h * 64;
            __builtin_amdgcn_global_load_lds((const GAS unsigned*)(rsrc + OFF_NAK + 8 * (ps ^ ((idx >> 1) & 7))), (LAS unsigned*)(L + (8 * i + w) * 1024), 16, 0, 0);
            __builtin_amdgcn_global_load_lds((const GAS unsigned*)(rsrc + OFF_NAV + 8 * (ps ^ (((idx >> 1) & 3) << 1))), (LAS unsigned*)(L + NA_TILE_B + (8 * i + w) * 1024), 16, 0, 0); }
        { const float* rpb = p.in(I_NA_RPB) + ((size_t)l * NAH + h) * 15 * 31; if (c.tid < 15 * 31) Brp[c.tid] = rpb[c.tid]; }
        const size_t tok = (size_t)b * SEQ + rr * 64 + qcol;
        bf16x8 qf[2];
        { const bf16_t* qrow = proj + tok * PIN + OFF_NAQ + h * 64 + 8 * g; qf[0] = as_bf16x8(*(const u32x4*)qrow); qf[1] = as_bf16x8(*(const u32x4*)(qrow + 32)); }
        asm volatile("s_waitcnt vmcnt(0)" ::: "memory");
        __syncthreads();
        f32x4 acc[16];
        const int trow0 = rsw - R0;
#pragma unroll
        for (int kb = 0; kb < 16; ++kb) { const int idx = (trow0 + (kb >> 1)) * 64 + kc0 + 16 * (kb & 1) + qc;
            const LAS unsigned char* kr = L + idx * 128; const int f = (idx >> 1) & 7;
            f32x4 a4 = (f32x4){0.f, 0.f, 0.f, 0.f};
            a4 = __builtin_amdgcn_mfma_f32_16x16x32_bf16(*(const LAS bf16x8*)(kr + 16 * ((0 + g) ^ f)), qf[0], a4, 0, 0, 0);
            a4 = __builtin_amdgcn_mfma_f32_16x16x32_bf16(*(const LAS bf16x8*)(kr + 16 * ((4 + g) ^ f)), qf[1], a4, 0, 0, 0);
            acc[kb] = a4; }
        float m = -INFINITY;
#pragma unroll
        for (int kb = 0; kb < 16; ++kb) { const int krow = rsw + (kb >> 1); const LAS float* brow = Brp + (krow - rr + 7) * 31 + 15 - qcol;
#pragma unroll
            for (int r = 0; r < 4; ++r) { const int kc = kc0 + 16 * (kb & 1) + 4 * g + r; const bool ok = (kc >= cs) && (kc < cs + 16);
                const float s = ok ? acc[kb][r] * 0.125f + brow[ok ? kc : qcol] : -INFINITY; acc[kb][r] = s; m = fmaxf(m, s); } }
        m = fmaxf(m, __shfl_xor(m, 16)); m = fmaxf(m, __shfl_xor(m, 32));
        float sum = 0.f;
#pragma unroll
        for (int kb = 0; kb < 16; ++kb)
#pragma unroll
            for (int r = 0; r < 4; ++r) { const float e = __builtin_amdgcn_exp2f((acc[kb][r] - m) * 1.4426950408889634f); acc[kb][r] = e; sum += e; }
        sum += __shfl_xor(sum, 16); sum += __shfl_xor(sum, 32);
        const float inv = 1.0f / sum;
        f32x4 o[4];
#pragma unroll
        for (int db = 0; db < 4; ++db) o[db] = (f32x4){0.f, 0.f, 0.f, 0.f};
#pragma unroll
        for (int s = 0; s < 8; ++s) { u32x4 wv;
            wv.x = cvt_pk_bf16(acc[2 * s][0] * inv, acc[2 * s][1] * inv); wv.y = cvt_pk_bf16(acc[2 * s][2] * inv, acc[2 * s][3] * inv);
            wv.z = cvt_pk_bf16(acc[2 * s + 1][0] * inv, acc[2 * s + 1][1] * inv); wv.w = cvt_pk_bf16(acc[2 * s + 1][2] * inv, acc[2 * s + 1][3] * inv);
            const bf16x8 pbv = as_bf16x8(wv);
            const int rb = ((trow0 + s) * 64 + kc0) * 128;
#pragma unroll
            for (int db = 0; db < 4; ++db) { const bf16x8 av = tr_pair(L + lbV[db] + rb, L + lbV[db] + rb + 16 * 128);
                o[db] = __builtin_amdgcn_mfma_f32_16x16x32_bf16(av, pbv, o[db], 0, 0, 0); } }
        bf16_t* yrow = ycat + tok * DM + h * 64 + 4 * g;
#pragma unroll
        for (int db = 0; db < 4; ++db) { u32x2 wv; wv.x = cvt_pk_bf16(o[db][0], o[db][1]); wv.y = cvt_pk_bf16(o[db][2], o[db][3]); *(u32x2*)(yrow + 16 * db) = wv; }
    }
}

__device__ __forceinline__ void ph_hypre(const PD& p, const Ctx& c, int l) {
    const bf16_t* proj = (const bf16_t*)(p.ws() + WS_PROJ); bf16_t* hs = (bf16_t*)(p.ws() + WS_HS);
    LAS float* U = (LAS float*)c.lds;
    const float* cw = p.in(I_HY_CONV_W) + (size_t)l * 3 * 1536; const float* cb = p.in(I_HY_CONV_B) + (size_t)l * 1536;
    for (int u = c.bid; u < NB * 32 * 24; u += c.G) {
        const int cg = u % 24, tt = (u / 24) % 32, b = u / (24 * 32); const int t0 = tt * 64;
        __syncthreads();
        for (int idx = c.tid; idx < 66 * 64; idx += NTHR) { const int rr = idx >> 6, cc = idx & 63; const int t = t0 - 1 + rr;
            U[rr * 65 + cc] = (t >= 0 && t < SEQ) ? bf2f(proj[(size_t)(b * SEQ + t) * PIN + OFF_HY + cg * 64 + cc]) : 0.f; }
        __syncthreads();
        for (int idx = c.tid; idx < 64 * 64; idx += NTHR) { const int tl = idx & 63, cc = idx >> 6; const int ch = cg * 64 + cc;
            const float s = U[tl * 65 + cc] * cw[ch] + U[(tl + 1) * 65 + cc] * cw[1536 + ch] + U[(tl + 2) * 65 + cc] * cw[3072 + ch] + cb[ch];
            hs[((size_t)b * 1536 + ch) * SEQ + t0 + tl] = (bf16_t)f2bf(s); }
    }
}

__device__ __forceinline__ void ph_kcopy(const PD& p, const Ctx& c) {
    LAS float* kf = (LAS float*)c.lds;
    for (int u = c.bid; u < DEPTH * 2 * HYW; u += c.G) {
        const float* src = (const float*)(p.ws() + WS_KF) + (size_t)u * 4096; bf16_t* dst = (bf16_t*)(p.ws() + WS_KFB) + (size_t)u * 4 * KFC;
        __syncthreads();
        for (int i = c.tid; i < 1024; i += NTHR) *(LAS f32x4*)(kf + 4 * i) = *(const f32x4*)(src + 4 * i);
        __syncthreads();
        for (int q = c.tid; q < 4 * (KFC / 8); q += NTHR) { const int rho = q / (KFC / 8), x0 = (q % (KFC / 8)) * 8; float v[8];
#pragma unroll
            for (int e = 0; e < 8; ++e) { const int x = x0 + e - rho; v[e] = (x >= 1 && x <= 4095) ? kf[4096 - x] : 0.f; }
            u32x4 o; o.x = pk2(v[0], v[1]); o.y = pk2(v[2], v[3]); o.z = pk2(v[4], v[5]); o.w = pk2(v[6], v[7]);
            *(u32x4*)(dst + rho * KFC + x0) = o; }
    }
}

constexpr int HY_ZP = 2496, HY_ZPB = HY_ZP * 2 + 16;
constexpr int HY_KRB = KFC * 2;
constexpr int HY_LDS_KR0 = 0, HY_LDS_KR1 = 4 * HY_KRB, HY_LDS_Z = 8 * HY_KRB;
__device__ __forceinline__ void ph_hyconv(const PD& p, const Ctx& c, int l) {
    const bf16_t* hs = (const bf16_t*)(p.ws() + WS_HS); bf16_t* ycat = (bf16_t*)(p.ws() + WS_YCAT);
    LAS unsigned char* L = c.lds;
    const int lane = c.lane, w = c.wave, a = lane & 31, hh = lane >> 5, nb = a >> 3, il = a & 7;
    const int laneA = (a & 3) * HY_KRB + 2 * (2048 + 8 * hh - 4 * (a >> 2));
    const int laneB = HY_LDS_Z + nb * HY_ZPB + 2 * (224 + 32 * (8 * w + il) + 8 * hh);
    for (int u = c.bid; u < HYW; u += c.G) {
        const int ch = u;
        __syncthreads();
        { const u32x4* s0 = (const u32x4*)((const bf16_t*)(p.ws() + WS_KFB) + (((size_t)l * 2 + 0) * HYW + ch) * 4 * KFC);
          const u32x4* s1 = (const u32x4*)((const bf16_t*)(p.ws() + WS_KFB) + (((size_t)l * 2 + 1) * HYW + ch) * 4 * KFC);
          for (int i = c.tid; i < 4 * HY_KRB / 16; i += NTHR) { *(LAS u32x4*)(L + HY_LDS_KR0 + 16 * i) = s0[i]; *(LAS u32x4*)(L + HY_LDS_KR1 + 16 * i) = s1[i]; }
          for (int i = c.tid; i < NB * (SEQ / 8); i += NTHR) { const int b = i >> 8, t8 = i & 255;
              *(LAS u32x4*)(L + HY_LDS_Z + b * HY_ZPB + 2 * (224 + 8 * t8)) = *(const u32x4*)(hs + ((size_t)b * 1536 + 1024 + ch) * SEQ + 8 * t8); }
          for (int i = c.tid; i < NB * 2 * 28; i += NTHR) { const int b = i / 56, r = i % 56; const int e0 = r < 28 ? 8 * r : 224 + SEQ + 8 * (r - 28);
              *(LAS u32x4*)(L + HY_LDS_Z + b * HY_ZPB + 2 * e0) = (u32x4){0u, 0u, 0u, 0u}; } }
        __syncthreads();
#pragma unroll 1
        for (int o = 0; o < 2; ++o) {
            const LAS unsigned char* KR = L + (o ? HY_LDS_KR1 : HY_LDS_KR0) + laneA;
            f32x16 acc;
#pragma unroll
            for (int r = 0; r < 16; ++r) acc[r] = 0.f;
            asm volatile("" : "+v"(acc));
            const int d_lo = 8 * w - 63, d_hi = 8 * w + 7;
#pragma unroll 2
            for (int delta = d_lo; delta <= d_hi; ++delta) {
                const LAS unsigned char* ka = KR - 64 * delta; const LAS unsigned char* zb = L + laneB - 64 * delta;
#pragma unroll
                for (int sp = 0; sp < 2; ++sp) {
                    const u32x2 a0 = *(const LAS u32x2*)(ka + 32 * sp), a1 = *(const LAS u32x2*)(ka + 32 * sp + 8);
                    const bf16x8 av = as_bf16x8((u32x4){a0.x, a0.y, a1.x, a1.y});
                    const bf16x8 bv = *(const LAS bf16x8*)(zb + 32 * sp);
                    acc = __builtin_amdgcn_mfma_f32_32x32x16_bf16(av, bv, acc, 0, 0, 0); } }
            __syncthreads();
            const float sd = p.in(I_HY_SKIP)[((size_t)l * 2 + o) * HYW + ch];
            const int tb = 32 * (8 * w + il) + 4 * hh;
            const bf16_t* gsrc = hs + ((size_t)nb * 1536 + o * 512 + ch) * SEQ + tb;
            LAS unsigned char* zrow = L + HY_LDS_Z + nb * HY_ZPB + 2 * (224 + tb);
#pragma unroll
            for (int i4 = 0; i4 < 4; ++i4) { const u32x2 gv = *(const u32x2*)(gsrc + 8 * i4); const u32x2 zv = *(const LAS u32x2*)(zrow + 16 * i4);
                const float g0 = bf2f(gv.x & 0xffffu), g1 = bf2f(gv.x >> 16), g2 = bf2f(gv.y & 0xffffu), g3 = bf2f(gv.y >> 16);
                const float z0 = bf2f(zv.x & 0xffffu), z1 = bf2f(zv.x >> 16), z2 = bf2f(zv.y & 0xffffu), z3 = bf2f(zv.y >> 16);
                const float r0 = g0 * (acc[4 * i4 + 0] + sd * z0), r1 = g1 * (acc[4 * i4 + 1] + sd * z1), r2 = g2 * (acc[4 * i4 + 2] + sd * z2), r3 = g3 * (acc[4 * i4 + 3] + sd * z3);
                if (o == 0) { u32x2 wv; wv.x = cvt_pk_bf16(r0, r1); wv.y = cvt_pk_bf16(r2, r3); *(LAS u32x2*)(zrow + 16 * i4) = wv; }
                else { bf16_t* yo = ycat + (size_t)(nb * SEQ + tb + 8 * i4) * DM + NAW + ch;
                    yo[0] = (bf16_t)f2bf(r0); yo[DM] = (bf16_t)f2bf(r1); yo[2 * DM] = (bf16_t)f2bf(r2); yo[3 * DM] = (bf16_t)f2bf(r3); } }
            __syncthreads();
        }
    }
}

__device__ __forceinline__ void ph_ret(const PD& p, const Ctx& c, int l) {
    const bf16_t* proj = (const bf16_t*)(p.ws() + WS_PROJ); bf16_t* ycat = (bf16_t*)(p.ws() + WS_YCAT);
    LAS unsigned char* L = c.lds;
    const int lane = c.lane, cc = lane & 31, hh = lane >> 5, w = c.wave;
    const int tq = (lane & 15) >> 2, tp = lane & 3, tblk = (lane >> 4) & 1;
    int lbV[4];
#pragma unroll
    for (int c4 = 0; c4 < 4; ++c4) lbV[c4] = 256 * (4 * hh + tq) + 16 * (((c4 ^ tq) << 2) | (2 * tblk + (tp >> 1))) + 8 * (tp & 1);
    const int kA = cc * 256, kX = cc & 15;
    const int g_row0 = w * 4 + (lane >> 4), g_ps = lane & 15;
    for (int u = c.bid; u < NB * RETH * 8; u += c.G) {
        const int qt = u & 7, h = (u >> 3) % RETH, b = u / (8 * RETH);
        const int tw0 = qt * 256 + 32 * w;
        const float lf2 = log2f(1.0f - exp2f(-5.0f - (float)h)), lb2 = log2f(1.0f - exp2f(-5.5f - (float)h));
        float Gf1[4], Gf8[4], Gb1[4], Gb8[4];
#pragma unroll
        for (int j = 0; j < 4; ++j) { Gf1[j] = exp2f(-lf2 * (float)j); Gf8[j] = exp2f(-lf2 * (float)(8 * j)); Gb1[j] = exp2f(lb2 * (float)j); Gb8[j] = exp2f(lb2 * (float)(8 * j)); }
        const bf16_t* kvb = proj + (size_t)(b * SEQ) * PIN + h * RETD;
#define RT_ISSUE(kt) do { _Pragma("unroll") for (int _i = 0; _i < 2; ++_i) { const int _row = g_row0 + 32 * _i; const bf16_t* _r = kvb + (size_t)(64 * (kt) + _row) * PIN; \
            __builtin_amdgcn_global_load_lds((const GAS unsigned*)(_r + OFF_RK + 8 * (g_ps ^ (_row & 15))), (LAS unsigned*)(L + ((kt) & 1) * 32768 + (8 * _i + w) * 1024), 16, 0, 0); \
            __builtin_amdgcn_global_load_lds((const GAS unsigned*)(_r + OFF_RV + 8 * (g_ps ^ ((_row & 3) << 2))), (LAS unsigned*)(L + ((kt) & 1) * 32768 + 16384 + (8 * _i + w) * 1024), 16, 0, 0); } } while (0)
        __syncthreads();
        RT_ISSUE(0);
        const size_t tok = (size_t)b * SEQ + tw0 + cc;
        bf16x8 qf[8];
        { const bf16_t* qrow = proj + tok * PIN + OFF_RQ + h * RETD + 8 * hh;
#pragma unroll
          for (int ks = 0; ks < 8; ++ks) qf[ks] = as_bf16x8(*(const u32x4*)(qrow + 16 * ks)); }
        f32x16 o[4];
#pragma unroll
        for (int c4 = 0; c4 < 4; ++c4) {
#pragma unroll
            for (int r = 0; r < 16; ++r) o[c4][r] = 0.f;
            asm volatile("" : "+v"(o[c4])); }
        asm volatile("s_waitcnt vmcnt(0)" ::: "memory");
        __syncthreads();
#pragma unroll 1
        for (int kt = 0; kt < SEQ / 64; ++kt) {
            if (kt + 1 < SEQ / 64) RT_ISSUE(kt + 1);
            const LAS unsigned char* Kt = L + (kt & 1) * 32768; const LAS unsigned char* Vt = Kt + 16384;
            f32x16 s[2];
#pragma unroll
            for (int kb = 0; kb < 2; ++kb) {
#pragma unroll
                for (int r = 0; r < 16; ++r) s[kb][r] = 0.f;
                asm volatile("" : "+v"(s[kb])); }
#pragma unroll
            for (int ks = 0; ks < 8; ++ks) { const LAS unsigned char* Ka = Kt + kA + 16 * ((2 * ks + hh) ^ kX);
#pragma unroll
                for (int kb = 0; kb < 2; ++kb) s[kb] = __builtin_amdgcn_mfma_f32_32x32x16_bf16(*(const LAS bf16x8*)(Ka + kb * 8192), qf[ks], s[kb], 0, 0, 0); }
            const int s0 = 64 * kt;
            if (s0 + 63 <= tw0) {
#pragma unroll
                for (int kb = 0; kb < 2; ++kb) { const float E = __builtin_amdgcn_exp2f(lf2 * (float)(tw0 + cc - (s0 + 32 * kb + 4 * hh)));
#pragma unroll
                    for (int i4 = 0; i4 < 4; ++i4) { const float e8 = E * Gf8[i4];
#pragma unroll
                        for (int j = 0; j < 4; ++j) s[kb][4 * i4 + j] *= e8 * Gf1[j]; } }
            } else if (s0 > tw0 + 31) {
#pragma unroll
                for (int kb = 0; kb < 2; ++kb) { const float E = __builtin_amdgcn_exp2f(lb2 * (float)((s0 + 32 * kb + 4 * hh) - (tw0 + cc)));
#pragma unroll
                    for (int i4 = 0; i4 < 4; ++i4) { const float e8 = E * Gb8[i4];
#pragma unroll
                        for (int j = 0; j < 4; ++j) s[kb][4 * i4 + j] *= e8 * Gb1[j]; } }
            } else {
#pragma unroll
                for (int kb = 0; kb < 2; ++kb)
#pragma unroll
                    for (int r = 0; r < 16; ++r) { const int diff = (tw0 + cc) - (s0 + 32 * kb + 4 * hh + (r & 3) + 8 * (r >> 2));
                        s[kb][r] *= __builtin_amdgcn_exp2f((diff >= 0 ? lf2 : -lb2) * (float)diff); }
            }
            bf16x8 pb[2][2];
#pragma unroll
            for (int kb = 0; kb < 2; ++kb)
#pragma unroll
                for (int sx = 0; sx < 2; ++sx) { u32x4 wv;
                    wv.x = cvt_pk_bf16(s[kb][8 * sx + 0], s[kb][8 * sx + 1]); wv.y = cvt_pk_bf16(s[kb][8 * sx + 2], s[kb][8 * sx + 3]);
                    wv.z = cvt_pk_bf16(s[kb][8 * sx + 4], s[kb][8 * sx + 5]); wv.w = cvt_pk_bf16(s[kb][8 * sx + 6], s[kb][8 * sx + 7]);
                    pb[kb][sx] = as_bf16x8(wv); }
#pragma unroll
            for (int kb = 0; kb < 2; ++kb)
#pragma unroll
                for (int sx = 0; sx < 2; ++sx) { const int rb = (32 * kb + 16 * sx) * 256;
#pragma unroll
                    for (int c4 = 0; c4 < 4; ++c4) { const bf16x8 a = tr_pair(Vt + lbV[c4] + rb, Vt + lbV[c4] + rb + 8 * 256);
                        o[c4] = __builtin_amdgcn_mfma_f32_32x32x16_bf16(a, pb[kb][sx], o[c4], 0, 0, 0); } }
            asm volatile("s_waitcnt vmcnt(0)" ::: "memory");
            __syncthreads();
        }
#undef RT_ISSUE
        float sm = 0.f;
#pragma unroll
        for (int c4 = 0; c4 < 4; ++c4)
#pragma unroll
            for (int r = 0; r < 16; ++r) sm += o[c4][r];
        sm += __shfl_xor(sm, 32);
        const float mu = sm * (1.f / RETD); float v2 = 0.f;
#pragma unroll
        for (int c4 = 0; c4 < 4; ++c4)
#pragma unroll
            for (int r = 0; r < 16; ++r) { const float d = o[c4][r] - mu; o[c4][r] = d; v2 += d * d; }
        v2 += __shfl_xor(v2, 32);
        const float rstd = rsqrtf(v2 * (1.f / RETD) + GN_EPS);
        const bf16_t* grow = proj + tok * PIN + OFF_RG + h * RETD + 4 * hh; bf16_t* yrow = ycat + tok * DM + NAW + HYW + h * RETD + 4 * hh;
#pragma unroll
        for (int c4 = 0; c4 < 4; ++c4)
#pragma unroll
            for (int i4 = 0; i4 < 4; ++i4) { const u32x2 gv = *(const u32x2*)(grow + 32 * c4 + 8 * i4);
                const float g0 = bf2f(gv.x & 0xffffu), g1 = bf2f(gv.x >> 16), g2 = bf2f(gv.y & 0xffffu), g3 = bf2f(gv.y >> 16);
                u32x2 wv; wv.x = cvt_pk_bf16(o[c4][4 * i4 + 0] * rstd * (g0 / (1.0f + __expf(-g0))), o[c4][4 * i4 + 1] * rstd * (g1 / (1.0f + __expf(-g1))));
                wv.y = cvt_pk_bf16(o[c4][4 * i4 + 2] * rstd * (g2 / (1.0f + __expf(-g2))), o[c4][4 * i4 + 3] * rstd * (g3 / (1.0f + __expf(-g3))));
                *(u32x2*)(yrow + 32 * c4 + 8 * i4) = wv; }
    }
}

__device__ __forceinline__ void ph_gnorm(const PD& p, const Ctx& c, int l) {
    const int gw = c.bid * NWAVES + c.wave, NGW = c.G * NWAVES;
    const float* gain = p.in(I_BRANCH_NORM) + (size_t)l * DM;
    for (int m = gw; m < NT; m += NGW) {
        const bf16_t* yr = (const bf16_t*)(p.ws() + WS_YCAT) + (size_t)m * DM; bf16_t* orow = (bf16_t*)(p.ws() + WS_YN) + (size_t)m * DM;
        float v[4][8]; float ss[3] = {0.f, 0.f, 0.f};
#pragma unroll
        for (int j = 0; j < 4; ++j) { const int e0 = 512 * j + 8 * c.lane; unpack8(*(const u32x4*)(yr + e0), v[j]);
            float s = 0.f;
#pragma unroll
            for (int i = 0; i < 8; ++i) s += v[j][i] * v[j][i];
            const int grp = e0 < NAW ? 0 : (e0 < NAW + HYW ? 1 : 2);
            ss[0] += grp == 0 ? s : 0.f; ss[1] += grp == 1 ? s : 0.f; ss[2] += grp == 2 ? s : 0.f; }
        const float r0 = rsqrtf(wave_sum(ss[0]) * (1.f / NAW) + RMS_EPS), r1 = rsqrtf(wave_sum(ss[1]) * (1.f / HYW) + RMS_EPS), r2 = rsqrtf(wave_sum(ss[2]) * (1.f / RETW) + RMS_EPS);
#pragma unroll
        for (int j = 0; j < 4; ++j) { const int e0 = 512 * j + 8 * c.lane; const float rr = e0 < NAW ? r0 : (e0 < NAW + HYW ? r1 : r2);
            const f32x4 g0 = *(const f32x4*)(gain + e0), g1 = *(const f32x4*)(gain + e0 + 4);
            u32x4 w; w.x = pk2(v[j][0] * rr * g0.x, v[j][1] * rr * g0.y); w.y = pk2(v[j][2] * rr * g0.z, v[j][3] * rr * g0.w);
            w.z = pk2(v[j][4] * rr * g1.x, v[j][5] * rr * g1.y); w.w = pk2(v[j][6] * rr * g1.z, v[j][7] * rr * g1.w);
            *(u32x4*)(orow + e0) = w; }
    }
}

__device__ __forceinline__ void ph_xatt(const PD& p, const Ctx& c, int l) {
    const bf16_t* qc = (const bf16_t*)(p.ws() + WS_QC); const bf16_t* kv = (const bf16_t*)(p.ws() + WS_KVC) + (size_t)l * 1024 * 4096; bf16_t* oc = (bf16_t*)(p.ws() + WS_OC);
    LAS unsigned char* L = c.lds;
    const int lane = c.lane, cc = lane & 31, hh = lane >> 5;
    const int fK = (cc >> 1) & 7;
    const int tq = (lane & 15) >> 2, tp = lane & 3, tblk = (lane >> 4) & 1, fV = ((tq >> 1) & 1) << 2;
    const int lbV0 = (4 * hh + tq) * 128 + 16 * (fV + 2 * tblk + (tp >> 1)) + 8 * (tp & 1);
    const int lbV1 = (4 * hh + tq) * 128 + 16 * ((4 ^ fV) + 2 * tblk + (tp >> 1)) + 8 * (tp & 1);
    for (int u = c.bid; u < NB * XH * 8; u += c.G) {
        const int qt = u & 7, h = (u >> 3) & 3, b = u >> 5;
        const bf16_t* kbase = kv + (size_t)(b * NMEM) * 4096 + h * XD;
        const size_t tok = (size_t)b * SEQ + qt * 256 + c.wave * 32 + cc;
        const bf16_t* qrow = qc + tok * DM + h * XD + 8 * hh;
        const int g_row0 = c.wave * 8 + (lane >> 3), g_ps = lane & 7;
#define XA_ISSUE(ci) do { const bf16_t* _src = kbase + ((ci) < 8 ? 64 * (ci) : 2048 + 64 * ((ci) - 8)); \
        _Pragma("unroll") for (int _i = 0; _i < 4; ++_i) { const int _row = g_row0 + 64 * _i; const int _f = (ci) < 8 ? ((_row >> 1) & 7) : (((_row >> 1) & 1) << 2); \
            __builtin_amdgcn_global_load_lds((const GAS unsigned*)(_src + (size_t)_row * 4096 + 8 * (g_ps ^ _f)), (LAS unsigned*)(L + ((ci) & 1) * 32768 + (8 * _i + c.wave) * 1024), 16, 0, 0); } } while (0)
#define XA_COMMIT(ci) asm volatile("s_waitcnt vmcnt(0)" ::: "memory")
        __syncthreads();
        XA_ISSUE(0); XA_COMMIT(0);
        bf16x8 qf[4], qn[4];
#pragma unroll
        for (int ks = 0; ks < 4; ++ks) qf[ks] = as_bf16x8(*(const u32x4*)(qrow + 16 * ks));
        __syncthreads();
        f32x16 acc[8];
#pragma unroll
        for (int kb = 0; kb < 8; ++kb)
#pragma unroll
            for (int r = 0; r < 16; ++r) acc[kb][r] = 0.f;
#pragma unroll 1
        for (int ci = 0; ci < 8; ++ci) {
            XA_ISSUE(ci + 1);
            if (ci + 1 < 8) {
#pragma unroll
                for (int ks = 0; ks < 4; ++ks) qn[ks] = as_bf16x8(*(const u32x4*)(qrow + 64 * (ci + 1) + 16 * ks)); }
            const LAS unsigned char* S = L + (ci & 1) * 32768 + cc * 128;
#pragma unroll
            for (int ks = 0; ks < 4; ++ks) { const LAS unsigned char* Sk = S + 16 * ((2 * ks + hh) ^ fK);
#pragma unroll
                for (int kb = 0; kb < 8; ++kb) { const bf16x8 a = *(const LAS bf16x8*)(Sk + kb * 4096);
                    acc[kb] = __builtin_amdgcn_mfma_f32_32x32x16_bf16(a, qf[ks], acc[kb], 0, 0, 0);
                    if ((kb & 3) == 3) __builtin_amdgcn_sched_barrier(0); } }
            XA_COMMIT(ci + 1);
#pragma unroll
            for (int ks = 0; ks < 4; ++ks) qf[ks] = qn[ks];
            __syncthreads();
        }
        bf16x8 pb[8][2];
        { float m = -INFINITY;
#pragma unroll
          for (int kb = 0; kb < 8; ++kb)
#pragma unroll
              for (int r = 0; r < 16; ++r) m = fmaxf(m, acc[kb][r]);
          m = fmaxf(m, __shfl_xor(m, 32));
          const float sc = 0.04419417382415922f * 1.4426950408889634f; const float ms = m * sc; float sum = 0.f;
#pragma unroll
          for (int kb = 0; kb < 8; ++kb)
#pragma unroll
              for (int r = 0; r < 16; ++r) { const float e = __builtin_amdgcn_exp2f(acc[kb][r] * sc - ms); acc[kb][r] = e; sum += e; }
          sum += __shfl_xor(sum, 32);
          const float inv = 1.0f / sum;
#pragma unroll
          for (int kb = 0; kb < 8; ++kb)
#pragma unroll
              for (int s = 0; s < 2; ++s) { u32x4 w;
                  w.x = cvt_pk_bf16(acc[kb][8 * s + 0] * inv, acc[kb][8 * s + 1] * inv); w.y = cvt_pk_bf16(acc[kb][8 * s + 2] * inv, acc[kb][8 * s + 3] * inv);
                  w.z = cvt_pk_bf16(acc[kb][8 * s + 4] * inv, acc[kb][8 * s + 5] * inv); w.w = cvt_pk_bf16(acc[kb][8 * s + 6] * inv, acc[kb][8 * s + 7] * inv);
                  pb[kb][s] = as_bf16x8(w); } }
        bf16_t* orow = oc + tok * DM + h * XD + 4 * hh;
#pragma unroll 1
        for (int ci = 8; ci < 16; ++ci) {
            if (ci + 1 < 16) XA_ISSUE(ci + 1);
            const LAS unsigned char* S = L + (ci & 1) * 32768;
            f32x16 o[2];
#pragma unroll
            for (int db = 0; db < 2; ++db) {
#pragma unroll
                for (int r = 0; r < 16; ++r) o[db][r] = 0.f;
                asm volatile("" : "+v"(o[db])); }
#pragma unroll
            for (int kb = 0; kb < 8; ++kb)
#pragma unroll
                for (int s = 0; s < 2; ++s) {
                    const bf16x8 a0 = tr_pair(S + lbV0 + (32 * kb + 16 * s) * 128, S + lbV0 + (32 * kb + 16 * s + 8) * 128);
                    const bf16x8 a1 = tr_pair(S + lbV1 + (32 * kb + 16 * s) * 128, S + lbV1 + (32 * kb + 16 * s + 8) * 128);
                    o[0] = __builtin_amdgcn_mfma_f32_32x32x16_bf16(a0, pb[kb][s], o[0], 0, 0, 0);
                    o[1] = __builtin_amdgcn_mfma_f32_32x32x16_bf16(a1, pb[kb][s], o[1], 0, 0, 0); }
#pragma unroll
            for (int db = 0; db < 2; ++db)
#pragma unroll
                for (int i4 = 0; i4 < 4; ++i4) { u32x2 w; w.x = cvt_pk_bf16(o[db][4 * i4 + 0], o[db][4 * i4 + 1]); w.y = cvt_pk_bf16(o[db][4 * i4 + 2], o[db][4 * i4 + 3]);
                    *(u32x2*)(orow + 64 * (ci - 8) + 32 * db + 8 * i4) = w; }
            if (ci + 1 < 16) XA_COMMIT(ci + 1);
            __syncthreads();
        }
#undef XA_ISSUE
#undef XA_COMMIT
    }
}

__device__ __forceinline__ void ph_router(const PD& p, const Ctx& c, int l) {
    const int gw = c.bid * NWAVES + c.wave, NGW = c.G * NWAVES;
    const float* gain = p.in(I_NORM_MOE) + (size_t)l * DM; const float* wr = p.in(I_W_ROUTER) + (size_t)l * DM * NE;
    LAS unsigned char* L = c.lds;
    __syncthreads();
    for (int ci = c.tid; ci < DM * 4; ci += NTHR) { const int k = ci >> 2, part = ci & 3; const int slot = (4 * (k >> 8) + (k & 3)) * 64 + ((k & 255) >> 2);
        *(LAS f32x4*)(L + slot * 64 + 16 * part) = *(const f32x4*)(wr + (size_t)k * NE + 4 * part); }
    __syncthreads();
    for (int m = gw; m < NT; m += NGW) {
        f32x4 v[8]; float lg[16];
        row_load_f32((const float*)(p.ws() + WS_XRES) + (size_t)m * DM, c.lane, v);
        const float rstd = rsqrtf(row_ssq(v) * (1.f / DM) + RMS_EPS);
#pragma unroll
        for (int j = 0; j < 8; ++j) v[j] = v[j] * rstd * *(const f32x4*)(gain + 256 * j + 4 * c.lane);
        row_store_bf16((bf16_t*)(p.ws() + WS_HN) + (size_t)m * DM, c.lane, v);
#pragma unroll
        for (int e = 0; e < 16; ++e) lg[e] = 0.f;
#pragma unroll
        for (int j = 0; j < 8; ++j)
#pragma unroll
            for (int q = 0; q < 4; ++q) { const LAS f32x4* wp = (const LAS f32x4*)(L + ((4 * j + q) * 64 + c.lane) * 64); const float hv = v[j][q];
#pragma unroll
                for (int e4 = 0; e4 < 4; ++e4) { const f32x4 wv = wp[e4];
                    lg[e4 * 4 + 0] += hv * wv.x; lg[e4 * 4 + 1] += hv * wv.y; lg[e4 * 4 + 2] += hv * wv.z; lg[e4 * 4 + 3] += hv * wv.w; }
                if (q & 1) __builtin_amdgcn_sched_barrier(0); }
        float mx = -INFINITY;
#pragma unroll
        for (int e = 0; e < 16; ++e) { lg[e] = wave_sum(lg[e]); mx = fmaxf(mx, lg[e]); }
        float sum = 0.f;
#pragma unroll
        for (int e = 0; e < 16; ++e) { lg[e] = expf(lg[e] - mx); sum += lg[e]; }
        if (c.lane < 16) { float a = 0.f;
#pragma unroll
            for (int e = 0; e < 16; ++e) a = (c.lane == e) ? lg[e] : a;
            ((float*)(p.ws() + WS_AFF))[(size_t)m * NE + c.lane] = a / sum; }
    }
}

__device__ __forceinline__ void ph_topk(const PD& p, const Ctx& c) {
    LAS float* a = (LAS float*)c.lds;
    const float* aff = (const float*)(p.ws() + WS_AFF); int* idx = (int*)(p.ws() + WS_IDX); float* gs = (float*)(p.ws() + WS_GSEL); int* inv = (int*)(p.ws() + WS_INV);
    for (int u = c.bid; u < NB * NE * 4; u += c.G) {
        const int qd = u & 3, e = (u >> 2) % NE, b = u / (4 * NE);
        __syncthreads();
        for (int t = c.tid; t < SEQ; t += NTHR) a[t] = aff[(size_t)(b * SEQ + t) * NE + e];
        __syncthreads();
        const int i = qd * NTHR + c.tid; const float ai = a[i]; int rank = 0;
        for (int j4 = 0; j4 < SEQ / 4; ++j4) { const f32x4 av = *(const LAS f32x4*)(a + 4 * j4); const int j = 4 * j4;
            rank += (av.x > ai || (av.x == ai && j < i)) ? 1 : 0; rank += (av.y > ai || (av.y == ai && j + 1 < i)) ? 1 : 0;
            rank += (av.z > ai || (av.z == ai && j + 2 < i)) ? 1 : 0; rank += (av.w > ai || (av.w == ai && j + 3 < i)) ? 1 : 0; }
        if (rank < CAP) { idx[(b * NE + e) * CAP + rank] = i; gs[(b * NE + e) * CAP + rank] = ai; inv[(size_t)(b * SEQ + i) * NE + e] = rank; }
        else inv[(size_t)(b * SEQ + i) * NE + e] = -1;
    }
}

__device__ __forceinline__ void ph_gather(const PD& p, const Ctx& c) {
    const int gw = c.bid * NWAVES + c.wave, NGW = c.G * NWAVES;
    const int* idx = (const int*)(p.ws() + WS_IDX);
    for (int r = gw; r < NE * NB * CAP; r += NGW) { const int e = r / (NB * CAP), b = (r / CAP) % NB, slot = r % CAP;
        const int t = idx[(b * NE + e) * CAP + slot];
        const u32x4* s = (const u32x4*)((const bf16_t*)(p.ws() + WS_HN) + (size_t)(b * SEQ + t) * DM); u32x4* d = (u32x4*)((bf16_t*)(p.ws() + WS_XE) + (size_t)r * DM);
#pragma unroll
        for (int j = 0; j < 4; ++j) d[64 * j + c.lane] = s[64 * j + c.lane]; }
}

__device__ __forceinline__ void ph_combine(const PD& p, const Ctx& c, int l) {
    const int gw = c.bid * NWAVES + c.wave, NGW = c.G * NWAVES;
    const int* inv = (const int*)(p.ws() + WS_INV); const float* gs = (const float*)(p.ws() + WS_GSEL); const float* ym = (const float*)(p.ws() + WS_YMOE);
    for (int m = gw; m < NT; m += NGW) { const int b = m / SEQ;
        float* xr = (float*)(p.ws() + WS_XRES) + (size_t)m * DM;
        f32x4 v[8]; row_load_f32(xr, c.lane, v);
        for (int e = 0; e < NE; ++e) { const int slot = inv[(size_t)m * NE + e];
            if (slot >= 0) { const float g = gs[(b * NE + e) * CAP + slot]; const float* yr = ym + ((size_t)e * 1024 + b * CAP + slot) * DM;
#pragma unroll
                for (int j = 0; j < 8; ++j) v[j] = v[j] + g * *(const f32x4*)(yr + 256 * j + 4 * c.lane); } }
        if (l == DEPTH - 1) { const float rstd = rsqrtf(row_ssq(v) * (1.f / DM) + RMS_EPS); float* orow = p.out() + (size_t)m * DM; const float* gain = p.in(I_FINAL_NORM);
#pragma unroll
            for (int j = 0; j < 8; ++j) *(f32x4*)(orow + 256 * j + 4 * c.lane) = v[j] * rstd * *(const f32x4*)(gain + 256 * j + 4 * c.lane); }
        else {
#pragma unroll
            for (int j = 0; j < 8; ++j) *(f32x4*)(xr + 256 * j + 4 * c.lane) = v[j]; }
    }
}
template <int PH> __device__ __forceinline__ void run_phase(const Ctx& c_in, int l) {
    asm volatile("; PHASE_MARK %0" :: "n"(PH));
    Ctx c = c_in; { int ln; asm volatile("v_mbcnt_lo_u32_b32 %0, -1, 0\n\tv_mbcnt_hi_u32_b32 %0, -1, %0" : "=v"(ln)); c.lane = ln; c.tid = c_in.wave * 64 + ln; }
    PD p; { KArgQ q = (KArgQ)__builtin_amdgcn_kernarg_segment_ptr(); asm volatile("" : "+s"(q)); p.q = q; }
    unsigned char* ws = p.ws();
    if constexpr (PH == PH_CVT) ph_cvt(p, c);
    else if constexpr (PH == PH_PRE) ph_pre(p, c);
    else if constexpr (PH == PH_NORM1) ph_norm(p, c, p.in(I_NORM_MIX) + (size_t)l * DM);
    else if constexpr (PH == PH_NORM2) ph_norm(p, c, p.in(I_NORM_CROSS) + (size_t)l * DM);
    else if constexpr (PH == PH_INPROJ) {
        pg8::Gemm g{(const bf16_t*)(ws + WS_HN), (const bf16_t*)(ws + WS_WIN) + (size_t)l * PIN * DM, DM};
        pg8::StaticOrder S; S.init(NT, PIN, c.G, c.bid);
        EpiInProj E{(bf16_t*)(ws + WS_PROJ), (const float*)(ws + WS_ROT), (const float*)(ws + WS_ROT) + SEQ * 64};
        pg8::gemm_phase(c.lds, c.tid, g, S, E);
    }
    else if constexpr (PH == PH_NA) ph_na(p, c, l);
    else if constexpr (PH == PH_HYPRE) ph_hypre(p, c, l);
    else if constexpr (PH == PH_HYCONV) ph_hyconv(p, c, l);
    else if constexpr (PH == PH_RET) ph_ret(p, c, l);
    else if constexpr (PH == PH_GNORM) ph_gnorm(p, c, l);
    else if constexpr (PH == PH_OUT) {
        pg8::Gemm g{(const bf16_t*)(ws + WS_YN), (const bf16_t*)(ws + WS_WOUT) + (size_t)l * DM * DM, DM};
        pg8::StaticOrder S; S.init(NT, DM, c.G, c.bid);
        EpiResid E{(float*)(ws + WS_XRES)};
        pg8::gemm_phase(c.lds, c.tid, g, S, E);
    }
    else if constexpr (PH == PH_CQ) {
        pg8::Gemm g{(const bf16_t*)(ws + WS_HN), (const bf16_t*)(ws + WS_WCQ) + (size_t)l * DM * DM, DM};
        pg8::StaticOrder S; S.init(NT, DM, c.G, c.bid);
        EpiBf16 E{(bf16_t*)(ws + WS_QC), DM};
        pg8::gemm_phase(c.lds, c.tid, g, S, E);
    }
    else if constexpr (PH == PH_CKV) {
        pg8::Gemm g{(const bf16_t*)(ws + WS_MEMN), (const bf16_t*)(ws + WS_WCKV) + (size_t)l * 4096 * DM, DM};
        pg8::StaticOrder S; S.init(NB * NMEM, 4096, c.G, (c.bid + 160) & 255);
        EpiBf16 E{(bf16_t*)(ws + WS_KVC) + (size_t)l * 1024 * 4096, 4096};
        pg8::gemm_phase(c.lds, c.tid, g, S, E);
    }
    else if constexpr (PH == PH_XATT) ph_xatt(p, c, l);
    else if constexpr (PH == PH_CO) {
        pg8::Gemm g{(const bf16_t*)(ws + WS_OC), (const bf16_t*)(ws + WS_WCO) + (size_t)l * DM * DM, DM};
        pg8::StaticOrder S; S.init(NT, DM, c.G, c.bid);
        EpiResid E{(float*)(ws + WS_XRES)};
        pg8::gemm_phase(c.lds, c.tid, g, S, E);
    }
    else if constexpr (PH == PH_ROUTER) ph_router(p, c, l);
    else if constexpr (PH == PH_TOPK) ph_topk(p, c);
    else if constexpr (PH == PH_GATHER) ph_gather(p, c);
    else if constexpr (PH == PH_GU) {
        pg8::Gemm g{(const bf16_t*)(ws + WS_XE), (const bf16_t*)(ws + WS_WGU) + (size_t)l * NE * 4096 * DM, DM};
        pg8::MoeOrder S; S.init(16, c.G, c.bid);
        EpiGU E{(bf16_t*)(ws + WS_ACT), 16};
        pg8::gemm_phase(c.lds, c.tid, g, S, E);
    }
    else if constexpr (PH == PH_DOWN) {
        pg8::Gemm g{(const bf16_t*)(ws + WS_ACT), (const bf16_t*)(ws + WS_WDN) + (size_t)l * NE * DM * FF, FF};
        pg8::MoeOrder S; S.init(8, c.G, c.bid);
        EpiDown E{(float*)(ws + WS_YMOE), 8};
        pg8::gemm_phase(c.lds, c.tid, g, S, E);
    }
    else if constexpr (PH == PH_COMBINE) ph_combine(p, c, l);
    else if constexpr (PH == PH_KCOPY) ph_kcopy(p, c);
}

__global__ void __launch_bounds__(NTHR, 2) mega_fwd(P p) {
    extern __shared__ __attribute__((aligned(16))) unsigned char lds_raw[];
    Ctx c; c.tid = 0; c.lane = 0; c.wave = __builtin_amdgcn_readfirstlane((int)threadIdx.x >> 6); c.G = gridDim.x; c.bid = blockIdx.x; c.lds = (LAS unsigned char*)lds_raw;
    volatile LAS unsigned* st = (volatile LAS unsigned*)(c.lds + LDS_BYTES - 16);
    if (threadIdx.x < 4) st[threadIdx.x] = 0u;
    __syncthreads();
    (void)xcd_barrier_post((unsigned*)((unsigned char*)(GAS unsigned char*)p.ws + WS_CTL), st);
#ifndef PROBE_MASK
#define PROBE_MASK 0
#endif
#define RUNP(PH, ...) do { run_phase<PH>(__VA_ARGS__); if ((PROBE_MASK >> (PH)) & 1) { GRID_BAR(); run_phase<PH>(__VA_ARGS__); } } while (0)
#define GRID_BAR() do { PD _p; { KArgQ _q = (KArgQ)__builtin_amdgcn_kernarg_segment_ptr(); asm volatile("" : "+s"(_q)); _p.q = _q; } \
        XcdBarrier _b; _b.bar = (unsigned*)(_p.ws() + WS_CTL); _b.x = xb_xcc_id(); _b.st = (volatile LAS unsigned*)(c.lds + LDS_BYTES - 16); xcd_barrier(_b); } while (0)
    RUNP(PH_CVT, c, 0);
    RUNP(PH_PRE, c, 0);
    GRID_BAR();
    RUNP(PH_NORM1, c, 0);
    RUNP(PH_KCOPY, c, 0);
    GRID_BAR();
    for (int l = 0; l < DEPTH; ++l) {
        RUNP(PH_INPROJ, c, l);
        RUNP(PH_CKV, c, l);
        GRID_BAR();
        RUNP(PH_HYPRE, c, l);
        RUNP(PH_NA, c, l);
        GRID_BAR();
        RUNP(PH_HYCONV, c, l);
        RUNP(PH_RET, c, l);
        GRID_BAR();
        RUNP(PH_GNORM, c, l);
        GRID_BAR();
        RUNP(PH_OUT, c, l);
        GRID_BAR();
        RUNP(PH_NORM2, c, l);
        GRID_BAR();
        RUNP(PH_CQ, c, l);
        GRID_BAR();
        RUNP(PH_XATT, c, l);
        GRID_BAR();
        RUNP(PH_CO, c, l);
        GRID_BAR();
        RUNP(PH_ROUTER, c, l);
        GRID_BAR();
        RUNP(PH_TOPK, c, l);
        GRID_BAR();
        RUNP(PH_GATHER, c, l);
        GRID_BAR();
        RUNP(PH_GU, c, l);
        GRID_BAR();
        RUNP(PH_DOWN, c, l);
        GRID_BAR();
        RUNP(PH_COMBINE, c, l);
        if (l + 1 < DEPTH) { RUNP(PH_NORM1, c, l + 1); GRID_BAR(); }
    }
}

extern "C" void kernel_launch(void* const* d_in, const int* in_sizes, int n_in, void* d_out, int out_size, void* d_ws, size_t ws_size, hipStream_t stream) {
    if (n_in != N_IN || out_size != NT * DM || ws_size < WS_END) { fprintf(stderr, "kernel_launch: unexpected shapes (n_in %d, out %d, ws %zu < %zu); nothing launched\n", n_in, out_size, ws_size, (size_t)WS_END); return; }
    static int grid = 0;
    if (!grid) {
        int dev = 0, cus = 0, per_cu = 0;
        if (hipGetDevice(&dev) != hipSuccess || hipDeviceGetAttribute(&cus, hipDeviceAttributeMultiprocessorCount, dev) != hipSuccess) { fprintf(stderr, "kernel_launch: device query failed\n"); return; }
        if (hipFuncSetAttribute((const void*)mega_fwd, hipFuncAttributeMaxDynamicSharedMemorySize, LDS_BYTES) != hipSuccess) { fprintf(stderr, "kernel_launch: hipFuncSetAttribute failed\n"); return; }
        if (hipOccupancyMaxActiveBlocksPerMultiprocessor(&per_cu, (const void*)mega_fwd, NTHR, LDS_BYTES) != hipSuccess || per_cu < 1) fprintf(stderr, "kernel_launch: occupancy query reports %d workgroups per CU\n", per_cu);
        grid = cus;
    }
    P p{};
    for (int i = 0; i < N_IN; ++i) p.in[i] = (const float*)d_in[i];
    p.out = (float*)d_out; p.ws = (unsigned char*)d_ws;
    if (hipMemsetAsync((char*)d_ws + WS_CTL, 0, XCD_BAR_WORDS * sizeof(unsigned), stream) != hipSuccess) { fprintf(stderr, "kernel_launch: memset failed\n"); return; }
    hipLaunchKernelGGL(mega_fwd, dim3(grid), dim3(NTHR), LDS_BYTES, stream, p);
    hipError_t le = hipGetLastError();
    if (le != hipSuccess) fprintf(stderr, "kernel_launch: launch failed: %s\n", hipGetErrorName(le));
}
```

```cpp
#include <hip/hip_runtime.h>
#include <cstdio>
#include <cstdint>
#include <cmath>

#define LAS __attribute__((address_space(3)))
#define GAS __attribute__((address_space(1)))
typedef unsigned short bf16_t;
typedef short bf16x8 __attribute__((ext_vector_type(8)));
typedef float f32x4 __attribute__((ext_vector_type(4)));
typedef float f32x2 __attribute__((ext_vector_type(2)));
typedef unsigned u32x4 __attribute__((ext_vector_type(4)));
typedef unsigned u32x2 __attribute__((ext_vector_type(2)));

constexpr int NB = 4, SEQ = 2048, DM = 2048, NT = NB * SEQ, DEPTH = 2;
constexpr int NMEM = 256, GW = 64, ROWS = SEQ / GW;
constexpr int NAW = 768, NAH = 12, NADH = 64;
constexpr int HYW = 512, HYFF = 64;
constexpr int RETW = 768, RETH = 6, RETD = 128;
constexpr int PIN = 6912;
constexpr int OFF_NAQ = 0, OFF_NAK = 768, OFF_NAV = 1536, OFF_HY = 2304, OFF_RQ = 3840, OFF_RK = 4608, OFF_RV = 5376, OFF_RG = 6144;
constexpr int XH = 4, XD = 512;
constexpr int NE = 16, FF = 2048, CAP = 256;
constexpr float RMS_EPS = 1e-6f, GN_EPS = 1e-5f;

enum { I_X = 0, I_MEM, I_NORM_MIX, I_W_IN, I_NA_RPB, I_HY_CONV_W, I_HY_CONV_B, I_HY_W1, I_HY_B1, I_HY_W2, I_HY_B2, I_HY_W3, I_HY_FREQ, I_HY_SKIP,
       I_BRANCH_NORM, I_W_OUT, I_NORM_CROSS, I_MEM_NORM, I_W_CQ, I_W_CKV, I_W_CO, I_NORM_MOE, I_W_ROUTER, I_W_GATE, I_W_UP, I_W_DOWN, I_FINAL_NORM, N_IN };

constexpr size_t MiB = (size_t)1 << 20;
constexpr size_t WS_CTL   = 0;
constexpr size_t WS_XRES  = 1 * MiB;
constexpr size_t WS_HN    = WS_XRES + 64 * MiB;
constexpr size_t WS_PROJ  = WS_HN + 32 * MiB;
constexpr size_t WS_YCAT  = WS_PROJ + 108 * MiB;
constexpr size_t WS_YN    = WS_YCAT + 32 * MiB;
constexpr size_t WS_QC    = WS_YN + 32 * MiB;
constexpr size_t WS_KVC   = WS_QC + 32 * MiB;
constexpr size_t WS_OC    = WS_KVC + 16 * MiB;
constexpr size_t WS_MEMN  = WS_OC + 32 * MiB;
constexpr size_t WS_AFF   = WS_MEMN + 4 * MiB;
constexpr size_t WS_IDX   = WS_AFF + 1 * MiB;
constexpr size_t WS_GSEL  = WS_IDX + 1 * MiB;
constexpr size_t WS_INV   = WS_GSEL + 1 * MiB;
constexpr size_t WS_XE    = WS_INV + 1 * MiB;
constexpr size_t WS_ACT   = WS_XE + 64 * MiB;
constexpr size_t WS_YMOE  = WS_ACT + 64 * MiB;
constexpr size_t WS_ROT   = WS_YMOE + 128 * MiB;
constexpr size_t WS_KF    = WS_ROT + 1 * MiB;
constexpr size_t WS_HS    = WS_KF + 32 * MiB;
constexpr size_t WS_WIN   = WS_HS + 48 * MiB;
constexpr size_t WS_WOUT  = WS_WIN + 54 * MiB;
constexpr size_t WS_WCQ   = WS_WOUT + 16 * MiB;
constexpr size_t WS_WCKV  = WS_WCQ + 16 * MiB;
constexpr size_t WS_WCO   = WS_WCKV + 32 * MiB;
constexpr size_t WS_WGU   = WS_WCO + 16 * MiB;
constexpr size_t WS_WDN   = WS_WGU + 512 * MiB;
constexpr size_t WS_KFB   = WS_WDN + 256 * MiB;
constexpr size_t WS_RS    = WS_KFB + 68 * MiB;
constexpr size_t WS_END   = WS_RS + 2 * MiB;
constexpr size_t RS_MIX = 0, RS_MOE = NT * 4, RS_X = 2 * NT * 4, RS_SSQ = 2 * NT * 4 + 16384 * 4;
constexpr int KFC = 4128;

struct P { const float* in[N_IN]; float* out; unsigned char* ws; };
typedef const __attribute__((address_space(4))) unsigned long long* KArgQ;
struct PD { KArgQ q;
    __device__ __forceinline__ const float* in(int i) const { return (const float*)(const GAS float*)q[i]; }
    __device__ __forceinline__ float* out() const { return (float*)(GAS float*)q[N_IN]; }
    __device__ __forceinline__ unsigned char* ws() const { return (unsigned char*)(GAS unsigned char*)q[N_IN + 1]; } };

__device__ __forceinline__ float bf2f(unsigned v) { return __uint_as_float(v << 16); }
__device__ __forceinline__ unsigned f2bf(float f) { unsigned u = __float_as_uint(f); u += 0x7fffu + ((u >> 16) & 1u); return u >> 16; }
typedef __bf16 bf16x2_t __attribute__((ext_vector_type(2)));
__device__ __forceinline__ unsigned cvt_pk_bf16(float lo, float hi) { union { bf16x2_t b; unsigned u; } x; x.b = __builtin_convertvector((f32x2){lo, hi}, bf16x2_t); return x.u; }
__device__ __forceinline__ unsigned pk2(float lo, float hi) { return cvt_pk_bf16(lo, hi); }
__device__ __forceinline__ void unpack8(const u32x4 w, float (&f)[8]) {
    f[0] = bf2f(w.x & 0xffffu); f[1] = bf2f(w.x >> 16); f[2] = bf2f(w.y & 0xffffu); f[3] = bf2f(w.y >> 16);
    f[4] = bf2f(w.z & 0xffffu); f[5] = bf2f(w.z >> 16); f[6] = bf2f(w.w & 0xffffu); f[7] = bf2f(w.w >> 16);
}
__device__ __forceinline__ float wave_sum(float v) {
#pragma unroll
    for (int o = 1; o < 64; o <<= 1) v += __shfl_xor(v, o);
    return v;
}
#define LDS_WAIT() asm volatile("s_waitcnt lgkmcnt(0)" ::: "memory")
namespace pg8 {
constexpr int BM = 256, BK = 64, HALF = 128, HTB = HALF * BK * 2  , STAGE_BYTES = 8 * HTB, NXCD = 8, WGM = 8;

__host__ __device__ __forceinline__ int lds_byte(int r, int c) { const int st = (r >> 4) * 2 + (c >> 5), rr = r & 15, cc = c & 31, ob = rr * 64 + cc * 2; return st * 1024 + (ob ^ (((ob >> 9) & 1) << 5)); }
__host__ __device__ __forceinline__ void stage_rc(int b, int& R, int& C) { const int st = b / 1024, sb = b % 1024, swz = sb ^ (((sb >> 9) & 1) << 5); R = (st >> 1) * 16 + swz / 64; C = (st & 1) * 32 + (swz % 64) / 2; }
__host__ __device__ __forceinline__ int perm32(int rho) { const int n = rho >> 4, i = rho & 15; return 8 * (i >> 2) + 4 * n + (i & 3); }

struct Unit { int pm, pn; };
struct Gemm { const bf16_t* A; const bf16_t* Bt; int K; };

struct StaticOrder {
    int nM, nN, nwg, G, c;
    __device__ void init(int M, int N, int G_, int c_) { nM = M / BM; nN = N / BM; nwg = nM * nN; G = G_; c = c_; }
    __device__ bool next(int i, Unit& u) const {
        const long L = (long)i * G + c; if (L >= nwg) return false;
        int wgid = (int)L; { const int q = nwg / NXCD, r = nwg % NXCD, xcd = wgid % NXCD, off = wgid / NXCD; wgid = (xcd < r ? xcd * (q + 1) : r * (q + 1) + (xcd - r) * q) + off; }
        const int nig = WGM * nN, gid = wgid / nig, fm = gid * WGM, gsz = (nM - fm) < WGM ? (nM - fm) : WGM;
        u.pm = fm + ((wgid % nig) % gsz); u.pn = (wgid % nig) / gsz; return true;
    }
};
struct MoeOrder {
    int npn, G, x, s;
    __device__ void init(int npn_, int G_, int c_) { npn = npn_; G = G_; x = c_ & 7; s = c_ >> 3; }
    __device__ bool next(int i, Unit& u) const {
        if (G != 256) { const int L = i * G + (s * 8 + x); const int per_e = 4 * npn; if (L >= 16 * per_e) return false;
            const int e = L / per_e, r = L % per_e; u.pm = e * 4 + (r & 3); u.pn = e * npn + (r >> 2); return true; }
        const int q = i * 8 + x;
        const int nch = 16 * npn / 8; if (q >= nch) return false;
        const int e = q / (npn / 8), half = q % (npn / 8);
        u.pm = e * 4 + (s & 3); u.pn = e * npn + 8 * half + (s >> 2); return true;
    }
};

template <class Epi, class Sched, bool ALIGN_EPI = true, bool SP2 = true>
__device__ __forceinline__ void gemm_phase(LAS unsigned char* lds, const int tid, const Gemm g, const Sched& S, const Epi& E) {
    const int wid = __builtin_amdgcn_readfirstlane(tid >> 6), lane = tid & 63, wr = wid >> 2, wc = wid & 3, fr = lane & 15, fq = lane >> 4;
    const int K = g.K, nt = K / BK;
    unsigned voffA[2], voffB[2];
#pragma unroll
    for (int i = 0; i < 2; ++i) { int R, C; stage_rc(tid * 16 + i * 8192, R, C); const int Rb = Epi::PERM ? ((R & ~31) + perm32(R & 31)) : R;
        voffA[i] = (unsigned)(R * K + C) * 2u; voffB[i] = (unsigned)(Rb * K + C) * 2u; }
    const size_t kstep = (size_t)(BK * 2);
    const size_t hstep = (size_t)HALF * K * 2;
    const size_t tstep = 2 * hstep;
    const unsigned ldsw = (unsigned)wid * 1024u;
    const int aoff = lds_byte(wr * 64 + fr, fq * 8), boff = lds_byte(wc * 32 + fr, fq * 8);
#define PG8_SA(b, h) (((b) * 2 + (h)) * HTB)
#define PG8_SB(b, h) ((4 + (b) * 2 + (h)) * HTB)
#define PG8_STAGE(bufoff, gbase, voff) do { _Pragma("unroll") for (int _i = 0; _i < 2; ++_i) \
        __builtin_amdgcn_global_load_lds((const unsigned*)((const char*)(gbase) + (voff)[_i]), (LAS unsigned*)(lds + (bufoff) + ldsw + _i * 8192), 16, 0, 0); } while (0)
#define PG8_LDA(dst, b, h) do { _Pragma("unroll") for (int m = 0; m < 4; ++m) _Pragma("unroll") for (int k = 0; k < 2; ++k) dst[m][k] = *(const LAS bf16x8*)(lds + PG8_SA(b, h) + aoff + m * 2048 + k * 1024); } while (0)
#define PG8_LDB(dst, b, h) do { _Pragma("unroll") for (int n = 0; n < 2; ++n) _Pragma("unroll") for (int k = 0; k < 2; ++k) dst[n][k] = *(const LAS bf16x8*)(lds + PG8_SB(b, h) + boff + n * 2048 + k * 1024); } while (0)
#define PG8_MMA(ai, bj, At, Bt) do { __builtin_amdgcn_s_setprio(1); _Pragma("unroll") for (int m = 0; m < 4; ++m) _Pragma("unroll") for (int n = 0; n < 2; ++n) _Pragma("unroll") for (int k = 0; k < 2; ++k) \
        acc[ai][bj][m][n] = __builtin_amdgcn_mfma_f32_16x16x32_bf16(Bt[n][k], At[m][k], acc[ai][bj][m][n], 0, 0, 0); __builtin_amdgcn_s_setprio(0); } while (0)
#define PG8_WAIT_V(n) asm volatile("s_waitcnt vmcnt(" #n ")" ::: "memory")
#define PG8_WAIT_L(n) asm volatile("s_waitcnt lgkmcnt(" #n ")" ::: "memory")
#define PG8_BAR __builtin_amdgcn_s_barrier()
#define PG8_SCHED __builtin_amdgcn_sched_barrier(0)
    Unit cur, nxt; int ui = 0;
    if (!S.next(0, cur)) return;
    f32x4 acc[2][2][4][2];
#pragma unroll
    for (int a = 0; a < 2; ++a)
#pragma unroll
        for (int b = 0; b < 2; ++b)
#pragma unroll
            for (int m = 0; m < 4; ++m)
#pragma unroll
                for (int n = 0; n < 2; ++n) acc[a][b][m][n] = (f32x4){0.f, 0.f, 0.f, 0.f};
    bf16x8 At[4][2], B0[2][2], B1[2][2];
    const char* cA = (const char*)g.A + (size_t)cur.pm * tstep; const char* cB = (const char*)g.Bt + (size_t)cur.pn * tstep;
    if constexpr (SP2) {
        PG8_STAGE(PG8_SB(0, 0), cB, voffB); PG8_STAGE(PG8_SB(0, 1), cB + hstep, voffB); PG8_STAGE(PG8_SA(0, 0), cA, voffA); PG8_STAGE(PG8_SA(0, 1), cA + hstep, voffA);
        if (wr == 1) PG8_BAR;
        PG8_WAIT_V(2); PG8_BAR;
        PG8_STAGE(PG8_SB(1, 0), cB + kstep, voffB); PG8_STAGE(PG8_SA(1, 0), cA + kstep, voffA); PG8_STAGE(PG8_SB(1, 1), cB + hstep + kstep, voffB);
        PG8_WAIT_V(6); PG8_BAR;
    } else {
        PG8_STAGE(PG8_SB(0, 0), cB, voffB); PG8_STAGE(PG8_SA(0, 0), cA, voffA); PG8_STAGE(PG8_SB(0, 1), cB + hstep, voffB); PG8_STAGE(PG8_SA(0, 1), cA + hstep, voffA);
        if (wr == 1) PG8_BAR;
        PG8_WAIT_V(4); PG8_BAR;
        PG8_STAGE(PG8_SB(1, 0), cB + kstep, voffB); PG8_STAGE(PG8_SA(1, 0), cA + kstep, voffA); PG8_STAGE(PG8_SB(1, 1), cB + hstep + kstep, voffB);
        PG8_WAIT_V(6); PG8_BAR;
    }
    for (;;) {
        const bool has_next = S.next(ui + 1, nxt);
        const char* nA = has_next ? (const char*)g.A + (size_t)nxt.pm * tstep : cA; const char* nB = has_next ? (const char*)g.Bt + (size_t)nxt.pn * tstep : cB;
        for (int t = 0; t < nt; t += 2) {
            const bool last = (t == nt - 2);
            const char* a1 = cA + (size_t)(t + 1) * kstep;
            const char* a2 = last ? nA : cA + (size_t)(t + 2) * kstep; const char* b2 = last ? nB : cB + (size_t)(t + 2) * kstep;
            const char* a3 = a2 + kstep; const char* b3 = b2 + kstep;
            if constexpr (SP2) {
            PG8_LDB(B0, 0, 0); PG8_LDB(B1, 0, 1); PG8_SCHED; PG8_LDA(At, 0, 0); PG8_STAGE(PG8_SA(1, 1), a1 + hstep, voffA);
            PG8_WAIT_V(8); PG8_WAIT_L(0); PG8_BAR; PG8_MMA(0, 0, At, B0); PG8_MMA(0, 1, At, B1); PG8_BAR; PG8_SCHED;
            PG8_LDA(At, 0, 1); PG8_STAGE(PG8_SB(0, 0), b2, voffB); PG8_STAGE(PG8_SB(0, 1), b2 + hstep, voffB); PG8_STAGE(PG8_SA(0, 0), a2, voffA);
            PG8_WAIT_V(8); PG8_WAIT_L(0); PG8_BAR; PG8_MMA(1, 0, At, B0); PG8_MMA(1, 1, At, B1); PG8_BAR; PG8_SCHED;
            PG8_LDB(B0, 1, 0); PG8_LDB(B1, 1, 1); PG8_SCHED; PG8_LDA(At, 1, 0); PG8_STAGE(PG8_SA(0, 1), a2 + hstep, voffA);
            PG8_WAIT_V(8); PG8_WAIT_L(0); PG8_BAR; PG8_MMA(0, 0, At, B0); PG8_MMA(0, 1, At, B1); PG8_BAR; PG8_SCHED;
            PG8_LDA(At, 1, 1); PG8_STAGE(PG8_SB(1, 0), b3, voffB); PG8_STAGE(PG8_SB(1, 1), b3 + hstep, voffB); PG8_STAGE(PG8_SA(1, 0), a3, voffA);
            PG8_WAIT_V(8); PG8_WAIT_L(0); PG8_BAR; PG8_MMA(1, 0, At, B0); PG8_MMA(1, 1, At, B1); PG8_BAR; PG8_SCHED;
            } else {
            PG8_LDB(B0, 0, 0); PG8_SCHED; PG8_LDA(At, 0, 0); PG8_STAGE(PG8_SA(1, 1), a1 + hstep, voffA);
            PG8_WAIT_L(8); PG8_BAR; PG8_WAIT_L(0); PG8_MMA(0, 0, At, B0); PG8_BAR; PG8_SCHED;
            PG8_LDB(B1, 0, 1); PG8_STAGE(PG8_SB(0, 0), b2, voffB);
            PG8_BAR; PG8_WAIT_L(0); PG8_MMA(0, 1, At, B1); PG8_BAR;
            PG8_LDA(At, 0, 1); PG8_STAGE(PG8_SA(0, 0), a2, voffA);
            PG8_BAR; PG8_WAIT_L(0); PG8_MMA(1, 0, At, B0); PG8_BAR; PG8_SCHED;
            PG8_STAGE(PG8_SB(0, 1), b2 + hstep, voffB);
            PG8_WAIT_V(6); PG8_BAR; PG8_MMA(1, 1, At, B1); PG8_BAR;
            PG8_LDB(B0, 1, 0); PG8_SCHED; PG8_LDA(At, 1, 0); PG8_STAGE(PG8_SA(0, 1), a2 + hstep, voffA);
            PG8_WAIT_L(8); PG8_BAR; PG8_WAIT_L(0); PG8_MMA(0, 0, At, B0); PG8_BAR; PG8_SCHED;
            PG8_LDB(B1, 1, 1); PG8_STAGE(PG8_SB(1, 0), b3, voffB);
            PG8_BAR; PG8_WAIT_L(0); PG8_MMA(0, 1, At, B1); PG8_BAR;
            PG8_LDA(At, 1, 1); PG8_STAGE(PG8_SA(1, 0), a3, voffA);
            PG8_BAR; PG8_WAIT_L(0); PG8_MMA(1, 0, At, B0); PG8_BAR; PG8_SCHED;
            PG8_STAGE(PG8_SB(1, 1), b3 + hstep, voffB);
            PG8_WAIT_V(6); PG8_BAR; PG8_MMA(1, 1, At, B1); PG8_BAR;

            }
        }
        if constexpr (ALIGN_EPI) { if (wr == 0) PG8_BAR; }
        E(acc, cur, wr, wc, fr, fq);
        if (!has_next) break;
#pragma unroll
        for (int a = 0; a < 2; ++a)
#pragma unroll
            for (int b = 0; b < 2; ++b)
#pragma unroll
                for (int m = 0; m < 4; ++m)
#pragma unroll
                    for (int n = 0; n < 2; ++n) acc[a][b][m][n] = (f32x4){0.f, 0.f, 0.f, 0.f};
        cur = nxt; cA = nA; cB = nB; ++ui;
        if constexpr (ALIGN_EPI) { if (wr == 1) PG8_BAR; }
    }
    PG8_WAIT_V(0);
    if constexpr (!ALIGN_EPI) { if (wr == 0) PG8_BAR; }
    PG8_BAR;
#undef PG8_SA
#undef PG8_SB
#undef PG8_STAGE
#undef PG8_LDA
#undef PG8_LDB
#undef PG8_MMA
#undef PG8_WAIT_V
#undef PG8_WAIT_L
#undef PG8_BAR
#undef PG8_SCHED
}
}
#define XB_TMO      128
#define XB_XCNT(j)  (256  + 64 * (j))
#define XB_XSUB(j)  (1280 + 64 * (j))
#define XB_XGEN(j)  (2304 + 64 * (j))
#define XB_TOP      3328
#define XB_TOPGEN   3392
#define XCD_BAR_WORDS 3456
#define XB_SPIN_CAP (1u << 18)

__device__ __forceinline__ unsigned xb_ld(unsigned* p)              { return __hip_atomic_load(p, __ATOMIC_RELAXED, __HIP_MEMORY_SCOPE_AGENT); }
__device__ __forceinline__ unsigned xb_add(unsigned* p, unsigned v) { return __hip_atomic_fetch_add(p, v, __ATOMIC_RELAXED, __HIP_MEMORY_SCOPE_AGENT); }
__device__ __forceinline__ unsigned xb_xcc_id() { return (unsigned)__builtin_amdgcn_s_getreg((3 << 11) | 20) & 0xFu; }
#define XB_SPIN(cond, bar) do { unsigned _sp = 0; while (cond) { __builtin_amdgcn_s_sleep(1); \
    if ((++_sp & 255u) == 0u) { if (xb_ld(&(bar)[XB_TMO])) break; if (_sp > XB_SPIN_CAP) { atomicAdd(&(bar)[XB_TMO], 1u); break; } } } } while (0)

struct XcdBarrier {
    unsigned* bar; unsigned x;
    volatile LAS unsigned* st;
};

__device__ __forceinline__ XcdBarrier xcd_barrier_post(unsigned* bar, volatile LAS unsigned* st) {
    XcdBarrier b; b.bar = bar; b.x = xb_xcc_id(); b.st = st;
    if (threadIdx.x == 0) (void)xb_add(&bar[XB_XCNT(b.x)], 1u);
    return b;
}
__device__ __forceinline__ void xcd_barrier_complete(unsigned* bar, unsigned x, unsigned& nloc, unsigned& nx) {
    const unsigned G = gridDim.x * gridDim.y * gridDim.z;
    unsigned sum, cnt, mine, sp = 0u;
    for (;;) {
        sum = 0u; cnt = 0u; mine = 0u;
#pragma unroll
        for (unsigned j = 0; j < 16; ++j) { const unsigned c = xb_ld(&bar[XB_XCNT(j)]); sum += c; cnt += (c > 0u) ? 1u : 0u; mine = (j == x) ? c : mine; }
        if (sum == G) break;
        __builtin_amdgcn_s_sleep(1);
        if ((++sp & 255u) == 0u) { if (xb_ld(&bar[XB_TMO])) break; if (sp > XB_SPIN_CAP) { atomicAdd(&bar[XB_TMO], 1u); break; } }
    }
    nloc = mine > 0u ? mine : 1u; nx = cnt > 0u ? cnt : 1u;
}

__device__ __forceinline__ void xcd_barrier(const XcdBarrier& b) {
    asm volatile("s_waitcnt vmcnt(0)" ::: "memory");
    __syncthreads();
    if (threadIdx.x == 0) {
        unsigned* bar = b.bar;
        __builtin_amdgcn_s_waitcnt(0);
        unsigned nloc = b.st[0], nx = b.st[1];
        if (nloc == 0u) { xcd_barrier_complete(bar, b.x, nloc, nx); b.st[0] = nloc; b.st[1] = nx; }
        const unsigned old = xb_add(&bar[XB_XSUB(b.x)], 1u);
        const unsigned gen = old / nloc;
        if (old + 1u == (gen + 1u) * nloc) {
            __builtin_amdgcn_fence(__ATOMIC_RELEASE, "agent");
            asm volatile("s_waitcnt vmcnt(0)" ::: "memory");
            const unsigned og = xb_add(&bar[XB_TOP], 1u);
            const unsigned tg = og / nx;
            if (og + 1u == (tg + 1u) * nx) xb_add(&bar[XB_TOPGEN], 1u);
            else XB_SPIN(xb_ld(&bar[XB_TOPGEN]) == tg, bar);
            __builtin_amdgcn_fence(__ATOMIC_ACQUIRE, "agent");
            xb_add(&bar[XB_XGEN(b.x)], 1u);
            asm volatile("s_waitcnt vmcnt(0)" ::: "memory");
        } else {
            XB_SPIN(xb_ld(&bar[XB_XGEN(b.x)]) == gen, bar);
            __builtin_amdgcn_fence(__ATOMIC_ACQUIRE, "agent");
            asm volatile("s_waitcnt vmcnt(0)" ::: "memory");
        }
    }
    __syncthreads();
}

enum { PH_CVT = 0, PH_PRE, PH_NORM1, PH_INPROJ, PH_NA, PH_HYPRE, PH_HYCONV, PH_RET, PH_GNORM, PH_OUT, PH_NORM2, PH_CQ, PH_CKV, PH_XATT, PH_CO, PH_ROUTER, PH_TOPK, PH_GATHER,
       PH_GU, PH_DOWN, PH_COMBINE, PH_KCOPY, N_PHASES };
constexpr int NTHR = 512, NWAVES = 8;
constexpr int LDS_BYTES = 150 * 1024;

struct Ctx { int tid, lane, wave, G, bid; LAS unsigned char* lds; };

__device__ __forceinline__ void cvt_item(const float* src, size_t stride, int cd0, int cds, int K, bf16_t* WT, LAS float* scr, int k0, int n0, int lane, const float* gk) {
    f32x4 v[16];
    const float* s0 = src + (size_t)(k0 + (lane >> 4)) * stride;
#pragma unroll
    for (int i = 0; i < 16; ++i) v[i] = __builtin_nontemporal_load((const f32x4*)(s0 + (size_t)(4 * i) * stride));
#pragma unroll
    for (int i = 0; i < 16; ++i) { LAS float* d = scr + ((lane >> 4) + 4 * i) * 65 + cd0; const float g = gk ? gk[k0 + (lane >> 4) + 4 * i] : 1.0f;
        d[0] = v[i].x * g; d[cds] = v[i].y * g; d[2 * cds] = v[i].z * g; d[3 * cds] = v[i].w * g; }
    LDS_WAIT();
    const int c = lane >> 3, ns = lane & 7;
#pragma unroll
    for (int j = 0; j < 8; ++j) { const LAS float* s = scr + (8 * c) * 65 + ns + 8 * j;
        u32x4 o; o.x = pk2(s[0 * 65], s[1 * 65]); o.y = pk2(s[2 * 65], s[3 * 65]); o.z = pk2(s[4 * 65], s[5 * 65]); o.w = pk2(s[6 * 65], s[7 * 65]);
        *(u32x4*)(WT + (size_t)(n0 + ns + 8 * j) * K + k0 + 8 * c) = o; }
    LDS_WAIT();
}
__device__ __forceinline__ void ph_cvt(const PD& p, const Ctx& c) {
    LAS float* scr = (LAS float*)(c.lds) + c.wave * (64 * 65);
    const int gw = c.bid * NWAVES + c.wave, NGW = c.G * NWAVES;
    constexpr int I_IN = 32 * (PIN / 64), I_SQ = 32 * (DM / 64), I_KV = 32 * (4096 / 64), I_GU = NE * 32 * (4096 / 64), I_DN = NE * 32 * (DM / 64);
    constexpr int PER_LAYER = I_IN + 3 * I_SQ + I_KV + I_GU + I_DN;
    const int m = c.lane & 15;
    for (int it = gw; it < DEPTH * PER_LAYER; it += NGW) {
        const int l = it / PER_LAYER; int r = it % PER_LAYER;
        if (r < I_IN) { const int kb = r / (PIN / 64), nb = r % (PIN / 64); const int n0 = nb * 64;
            const float* W = p.in(I_W_IN) + (size_t)l * DM * PIN; bf16_t* WT = (bf16_t*)(p.ws() + WS_WIN) + (size_t)l * PIN * DM;
            if (n0 >= OFF_RQ && n0 < OFF_RV) {
                const int base = n0 & ~127, i0 = (n0 & 127) >> 1, s = m >> 3, mm = m & 7;
                cvt_item(W + base + 64 * s + i0 + 4 * mm, PIN, 8 * mm + s, 2, DM, WT, scr, kb * 64, n0, c.lane, p.in(I_NORM_MIX) + (size_t)l * DM);
            } else cvt_item(W + n0 + 4 * m, PIN, 4 * m, 1, DM, WT, scr, kb * 64, n0, c.lane, p.in(I_NORM_MIX) + (size_t)l * DM);
            continue; }
        r -= I_IN;
        if (r < 3 * I_SQ) { const int which = r / I_SQ; r %= I_SQ; const int kb = r / (DM / 64), nb = r % (DM / 64);
            const size_t wo = which == 0 ? WS_WOUT : (which == 1 ? WS_WCQ : WS_WCO);
            const float* W = (which == 0 ? p.in(I_W_OUT) : (which == 1 ? p.in(I_W_CQ) : p.in(I_W_CO))) + (size_t)l * DM * DM; bf16_t* WT = (bf16_t*)(p.ws() + wo) + (size_t)l * DM * DM;
            cvt_item(W + nb * 64 + 4 * m, DM, 4 * m, 1, DM, WT, scr, kb * 64, nb * 64, c.lane, which == 1 ? p.in(I_NORM_CROSS) + (size_t)l * DM : nullptr); continue; }
        r -= 3 * I_SQ;
        if (r < I_KV) { const int kb = r / 64, nb = r % 64;
            const float* W = p.in(I_W_CKV) + (size_t)l * DM * 4096; bf16_t* WT = (bf16_t*)(p.ws() + WS_WCKV) + (size_t)l * 4096 * DM;
            cvt_item(W + nb * 64 + 4 * m, 4096, 4 * m, 1, DM, WT, scr, kb * 64, nb * 64, c.lane, nullptr); continue; }
        r -= I_KV;
        if (r < I_GU) { const int e = r / (32 * 64); r %= (32 * 64); const int kb = r / 64, nb = r % 64;
            const int n0 = nb * 64, j = n0 >> 8, half = (n0 >> 7) & 1, f = 128 * j + (n0 & 127);
            const float* W = (half ? p.in(I_W_UP) : p.in(I_W_GATE)) + ((size_t)l * NE + e) * DM * FF;
            bf16_t* WT = (bf16_t*)(p.ws() + WS_WGU) + ((size_t)l * NE + e) * 4096 * DM;
            cvt_item(W + f + 4 * m, FF, 4 * m, 1, DM, WT, scr, kb * 64, n0, c.lane, p.in(I_NORM_MOE) + (size_t)l * DM); continue; }
        r -= I_GU;
        { const int e = r / (32 * 32); r %= (32 * 32); const int kb = r / 32, nb = r % 32;
            const float* W = p.in(I_W_DOWN) + ((size_t)l * NE + e) * FF * DM; bf16_t* WT = (bf16_t*)(p.ws() + WS_WDN) + ((size_t)l * NE + e) * DM * FF;
            cvt_item(W + nb * 64 + 4 * m, DM, 4 * m, 1, FF, WT, scr, kb * 64, nb * 64, c.lane, nullptr); }
    }
}

__device__ __forceinline__ void row_load_f32(const float* row, int lane, f32x4 (&v)[8]) {
#pragma unroll
    for (int j = 0; j < 8; ++j) v[j] = *(const f32x4*)(row + 256 * j + 4 * lane);
}
__device__ __forceinline__ float row_ssq(const f32x4 (&v)[8]) {
    float s = 0.f;
#pragma unroll
    for (int j = 0; j < 8; ++j) s += (v[j].x * v[j].x + v[j].y * v[j].y) + (v[j].z * v[j].z + v[j].w * v[j].w);
    return wave_sum(s);
}
__device__ __forceinline__ void row_store_bf16(bf16_t* row, int lane, const f32x4 (&v)[8]) {
#pragma unroll
    for (int j = 0; j < 8; ++j) { u32x2 o; o.x = pk2(v[j].x, v[j].y); o.y = pk2(v[j].z, v[j].w); *(u32x2*)(row + 256 * j + 4 * lane) = o; }
}
__device__ __forceinline__ float row_store_x(const f32x4 (&v)[8], float* xr, bf16_t* xbr, int lane) {
    const float rstd = rsqrtf(row_ssq(v) * (1.f / DM) + RMS_EPS);
    if (xr) {
#pragma unroll
        for (int j = 0; j < 8; ++j) *(f32x4*)(xr + 256 * j + 4 * lane) = v[j]; }
    row_store_bf16(xbr, lane, v);
    return rstd;
}
__device__ __forceinline__ void rmsnorm_row_to_bf16(const float* xrow, const float* gain, bf16_t* orow, int lane) {
    f32x4 v[8]; row_load_f32(xrow, lane, v);
    const float rstd = rsqrtf(row_ssq(v) * (1.f / DM) + RMS_EPS);
#pragma unroll
    for (int j = 0; j < 8; ++j) { const f32x4 g = *(const f32x4*)(gain + 256 * j + 4 * lane); v[j] = v[j] * rstd * g; }
    row_store_bf16(orow, lane, v);
}

__device__ __forceinline__ void ph_pre(const PD& p, const Ctx& c) {
    const int gw = c.bid * NWAVES + c.wave, NGW = c.G * NWAVES;
    for (int m = gw; m < NB * NMEM; m += NGW) rmsnorm_row_to_bf16(p.in(I_MEM) + (size_t)m * DM, p.in(I_MEM_NORM), (bf16_t*)(p.ws() + WS_MEMN) + (size_t)m * DM, c.lane);
    for (int m = gw; m < NT; m += NGW) { f32x4 v[8]; row_load_f32(p.in(I_X) + (size_t)m * DM, c.lane, v);
        const float rstd = row_store_x(v, (float*)(p.ws() + WS_XRES) + (size_t)m * DM, (bf16_t*)(p.ws() + WS_HN) + (size_t)m * DM, c.lane);
        if (c.lane == 0) ((float*)(p.ws() + WS_RS + RS_MIX))[m] = rstd; }
    { float* ct = (float*)(p.ws() + WS_ROT); float* st = ct + SEQ * 64;
      for (int i = c.bid * NTHR + c.tid; i < SEQ * 64; i += c.G * NTHR) { const int pos = i >> 6, k = i & 63;
          const float lin = (float)k / 63.0f; const float inv = 1.0f / powf(10000.0f, lin); const float ang = (float)pos * inv;
          ct[i] = (float)cos((double)ang); st[i] = (float)sin((double)ang); } }
    LAS float* sm = (LAS float*)c.lds;
    for (int u = c.bid; u < DEPTH * (SEQ / 16); u += c.G) {
        const int l = u / (SEQ / 16), t0 = (u % (SEQ / 16)) * 16;
        __syncthreads();
        if (c.tid < 16 * 17) { const int tt = c.tid / 17, k = c.tid % 17; const int t = t0 + tt; float f;
            if (k == 0) f = (float)t / (float)(SEQ - 1);
            else { const int i = (k - 1) & 7; const float band = 1e-4f + (float)i * ((7.0f - 1e-4f) / 7.0f);
                   const float ang = (2.0f * 3.14159265358979323846f) * ((float)t / (float)SEQ) * band;
                   f = (k <= 8) ? cosf(ang) : -sinf(ang); }
            sm[tt * 20 + k] = f; }
        __syncthreads();
        for (int q = c.tid; q < 16 * 64; q += NTHR) { const int tt = q >> 6, jj = q & 63; const float* w1 = p.in(I_HY_W1) + (size_t)l * 17 * 64; float a = p.in(I_HY_B1)[l * 64 + jj];
            for (int i = 0; i < 17; ++i) a += sm[tt * 20 + i] * w1[i * 64 + jj];
            sm[512 + q] = sinf(p.in(I_HY_FREQ)[l * 64 + jj] * a); }
        __syncthreads();
        for (int q = c.tid; q < 16 * 64; q += NTHR) { const int tt = q >> 6, jj = q & 63; const float* w2 = p.in(I_HY_W2) + (size_t)l * 64 * 64; float a = p.in(I_HY_B2)[l * 64 + jj];
            for (int i = 0; i < 64; ++i) a += sm[512 + tt * 64 + i] * w2[i * 64 + jj];
            sm[2048 + q] = sinf(p.in(I_HY_FREQ)[l * 64 + jj] * a); }
        __syncthreads();
        const float* w3 = p.in(I_HY_W3) + (size_t)l * 64 * 2048;
        float* kf = (float*)(p.ws() + WS_KF) + (size_t)l * 2 * 512 * 4096;
        const float min_decay = logf(1e-2f) / 1.5f, max_decay = logf(1e-2f) / 0.3f;
#pragma unroll 1
        for (int q = 0; q < 4; ++q) { const int n = c.tid + NTHR * q;
            float acc[16];
#pragma unroll
            for (int tt = 0; tt < 16; ++tt) acc[tt] = 0.f;
            for (int i = 0; i < 64; i += 4) { const float w0 = w3[(i + 0) * 2048 + n], w1 = w3[(i + 1) * 2048 + n], w2 = w3[(i + 2) * 2048 + n], w3v = w3[(i + 3) * 2048 + n];
#pragma unroll
                for (int tt = 0; tt < 16; ++tt) { const f32x4 hv = *(const LAS f32x4*)(sm + 2048 + tt * 64 + i); acc[tt] += hv.x * w0 + hv.y * w1 + hv.z * w2 + hv.w * w3v; } }
            const int o = n >> 10, dir = (n >> 9) & 1, ch = n & 511;
            const float delta = fabsf(min_decay + (max_decay - min_decay) * ((float)ch / 511.0f));
            float* kc = kf + ((size_t)o * 512 + ch) * 4096;
#pragma unroll
            for (int tt = 0; tt < 16; ++tt) { const int t = t0 + tt; const float a = acc[tt] * expf(-((float)t / (float)(SEQ - 1)) * delta);
                if (dir == 0) kc[2048 + t] = a; else { if (t >= 1) kc[2048 - t] = a; else kc[0] = 0.f; } } }
    }
}

__device__ __forceinline__ void ph_norm(const PD& p, const Ctx& c, const float* gain) {
    const int gw = c.bid * NWAVES + c.wave, NGW = c.G * NWAVES;
    for (int m = gw; m < NT; m += NGW) rmsnorm_row_to_bf16((const float*)(p.ws() + WS_XRES) + (size_t)m * DM, gain, (bf16_t*)(p.ws() + WS_HN) + (size_t)m * DM, c.lane);
}

struct EpiInProj {
    static constexpr bool PERM = true;
    bf16_t* O; const float* rc; const float* rs; const float* rstd;
    __device__ __forceinline__ void operator()(const f32x4 (&acc)[2][2][4][2], const pg8::Unit& u, int wr, int wc, int fr, int fq) const {
        const int row0 = u.pm * 256 + wr * 64 + fr, col0 = u.pn * 256 + wc * 32 + 8 * fq;
        const bool rot = (u.pn >= OFF_RQ / 256) && (u.pn < OFF_RV / 256);
        const float qs = (u.pn < OFF_RK / 256) ? 0.08838834764831845f : 1.0f;
        float rsc[2][4];
#pragma unroll
        for (int ai = 0; ai < 2; ++ai)
#pragma unroll
            for (int m = 0; m < 4; ++m) rsc[ai][m] = rstd[row0 + ai * 128 + m * 16];
#pragma unroll
        for (int ai = 0; ai < 2; ++ai)
#pragma unroll
            for (int m = 0; m < 4; ++m) { const int row = row0 + ai * 128 + m * 16; bf16_t* rowp = O + (size_t)row * PIN + col0;
#pragma unroll
                for (int bj = 0; bj < 2; ++bj) { f32x4 v0 = acc[ai][bj][m][0] * rsc[ai][m], v1 = acc[ai][bj][m][1] * rsc[ai][m];
                    if (rot) { const int pos = row & (SEQ - 1); const int i0 = ((col0 + bj * 128) & 127) >> 1;
                        const f32x4 cs = *(const f32x4*)(rc + pos * 64 + i0), sn = *(const f32x4*)(rs + pos * 64 + i0);
                        f32x4 r0, r1;
                        r0.x = (v0.x * cs.x - v0.y * sn.x) * qs; r0.y = (v0.x * sn.x + v0.y * cs.x) * qs;
                        r0.z = (v0.z * cs.y - v0.w * sn.y) * qs; r0.w = (v0.z * sn.y + v0.w * cs.y) * qs;
                        r1.x = (v1.x * cs.z - v1.y * sn.z) * qs; r1.y = (v1.x * sn.z + v1.y * cs.z) * qs;
                        r1.z = (v1.z * cs.w - v1.w * sn.w) * qs; r1.w = (v1.z * sn.w + v1.w * cs.w) * qs;
                        v0 = r0; v1 = r1; }
                    u32x4 w; w.x = cvt_pk_bf16(v0.x, v0.y); w.y = cvt_pk_bf16(v0.z, v0.w); w.z = cvt_pk_bf16(v1.x, v1.y); w.w = cvt_pk_bf16(v1.z, v1.w);
                    *(u32x4*)(rowp + bj * 128) = w; } }
    }
};
struct EpiBf16 {
    static constexpr bool PERM = true;
    bf16_t* O; int ldc; const LAS float* rl;
    __device__ __forceinline__ void operator()(const f32x4 (&acc)[2][2][4][2], const pg8::Unit& u, int wr, int wc, int fr, int fq) const {
        const int row0 = u.pm * 256 + wr * 64 + fr, col0 = u.pn * 256 + wc * 32 + 8 * fq;
#pragma unroll
        for (int ai = 0; ai < 2; ++ai)
#pragma unroll
            for (int m = 0; m < 4; ++m) { bf16_t* rowp = O + (size_t)(row0 + ai * 128 + m * 16) * ldc + col0; const float sc = rl ? rl[wr * 64 + fr + ai * 128 + m * 16] : 1.0f;
#pragma unroll
                for (int bj = 0; bj < 2; ++bj) { const f32x4 v0 = acc[ai][bj][m][0] * sc, v1 = acc[ai][bj][m][1] * sc;
                    u32x4 w; w.x = cvt_pk_bf16(v0.x, v0.y); w.y = cvt_pk_bf16(v0.z, v0.w); w.z = cvt_pk_bf16(v1.x, v1.y); w.w = cvt_pk_bf16(v1.z, v1.w);
                    *(u32x4*)(rowp + bj * 128) = w; } }
    }
};
struct EpiResid {
    static constexpr bool PERM = false;
    float* X; bf16_t* XB; float* ssq;
    __device__ __forceinline__ void operator()(const f32x4 (&acc)[2][2][4][2], const pg8::Unit& u, int wr, int wc, int fr, int fq) const {
        const int row0 = u.pm * 256 + wr * 64 + fr, col0 = u.pn * 256 + wc * 32 + 4 * fq;
#pragma unroll
        for (int ai = 0; ai < 2; ++ai)
#pragma unroll
            for (int m = 0; m < 4; ++m) { const int row = row0 + ai * 128 + m * 16; float* rowp = X + (size_t)row * DM + col0; bf16_t* rowb = XB + (size_t)row * DM + col0; float s = 0.f;
#pragma unroll
                for (int bj = 0; bj < 2; ++bj)
#pragma unroll
                    for (int n = 0; n < 2; ++n) { f32x4* q = (f32x4*)(rowp + bj * 128 + n * 16); const f32x4 v = *q + acc[ai][bj][m][n]; *q = v;
                        u32x2 w; w.x = cvt_pk_bf16(v.x, v.y); w.y = cvt_pk_bf16(v.z, v.w); *(u32x2*)(rowb + bj * 128 + n * 16) = w;
                        s += (v.x * v.x + v.y * v.y) + (v.z * v.z + v.w * v.w); }
                if (ssq) { s += __shfl_xor(s, 16); s += __shfl_xor(s, 32); if (fq == 0) ssq[(size_t)row * 32 + 4 * u.pn + wc] = s; } }
    }
};
struct EpiGU {
    static constexpr bool PERM = true;
    bf16_t* O; int npn; const float* rsx;
    __device__ __forceinline__ void operator()(const f32x4 (&acc)[2][2][4][2], const pg8::Unit& u, int wr, int wc, int fr, int fq) const {
        const int row0 = u.pm * 256 + wr * 64 + fr, col0 = (u.pn % npn) * 128 + wc * 32 + 8 * fq;
#pragma unroll
        for (int ai = 0; ai < 2; ++ai)
#pragma unroll
            for (int m = 0; m < 4; ++m) { const int row = row0 + ai * 128 + m * 16; bf16_t* rowp = O + (size_t)row * FF + col0; const float sc = rsx[row];
                float h[8];
#pragma unroll
                for (int n = 0; n < 2; ++n)
#pragma unroll
                    for (int j = 0; j < 4; ++j) { const float a = acc[ai][0][m][n][j] * sc, b = acc[ai][1][m][n][j] * sc; h[n * 4 + j] = a / (1.0f + __expf(-a)) * b; }
                u32x4 w; w.x = cvt_pk_bf16(h[0], h[1]); w.y = cvt_pk_bf16(h[2], h[3]); w.z = cvt_pk_bf16(h[4], h[5]); w.w = cvt_pk_bf16(h[6], h[7]);
                *(u32x4*)rowp = w; }
    }
};
struct EpiDown {
    static constexpr bool PERM = false;
    float* Y; int npn;
    __device__ __forceinline__ void operator()(const f32x4 (&acc)[2][2][4][2], const pg8::Unit& u, int wr, int wc, int fr, int fq) const {
        const int row0 = u.pm * 256 + wr * 64 + fr, col0 = (u.pn % npn) * 256 + wc * 32 + 4 * fq;
#pragma unroll
        for (int ai = 0; ai < 2; ++ai)
#pragma unroll
            for (int m = 0; m < 4; ++m) { float* rowp = Y + (size_t)(row0 + ai * 128 + m * 16) * DM + col0;
#pragma unroll
                for (int bj = 0; bj < 2; ++bj)
#pragma unroll
                    for (int n = 0; n < 2; ++n) *(f32x4*)(rowp + bj * 128 + n * 16) = acc[ai][bj][m][n]; }
    }
};

typedef float f32x16 __attribute__((ext_vector_type(16)));
typedef short s16x4 __attribute__((ext_vector_type(4)));
__device__ __forceinline__ bf16x8 as_bf16x8(const u32x4 v) { union { u32x4 u; bf16x8 b; } x; x.u = v; return x.b; }
__device__ __forceinline__ bf16x8 tr_pair(const LAS unsigned char* a0, const LAS unsigned char* a1) {
    const s16x4 lo = __builtin_amdgcn_ds_read_tr16_b64_v4i16((LAS s16x4*)a0), hi = __builtin_amdgcn_ds_read_tr16_b64_v4i16((LAS s16x4*)a1);
    return (bf16x8){lo.x, lo.y, lo.z, lo.w, hi.x, hi.y, hi.z, hi.w};
}
constexpr int NA_TILE_B = 9 * 64 * 128;
__device__ __forceinline__ void ph_na(const PD& p, const Ctx& c, int l) {
    const bf16_t* proj = (const bf16_t*)(p.ws() + WS_PROJ); bf16_t* ycat = (bf16_t*)(p.ws() + WS_YCAT);
    LAS unsigned char* L = c.lds; LAS float* Brp = (LAS float*)(L + 2 * NA_TILE_B);
    const int lane = c.lane, w = c.wave, qc = lane & 15, g = lane >> 4, j = w & 3;
    const int tq = (lane & 15) >> 2, tp = lane & 3, fvh = 2 * (g & 1) + (tq >> 1);
    const int kc0 = min(max(16 * j - 8, 0), 32);
    int lbV[4];
#pragma unroll
    for (int db = 0; db < 4; ++db) lbV[db] = NA_TILE_B + (4 * g + tq) * 128 + 16 * (2 * (db ^ fvh) + (tp >> 1)) + 8 * (tp & 1);
    const int qcol = 16 * j + qc, cs = min(max(qcol - 8, 0), 48);
    for (int u = c.bid; u < NB * NAH * (ROWS / 2); u += c.G) {
        const int rp = u % (ROWS / 2), h = (u / (ROWS / 2)) % NAH, b = u / ((ROWS / 2) * NAH);
        const int r0 = 2 * rp, R0 = min(max(r0 - 4, 0), ROWS - 8), nvalid = min(9, ROWS - R0) * 64;
        const int rr = r0 + (w >> 2), rsw = min(max(rr - 4, 0), ROWS - 8);
        const size_t tok0 = (size_t)b * SEQ + R0 * 64;
        __syncthreads();
#pragma unroll
        for (int i = 0; i < 9; ++i) { const int idx = (8 * i + w) * 8 + (lane >> 3), ps = lane & 7; const int isrc = min(idx, nvalid - 1);
            const bf16_t* rsrc = proj + (tok0 + isrc) * PIN + h * 64;
            __builtin_amdgcn_global_load_lds((const GAS unsigned*)(rsrc + OFF_NAK + 8 * (ps ^ ((idx >> 1) & 7))), (LAS unsigned*)(L + (8 * i + w) * 1024), 16, 0, 0);
            __builtin_amdgcn_global_load_lds((const GAS unsigned*)(rsrc + OFF_NAV + 8 * (ps ^ (((idx >> 1) & 3) << 1))), (LAS unsigned*)(L + NA_TILE_B + (8 * i + w) * 1024), 16, 0, 0); }
        { const float* rpb = p.in(I_NA_RPB) + ((size_t)l * NAH + h) * 15 * 31; if (c.tid < 15 * 31) Brp[c.tid] = rpb[c.tid]; }
        const size_t tok = (size_t)b * SEQ + rr * 64 + qcol;
        bf16x8 qf[2];
        { const bf16_t* qrow = proj + tok * PIN + OFF_NAQ + h * 64 + 8 * g; qf[0] = as_bf16x8(*(const u32x4*)qrow); qf[1] = as_bf16x8(*(const u32x4*)(qrow + 32)); }
        asm volatile("s_waitcnt vmcnt(0)" ::: "memory");
        __syncthreads();
        f32x4 acc[16];
        const int trow0 = rsw - R0;
#pragma unroll
        for (int kb = 0; kb < 16; ++kb) { const int idx = (trow0 + (kb >> 1)) * 64 + kc0 + 16 * (kb & 1) + qc;
            const LAS unsigned char* kr = L + idx * 128; const int f = (idx >> 1) & 7;
            f32x4 a4 = (f32x4){0.f, 0.f, 0.f, 0.f};
            a4 = __builtin_amdgcn_mfma_f32_16x16x32_bf16(*(const LAS bf16x8*)(kr + 16 * ((0 + g) ^ f)), qf[0], a4, 0, 0, 0);
            a4 = __builtin_amdgcn_mfma_f32_16x16x32_bf16(*(const LAS bf16x8*)(kr + 16 * ((4 + g) ^ f)), qf[1], a4, 0, 0, 0);
            acc[kb] = a4; }
        float m = -INFINITY;
#pragma unroll
        for (int kb = 0; kb < 16; ++kb) { const int krow = rsw + (kb >> 1); const LAS float* brow = Brp + (krow - rr + 7) * 31 + 15 - qcol;
#pragma unroll
            for (int r = 0; r < 4; ++r) { const int kc = kc0 + 16 * (kb & 1) + 4 * g + r; const bool ok = (kc >= cs) && (kc < cs + 16);
                const float s = ok ? acc[kb][r] * 0.125f + brow[ok ? kc : qcol] : -INFINITY; acc[kb][r] = s; m = fmaxf(m, s); } }
        m = fmaxf(m, __shfl_xor(m, 16)); m = fmaxf(m, __shfl_xor(m, 32));
        float sum = 0.f;
#pragma unroll
        for (int kb = 0; kb < 16; ++kb)
#pragma unroll
            for (int r = 0; r < 4; ++r) { const float e = __builtin_amdgcn_exp2f((acc[kb][r] - m) * 1.4426950408889634f); acc[kb][r] = e; sum += e; }
        sum += __shfl_xor(sum, 16); sum += __shfl_xor(sum, 32);
        const float inv = 1.0f / sum;
        f32x4 o[4];
#pragma unroll
        for (int db = 0; db < 4; ++db) o[db] = (f32x4){0.f, 0.f, 0.f, 0.f};
#pragma unroll
        for (int s = 0; s < 8; ++s) { u32x4 wv;
            wv.x = cvt_pk_bf16(acc[2 * s][0] * inv, acc[2 * s][1] * inv); wv.y = cvt_pk_bf16(acc[2 * s][2] * inv, acc[2 * s][3] * inv);
            wv.z = cvt_pk_bf16(acc[2 * s + 1][0] * inv, acc[2 * s + 1][1] * inv); wv.w = cvt_pk_bf16(acc[2 * s + 1][2] * inv, acc[2 * s + 1][3] * inv);
            const bf16x8 pbv = as_bf16x8(wv);
            const int rb = ((trow0 + s) * 64 + kc0) * 128;
#pragma unroll
            for (int db = 0; db < 4; ++db) { const bf16x8 av = tr_pair(L + lbV[db] + rb, L + lbV[db] + rb + 16 * 128);
                o[db] = __builtin_amdgcn_mfma_f32_16x16x32_bf16(av, pbv, o[db], 0, 0, 0); } }
        bf16_t* yrow = ycat + tok * DM + h * 64 + 4 * g;
#pragma unroll
        for (int db = 0; db < 4; ++db) { u32x2 wv; wv.x = cvt_pk_bf16(o[db][0], o[db][1]); wv.y = cvt_pk_bf16(o[db][2], o[db][3]); *(u32x2*)(yrow + 16 * db) = wv; }
    }
}

__device__ __forceinline__ void ph_hypre(const PD& p, const Ctx& c, int l) {
    const bf16_t* proj = (const bf16_t*)(p.ws() + WS_PROJ); bf16_t* hs = (bf16_t*)(p.ws() + WS_HS);
    LAS float* U = (LAS float*)c.lds;
    const float* cw = p.in(I_HY_CONV_W) + (size_t)l * 3 * 1536; const float* cb = p.in(I_HY_CONV_B) + (size_t)l * 1536;
    for (int u = c.bid; u < NB * 32 * 24; u += c.G) {
        const int cg = u % 24, tt = (u / 24) % 32, b = u / (24 * 32); const int t0 = tt * 64;
        __syncthreads();
        for (int idx = c.tid; idx < 66 * 8; idx += NTHR) { const int rr = idx >> 3, ck = idx & 7; const int t = t0 - 1 + rr; float f[8];
            if (t >= 0 && t < SEQ) unpack8(*(const u32x4*)(proj + (size_t)(b * SEQ + t) * PIN + OFF_HY + cg * 64 + 8 * ck), f);
            else {
#pragma unroll
                for (int e = 0; e < 8; ++e) f[e] = 0.f; }
#pragma unroll
            for (int e = 0; e < 8; ++e) U[rr * 65 + 8 * ck + e] = f[e]; }
        __syncthreads();
        { const int cc = c.tid & 63, tg = c.tid >> 6; const int ch = cg * 64 + cc;
          const float w0 = cw[ch], w1 = cw[1536 + ch], w2 = cw[3072 + ch], bb = cb[ch];
          float x[10];
#pragma unroll
          for (int r = 0; r < 10; ++r) x[r] = U[(8 * tg + r) * 65 + cc];
          float s[8];
#pragma unroll
          for (int r = 0; r < 8; ++r) s[r] = x[r] * w0 + x[r + 1] * w1 + x[r + 2] * w2 + bb;
          u32x4 o; o.x = pk2(s[0], s[1]); o.y = pk2(s[2], s[3]); o.z = pk2(s[4], s[5]); o.w = pk2(s[6], s[7]);
          *(u32x4*)(hs + ((size_t)b * 1536 + ch) * SEQ + t0 + 8 * tg) = o; }
    }
}

__device__ __forceinline__ void ph_kcopy(const PD& p, const Ctx& c) {
    LAS float* kf = (LAS float*)c.lds;
    for (int u = c.bid; u < DEPTH * 2 * HYW; u += c.G) {
        const float* src = (const float*)(p.ws() + WS_KF) + (size_t)u * 4096; bf16_t* dst = (bf16_t*)(p.ws() + WS_KFB) + (size_t)u * 4 * KFC;
        __syncthreads();
        for (int i = c.tid; i < 1024; i += NTHR) *(LAS f32x4*)(kf + 4 * i) = *(const f32x4*)(src + 4 * i);
        __syncthreads();
        for (int q = c.tid; q < 4 * (KFC / 8); q += NTHR) { const int rho = q / (KFC / 8), x0 = (q % (KFC / 8)) * 8; float v[8];
#pragma unroll
            for (int e = 0; e < 8; ++e) { const int x = x0 + e - rho; v[e] = (x >= 1 && x <= 4095) ? kf[4096 - x] : 0.f; }
            u32x4 o; o.x = pk2(v[0], v[1]); o.y = pk2(v[2], v[3]); o.z = pk2(v[4], v[5]); o.w = pk2(v[6], v[7]);
            *(u32x4*)(dst + rho * KFC + x0) = o; }
    }
}

constexpr int HY_ZP = 2496, HY_ZPB = HY_ZP * 2 + 16;
constexpr int HY_KRB = KFC * 2;
constexpr int HY_IMG = 33 * 1024;
constexpr int HY_LDS_KR0 = 0, HY_LDS_KR1 = HY_IMG, HY_LDS_Z = 2 * HY_IMG, HY_LDS_G = HY_LDS_Z + 4 * HY_ZPB;
__device__ __forceinline__ void ph_hyconv(const PD& p, const Ctx& c, int l) {
    bf16_t* hs = (bf16_t*)(p.ws() + WS_HS);
    LAS unsigned char* L = c.lds;
    const int lane = c.lane, w = c.wave, a = lane & 31, hh = lane >> 5, nb = a >> 3, il = a & 7;
    const int laneA = (a & 3) * HY_KRB + 2 * (2048 + 8 * hh - 4 * (a >> 2));
    const int laneB = HY_LDS_Z + nb * HY_ZPB + 2 * (224 + 32 * (8 * w + il) + 8 * hh);
    for (int u = c.bid; u < HYW; u += c.G) {
        const int ch = u;
        __syncthreads();
        { const unsigned char* f0 = (const unsigned char*)((const bf16_t*)(p.ws() + WS_KFB) + (((size_t)l * 2 + 0) * HYW + ch) * 4 * KFC);
          const unsigned char* f1 = (const unsigned char*)((const bf16_t*)(p.ws() + WS_KFB) + (((size_t)l * 2 + 1) * HYW + ch) * 4 * KFC);
          for (int q = w; q < 33; q += NWAVES) {
              __builtin_amdgcn_global_load_lds((const GAS unsigned*)(f0 + q * 1024 + lane * 16), (LAS unsigned*)(L + HY_LDS_KR0 + q * 1024), 16, 0, 0);
              __builtin_amdgcn_global_load_lds((const GAS unsigned*)(f1 + q * 1024 + lane * 16), (LAS unsigned*)(L + HY_LDS_KR1 + q * 1024), 16, 0, 0); }
          for (int q = w; q < 48; q += NWAVES) { const int part = q >> 4, b = (q >> 2) & 3, pc = q & 3;
              const bf16_t* src = hs + ((size_t)b * 1536 + (part == 0 ? 1024 : (part - 1) * 512) + ch) * SEQ + pc * 512 + lane * 8;
              LAS unsigned char* dst = part == 0 ? (L + HY_LDS_Z + b * HY_ZPB + 448 + pc * 1024) : (L + HY_LDS_G + ((part - 1) * 4 + b) * 4096 + pc * 1024);
              __builtin_amdgcn_global_load_lds((const GAS unsigned*)src, (LAS unsigned*)dst, 16, 0, 0); }
          for (int i = c.tid; i < NB * 2 * 28; i += NTHR) { const int b = i / 56, r = i % 56; const int e0 = r < 28 ? 8 * r : 224 + SEQ + 8 * (r - 28);
              *(LAS u32x4*)(L + HY_LDS_Z + b * HY_ZPB + 2 * e0) = (u32x4){0u, 0u, 0u, 0u}; } }
        asm volatile("s_waitcnt vmcnt(0)" ::: "memory");
        __syncthreads();
#pragma unroll 1
        for (int o = 0; o < 2; ++o) {
            const LAS unsigned char* KR = L + (o ? HY_LDS_KR1 : HY_LDS_KR0) + laneA;
            f32x16 acc;
#pragma unroll
            for (int r = 0; r < 16; ++r) acc[r] = 0.f;
            asm volatile("" : "+v"(acc));
            const int d_lo = 8 * w - 63, d_hi = 8 * w + 7;
#pragma unroll 2
            for (int delta = d_lo; delta <= d_hi; ++delta) {
                const LAS unsigned char* ka = KR - 64 * delta; const LAS unsigned char* zb = L + laneB - 64 * delta;
#pragma unroll
                for (int sp = 0; sp < 2; ++sp) {
                    const u32x2 a0 = *(const LAS u32x2*)(ka + 32 * sp), a1 = *(const LAS u32x2*)(ka + 32 * sp + 8);
                    const bf16x8 av = as_bf16x8((u32x4){a0.x, a0.y, a1.x, a1.y});
                    const bf16x8 bv = *(const LAS bf16x8*)(zb + 32 * sp);
                    acc = __builtin_amdgcn_mfma_f32_32x32x16_bf16(av, bv, acc, 0, 0, 0); } }
            __syncthreads();
            const float sd = p.in(I_HY_SKIP)[((size_t)l * 2 + o) * HYW + ch];
            const int tb = 32 * (8 * w + il) + 4 * hh;
            const LAS unsigned char* grow = L + HY_LDS_G + (o * 4 + nb) * 4096 + 2 * tb;
            LAS unsigned char* zrow = L + HY_LDS_Z + nb * HY_ZPB + 2 * (224 + tb);
#pragma unroll
            for (int i4 = 0; i4 < 4; ++i4) { const u32x2 gv = *(const LAS u32x2*)(grow + 16 * i4); const u32x2 zv = *(const LAS u32x2*)(zrow + 16 * i4);
                const float g0 = bf2f(gv.x & 0xffffu), g1 = bf2f(gv.x >> 16), g2 = bf2f(gv.y & 0xffffu), g3 = bf2f(gv.y >> 16);
                const float z0 = bf2f(zv.x & 0xffffu), z1 = bf2f(zv.x >> 16), z2 = bf2f(zv.y & 0xffffu), z3 = bf2f(zv.y >> 16);
                u32x2 wv; wv.x = cvt_pk_bf16(g0 * (acc[4 * i4 + 0] + sd * z0), g1 * (acc[4 * i4 + 1] + sd * z1)); wv.y = cvt_pk_bf16(g2 * (acc[4 * i4 + 2] + sd * z2), g3 * (acc[4 * i4 + 3] + sd * z3));
                *(LAS u32x2*)(zrow + 16 * i4) = wv; }
            __syncthreads();
        }
        for (int i = c.tid; i < NB * (SEQ / 8); i += NTHR) { const int b = i >> 8, t8 = i & 255;
            *(u32x4*)(hs + ((size_t)b * 1536 + 1024 + ch) * SEQ + 8 * t8) = *(const LAS u32x4*)(L + HY_LDS_Z + b * HY_ZPB + 2 * (224 + 8 * t8)); }
    }
}

__device__ __forceinline__ void ph_ret(const PD& p, const Ctx& c, int l) {
    const bf16_t* proj = (const bf16_t*)(p.ws() + WS_PROJ); bf16_t* ycat = (bf16_t*)(p.ws() + WS_YCAT);
    LAS unsigned char* L = c.lds;
    const int lane = c.lane, cc = lane & 31, hh = lane >> 5, w = c.wave;
    const int tq = (lane & 15) >> 2, tp = lane & 3, tblk = (lane >> 4) & 1;
    int lbV[4];
#pragma unroll
    for (int c4 = 0; c4 < 4; ++c4) lbV[c4] = 256 * (4 * hh + tq) + 16 * (((c4 ^ tq) << 2) | (2 * tblk + (tp >> 1))) + 8 * (tp & 1);
    const int kA = cc * 256, kX = cc & 15;
    const int g_row0 = w * 4 + (lane >> 4), g_ps = lane & 15;
    for (int u = c.bid; u < NB * RETH * 8; u += c.G) {
        const int qt = u & 7, h = (u >> 3) % RETH, b = u / (8 * RETH);
        const int tw0 = qt * 256 + 32 * w;
        const float lf2 = log2f(1.0f - exp2f(-5.0f - (float)h)), lb2 = log2f(1.0f - exp2f(-5.5f - (float)h));
        float Gf1[4], Gb1[4];
#pragma unroll
        for (int j = 0; j < 4; ++j) { Gf1[j] = exp2f(-lf2 * (float)j); Gb1[j] = exp2f(lb2 * (float)j); }
        const bf16_t* kvb = proj + (size_t)(b * SEQ) * PIN + h * RETD;
        unsigned rK[2], rV[2];
#pragma unroll
        for (int _i = 0; _i < 2; ++_i) { const int _row = g_row0 + 32 * _i; rK[_i] = (unsigned)(_row * PIN + OFF_RK + 8 * (g_ps ^ (_row & 15))) * 2u; rV[_i] = (unsigned)(_row * PIN + OFF_RV + 8 * (g_ps ^ ((_row & 3) << 2))) * 2u; }
#define RT_ISSUE(kt) do { const GAS char* _tb = (const GAS char*)(kvb + (size_t)(64 * (kt)) * PIN); _Pragma("unroll") for (int _i = 0; _i < 2; ++_i) { \
            __builtin_amdgcn_global_load_lds((const GAS unsigned*)(_tb + rK[_i]), (LAS unsigned*)(L + ((kt) & 1) * 32768 + (8 * _i + w) * 1024), 16, 0, 0); \
            __builtin_amdgcn_global_load_lds((const GAS unsigned*)(_tb + rV[_i]), (LAS unsigned*)(L + ((kt) & 1) * 32768 + 16384 + (8 * _i + w) * 1024), 16, 0, 0); } } while (0)
        __syncthreads();
        RT_ISSUE(0);
        bf16x8 qf[8];
        { const bf16_t* qrow = proj + (unsigned)((b * SEQ + tw0 + cc) * PIN + OFF_RQ + h * RETD + 8 * hh);
#pragma unroll
          for (int ks = 0; ks < 8; ++ks) qf[ks] = as_bf16x8(*(const u32x4*)(qrow + 16 * ks)); }
        f32x16 o[4];
#pragma unroll
        for (int c4 = 0; c4 < 4; ++c4) {
#pragma unroll
            for (int r = 0; r < 16; ++r) o[c4][r] = 0.f;
            asm volatile("" : "+v"(o[c4])); }
        asm volatile("s_waitcnt vmcnt(0)" ::: "memory");
        __syncthreads();
#pragma unroll 1
        for (int kt = 0; kt < SEQ / 64; ++kt) {
            if (kt + 1 < SEQ / 64) RT_ISSUE(kt + 1);
            const LAS unsigned char* Kt = L + (kt & 1) * 32768; const LAS unsigned char* Vt = Kt + 16384;
            f32x16 s[2];
#pragma unroll
            for (int kb = 0; kb < 2; ++kb) {
#pragma unroll
                for (int r = 0; r < 16; ++r) s[kb][r] = 0.f;
                asm volatile("" : "+v"(s[kb])); }
#pragma unroll
            for (int ks = 0; ks < 8; ++ks) { const LAS unsigned char* Ka = Kt + kA + 16 * ((2 * ks + hh) ^ kX);
#pragma unroll
                for (int kb = 0; kb < 2; ++kb) s[kb] = __builtin_amdgcn_mfma_f32_32x32x16_bf16(*(const LAS bf16x8*)(Ka + kb * 8192), qf[ks], s[kb], 0, 0, 0); }
            const int s0 = 64 * kt;
            if (s0 + 63 <= tw0) {
#pragma unroll
                for (int kb = 0; kb < 2; ++kb) { const int base = tw0 + cc - (s0 + 32 * kb + 4 * hh);
#pragma unroll
                    for (int i4 = 0; i4 < 4; ++i4) { const float e8 = __builtin_amdgcn_exp2f(lf2 * (float)(base - 8 * i4));
#pragma unroll
                        for (int j = 0; j < 4; ++j) s[kb][4 * i4 + j] *= e8 * Gf1[j]; } }
            } else if (s0 > tw0 + 31) {
#pragma unroll
                for (int kb = 0; kb < 2; ++kb) { const int nbase = (s0 + 32 * kb + 4 * hh) - (tw0 + cc);
#pragma unroll
                    for (int i4 = 0; i4 < 4; ++i4) { const float e8 = __builtin_amdgcn_exp2f(lb2 * (float)(nbase + 8 * i4));
#pragma unroll
                        for (int j = 0; j < 4; ++j) s[kb][4 * i4 + j] *= e8 * Gb1[j]; } }
            } else {
#pragma unroll
                for (int kb = 0; kb < 2; ++kb)
#pragma unroll
                    for (int r = 0; r < 16; ++r) { const int diff = (tw0 + cc) - (s0 + 32 * kb + 4 * hh + (r & 3) + 8 * (r >> 2));
                        s[kb][r] *= __builtin_amdgcn_exp2f((diff >= 0 ? lf2 : -lb2) * (float)diff); }
            }
            bf16x8 pb[2][2];
#pragma unroll
            for (int kb = 0; kb < 2; ++kb)
#pragma unroll
                for (int sx = 0; sx < 2; ++sx) { u32x4 wv;
                    wv.x = cvt_pk_bf16(s[kb][8 * sx + 0], s[kb][8 * sx + 1]); wv.y = cvt_pk_bf16(s[kb][8 * sx + 2], s[kb][8 * sx + 3]);
                    wv.z = cvt_pk_bf16(s[kb][8 * sx + 4], s[kb][8 * sx + 5]); wv.w = cvt_pk_bf16(s[kb][8 * sx + 6], s[kb][8 * sx + 7]);
                    pb[kb][sx] = as_bf16x8(wv); }
#pragma unroll
            for (int kb = 0; kb < 2; ++kb)
#pragma unroll
                for (int sx = 0; sx < 2; ++sx) { const int rb = (32 * kb + 16 * sx) * 256;
#pragma unroll
                    for (int c4 = 0; c4 < 4; ++c4) { const bf16x8 a = tr_pair(Vt + lbV[c4] + rb, Vt + lbV[c4] + rb + 8 * 256);
                        o[c4] = __builtin_amdgcn_mfma_f32_32x32x16_bf16(a, pb[kb][sx], o[c4], 0, 0, 0); } }
            asm volatile("s_waitcnt vmcnt(0)" ::: "memory");
            __syncthreads();
        }
#undef RT_ISSUE
        float sm = 0.f;
#pragma unroll
        for (int c4 = 0; c4 < 4; ++c4)
#pragma unroll
            for (int r = 0; r < 16; ++r) sm += o[c4][r];
        sm += __shfl_xor(sm, 32);
        const float mu = sm * (1.f / RETD); float v2 = 0.f;
#pragma unroll
        for (int c4 = 0; c4 < 4; ++c4)
#pragma unroll
            for (int r = 0; r < 16; ++r) { const float d = o[c4][r] - mu; o[c4][r] = d; v2 += d * d; }
        v2 += __shfl_xor(v2, 32);
        const float rstd = rsqrtf(v2 * (1.f / RETD) + GN_EPS);
        int cc2 = cc; asm volatile("" : "+v"(cc2));
        const int tok2 = b * SEQ + tw0 + cc2;
        const bf16_t* grow = proj + (unsigned)(tok2 * PIN + OFF_RG + h * RETD + 4 * hh); bf16_t* yrow = ycat + (unsigned)(tok2 * DM + NAW + HYW + h * RETD + 4 * hh);
#pragma unroll
        for (int c4 = 0; c4 < 4; ++c4)
#pragma unroll
            for (int i4 = 0; i4 < 4; ++i4) { const u32x2 gv = *(const u32x2*)(grow + 32 * c4 + 8 * i4);
                const float g0 = bf2f(gv.x & 0xffffu), g1 = bf2f(gv.x >> 16), g2 = bf2f(gv.y & 0xffffu), g3 = bf2f(gv.y >> 16);
                u32x2 wv; wv.x = cvt_pk_bf16(o[c4][4 * i4 + 0] * rstd * (g0 / (1.0f + __expf(-g0))), o[c4][4 * i4 + 1] * rstd * (g1 / (1.0f + __expf(-g1))));
                wv.y = cvt_pk_bf16(o[c4][4 * i4 + 2] * rstd * (g2 / (1.0f + __expf(-g2))), o[c4][4 * i4 + 3] * rstd * (g3 / (1.0f + __expf(-g3))));
                *(u32x2*)(yrow + 32 * c4 + 8 * i4) = wv; }
    }
}

constexpr int GN_PITCH = 1040;
__device__ __forceinline__ void ph_gnorm(const PD& p, const Ctx& c, int l) {
    const float* gain = p.in(I_BRANCH_NORM) + (size_t)l * DM;
    const bf16_t* hs = (const bf16_t*)(p.ws() + WS_HS);
    LAS unsigned char* T = c.lds;
    for (int u = c.bid; u < NT / 32; u += c.G) {
        const int b = u / (SEQ / 32), t0 = (u % (SEQ / 32)) * 32;
        __syncthreads();
        for (int q = c.tid; q < HYW * 4; q += NTHR) { const int ch = q >> 2, tq = q & 3;
            const u32x4 v = *(const u32x4*)(hs + ((size_t)b * 1536 + 1024 + ch) * SEQ + t0 + 8 * tq);
            LAS unsigned short* d = (LAS unsigned short*)(T + (8 * tq) * GN_PITCH + 2 * ch);
            d[0 * (GN_PITCH / 2)] = (unsigned short)(v.x & 0xffffu); d[1 * (GN_PITCH / 2)] = (unsigned short)(v.x >> 16); d[2 * (GN_PITCH / 2)] = (unsigned short)(v.y & 0xffffu); d[3 * (GN_PITCH / 2)] = (unsigned short)(v.y >> 16);
            d[4 * (GN_PITCH / 2)] = (unsigned short)(v.z & 0xffffu); d[5 * (GN_PITCH / 2)] = (unsigned short)(v.z >> 16); d[6 * (GN_PITCH / 2)] = (unsigned short)(v.w & 0xffffu); d[7 * (GN_PITCH / 2)] = (unsigned short)(v.w >> 16); }
        __syncthreads();
        for (int rr = c.wave; rr < 32; rr += NWAVES) { const int m = b * SEQ + t0 + rr;
            const bf16_t* yr = (const bf16_t*)(p.ws() + WS_YCAT) + (size_t)m * DM; bf16_t* orow = (bf16_t*)(p.ws() + WS_YN) + (size_t)m * DM;
            float v[4][8]; float ss[3] = {0.f, 0.f, 0.f};
#pragma unroll
            for (int j = 0; j < 4; ++j) { const int e0 = 512 * j + 8 * c.lane; const int grp = e0 < NAW ? 0 : (e0 < NAW + HYW ? 1 : 2);
                u32x4 raw; if (grp == 1) raw = *(const LAS u32x4*)(T + rr * GN_PITCH + 2 * (e0 - NAW)); else raw = *(const u32x4*)(yr + e0);
                unpack8(raw, v[j]);
                float s = 0.f;
#pragma unroll
                for (int i = 0; i < 8; ++i) s += v[j][i] * v[j][i];
                ss[0] += grp == 0 ? s : 0.f; ss[1] += grp == 1 ? s : 0.f; ss[2] += grp == 2 ? s : 0.f; }
            const float r0 = rsqrtf(wave_sum(ss[0]) * (1.f / NAW) + RMS_EPS), r1 = rsqrtf(wave_sum(ss[1]) * (1.f / HYW) + RMS_EPS), r2 = rsqrtf(wave_sum(ss[2]) * (1.f / RETW) + RMS_EPS);
#pragma unroll
            for (int j = 0; j < 4; ++j) { const int e0 = 512 * j + 8 * c.lane; const float rs = e0 < NAW ? r0 : (e0 < NAW + HYW ? r1 : r2);
                const f32x4 g0 = *(const f32x4*)(gain + e0), g1 = *(const f32x4*)(gain + e0 + 4);
                u32x4 wv; wv.x = pk2(v[j][0] * rs * g0.x, v[j][1] * rs * g0.y); wv.y = pk2(v[j][2] * rs * g0.z, v[j][3] * rs * g0.w);
                wv.z = pk2(v[j][4] * rs * g1.x, v[j][5] * rs * g1.y); wv.w = pk2(v[j][6] * rs * g1.z, v[j][7] * rs * g1.w);
                *(u32x4*)(orow + e0) = wv; } }
    }
}

__device__ __forceinline__ void ph_xatt(const PD& p, const Ctx& c, int l) {
    const bf16_t* qc = (const bf16_t*)(p.ws() + WS_QC); const bf16_t* kv = (const bf16_t*)(p.ws() + WS_KVC) + (size_t)l * 1024 * 4096; bf16_t* oc = (bf16_t*)(p.ws() + WS_OC);
    LAS unsigned char* L = c.lds;
    const int lane = c.lane, cc = lane & 31, hh = lane >> 5;
    const int fK = (cc >> 1) & 7;
    const int tq = (lane & 15) >> 2, tp = lane & 3, tblk = (lane >> 4) & 1, fV = ((tq >> 1) & 1) << 2;
    const int lbV0 = (4 * hh + tq) * 128 + 16 * (fV + 2 * tblk + (tp >> 1)) + 8 * (tp & 1);
    const int lbV1 = (4 * hh + tq) * 128 + 16 * ((4 ^ fV) + 2 * tblk + (tp >> 1)) + 8 * (tp & 1);
    for (int u = c.bid; u < NB * XH * 8; u += c.G) {
        const int qt = u & 7, h = (u >> 3) & 3, b = u >> 5;
        const bf16_t* kbase = kv + (size_t)(b * NMEM) * 4096 + h * XD;
        const size_t tok = (size_t)b * SEQ + qt * 256 + c.wave * 32 + cc;
        const bf16_t* qrow = qc + tok * DM + h * XD + 8 * hh;
        const int g_row0 = c.wave * 8 + (lane >> 3), g_ps = lane & 7;
#define XA_ISSUE(ci) do { const bf16_t* _src = kbase + ((ci) < 8 ? 64 * (ci) : 2048 + 64 * ((ci) - 8)); \
        _Pragma("unroll") for (int _i = 0; _i < 4; ++_i) { const int _row = g_row0 + 64 * _i; const int _f = (ci) < 8 ? ((_row >> 1) & 7) : (((_row >> 1) & 1) << 2); \
            __builtin_amdgcn_global_load_lds((const GAS unsigned*)(_src + (size_t)_row * 4096 + 8 * (g_ps ^ _f)), (LAS unsigned*)(L + ((ci) & 1) * 32768 + (8 * _i + c.wave) * 1024), 16, 0, 0); } } while (0)
#define XA_COMMIT(ci) asm volatile("s_waitcnt vmcnt(0)" ::: "memory")
        __syncthreads();
        XA_ISSUE(0); XA_COMMIT(0);
        bf16x8 qf[4], qn[4];
#pragma unroll
        for (int ks = 0; ks < 4; ++ks) qf[ks] = as_bf16x8(*(const u32x4*)(qrow + 16 * ks));
        __syncthreads();
        f32x16 acc[8];
#pragma unroll
        for (int kb = 0; kb < 8; ++kb)
#pragma unroll
            for (int r = 0; r < 16; ++r) acc[kb][r] = 0.f;
#pragma unroll 1
        for (int ci = 0; ci < 8; ++ci) {
            XA_ISSUE(ci + 1);
            if (ci + 1 < 8) {
#pragma unroll
                for (int ks = 0; ks < 4; ++ks) qn[ks] = as_bf16x8(*(const u32x4*)(qrow + 64 * (ci + 1) + 16 * ks)); }
            const LAS unsigned char* S = L + (ci & 1) * 32768 + cc * 128;
#pragma unroll
            for (int ks = 0; ks < 4; ++ks) { const LAS unsigned char* Sk = S + 16 * ((2 * ks + hh) ^ fK);
#pragma unroll
                for (int kb = 0; kb < 8; ++kb) { const bf16x8 a = *(const LAS bf16x8*)(Sk + kb * 4096);
                    acc[kb] = __builtin_amdgcn_mfma_f32_32x32x16_bf16(a, qf[ks], acc[kb], 0, 0, 0);
                    if ((kb & 3) == 3) __builtin_amdgcn_sched_barrier(0); } }
            XA_COMMIT(ci + 1);
#pragma unroll
            for (int ks = 0; ks < 4; ++ks) qf[ks] = qn[ks];
            __syncthreads();
        }
        bf16x8 pb[8][2];
        { float m = -INFINITY;
#pragma unroll
          for (int kb = 0; kb < 8; ++kb)
#pragma unroll
              for (int r = 0; r < 16; ++r) m = fmaxf(m, acc[kb][r]);
          m = fmaxf(m, __shfl_xor(m, 32));
          const float sc = 0.04419417382415922f * 1.4426950408889634f; const float ms = m * sc; float sum = 0.f;
#pragma unroll
          for (int kb = 0; kb < 8; ++kb)
#pragma unroll
              for (int r = 0; r < 16; ++r) { const float e = __builtin_amdgcn_exp2f(acc[kb][r] * sc - ms); acc[kb][r] = e; sum += e; }
          sum += __shfl_xor(sum, 32);
          const float inv = 1.0f / sum;
#pragma unroll
          for (int kb = 0; kb < 8; ++kb)
#pragma unroll
              for (int s = 0; s < 2; ++s) { u32x4 w;
                  w.x = cvt_pk_bf16(acc[kb][8 * s + 0] * inv, acc[kb][8 * s + 1] * inv); w.y = cvt_pk_bf16(acc[kb][8 * s + 2] * inv, acc[kb][8 * s + 3] * inv);
                  w.z = cvt_pk_bf16(acc[kb][8 * s + 4] * inv, acc[kb][8 * s + 5] * inv); w.w = cvt_pk_bf16(acc[kb][8 * s + 6] * inv, acc[kb][8 * s + 7] * inv);
                  pb[kb][s] = as_bf16x8(w); } }
        bf16_t* orow = oc + tok * DM + h * XD + 4 * hh;
#pragma unroll 1
        for (int ci = 8; ci < 16; ++ci) {
            if (ci + 1 < 16) XA_ISSUE(ci + 1);
            const LAS unsigned char* S = L + (ci & 1) * 32768;
            f32x16 o[2];
#pragma unroll
            for (int db = 0; db < 2; ++db) {
#pragma unroll
                for (int r = 0; r < 16; ++r) o[db][r] = 0.f;
                asm volatile("" : "+v"(o[db])); }
#pragma unroll
            for (int kb = 0; kb < 8; ++kb)
#pragma unroll
                for (int s = 0; s < 2; ++s) {
                    const bf16x8 a0 = tr_pair(S + lbV0 + (32 * kb + 16 * s) * 128, S + lbV0 + (32 * kb + 16 * s + 8) * 128);
                    const bf16x8 a1 = tr_pair(S + lbV1 + (32 * kb + 16 * s) * 128, S + lbV1 + (32 * kb + 16 * s + 8) * 128);
                    o[0] = __builtin_amdgcn_mfma_f32_32x32x16_bf16(a0, pb[kb][s], o[0], 0, 0, 0);
                    o[1] = __builtin_amdgcn_mfma_f32_32x32x16_bf16(a1, pb[kb][s], o[1], 0, 0, 0); }
#pragma unroll
            for (int db = 0; db < 2; ++db)
#pragma unroll
                for (int i4 = 0; i4 < 4; ++i4) { u32x2 w; w.x = cvt_pk_bf16(o[db][4 * i4 + 0], o[db][4 * i4 + 1]); w.y = cvt_pk_bf16(o[db][4 * i4 + 2], o[db][4 * i4 + 3]);
                    *(u32x2*)(orow + 64 * (ci - 8) + 32 * db + 8 * i4) = w; }
            if (ci + 1 < 16) XA_COMMIT(ci + 1);
            __syncthreads();
        }
#undef XA_ISSUE
#undef XA_COMMIT
    }
}

__device__ __forceinline__ void ph_router(const PD& p, const Ctx& c, int l) {
    const int gw = c.bid * NWAVES + c.wave, NGW = c.G * NWAVES;
    const float* gain = p.in(I_NORM_MOE) + (size_t)l * DM; const float* wr = p.in(I_W_ROUTER) + (size_t)l * DM * NE;
    LAS unsigned char* L = c.lds;
    __syncthreads();
    for (int ci = c.tid; ci < DM * 4; ci += NTHR) { const int k = ci >> 2, part = ci & 3; const int slot = (4 * (k >> 8) + (k & 3)) * 64 + ((k & 255) >> 2);
        *(LAS f32x4*)(L + slot * 64 + 16 * part) = *(const f32x4*)(wr + (size_t)k * NE + 4 * part); }
    __syncthreads();
    for (int m = gw; m < NT; m += NGW) {
        f32x4 v[8]; float lg[16];
        row_load_f32((const float*)(p.ws() + WS_XRES) + (size_t)m * DM, c.lane, v);
        const float rstd = rsqrtf(row_ssq(v) * (1.f / DM) + RMS_EPS);
#pragma unroll
        for (int j = 0; j < 8; ++j) v[j] = v[j] * rstd * *(const f32x4*)(gain + 256 * j + 4 * c.lane);
        if (c.lane == 0) ((float*)(p.ws() + WS_RS + RS_MOE))[m] = rstd;
#pragma unroll
        for (int e = 0; e < 16; ++e) lg[e] = 0.f;
#pragma unroll
        for (int j = 0; j < 8; ++j)
#pragma unroll
            for (int q = 0; q < 4; ++q) { const LAS f32x4* wp = (const LAS f32x4*)(L + ((4 * j + q) * 64 + c.lane) * 64); const float hv = v[j][q];
#pragma unroll
                for (int e4 = 0; e4 < 4; ++e4) { const f32x4 wv = wp[e4];
                    lg[e4 * 4 + 0] += hv * wv.x; lg[e4 * 4 + 1] += hv * wv.y; lg[e4 * 4 + 2] += hv * wv.z; lg[e4 * 4 + 3] += hv * wv.w; }
                if (q & 1) __builtin_amdgcn_sched_barrier(0); }
        float mx = -INFINITY;
#pragma unroll
        for (int e = 0; e < 16; ++e) { lg[e] = wave_sum(lg[e]); mx = fmaxf(mx, lg[e]); }
        float sum = 0.f;
#pragma unroll
        for (int e = 0; e < 16; ++e) { lg[e] = expf(lg[e] - mx); sum += lg[e]; }
        if (c.lane < 16) { float a = 0.f;
#pragma unroll
            for (int e = 0; e < 16; ++e) a = (c.lane == e) ? lg[e] : a;
            ((float*)(p.ws() + WS_AFF))[(size_t)m * NE + c.lane] = a / sum; }
    }
}

__device__ __forceinline__ void ph_topk(const PD& p, const Ctx& c) {
    LAS float* a = (LAS float*)c.lds;
    const float* aff = (const float*)(p.ws() + WS_AFF); int* idx = (int*)(p.ws() + WS_IDX); float* gs = (float*)(p.ws() + WS_GSEL); int* inv = (int*)(p.ws() + WS_INV);
    for (int u = c.bid; u < NB * NE * 4; u += c.G) {
        const int qd = u & 3, e = (u >> 2) % NE, b = u / (4 * NE);
        __syncthreads();
        for (int t = c.tid; t < SEQ; t += NTHR) a[t] = aff[(size_t)(b * SEQ + t) * NE + e];
        __syncthreads();
        const int i = qd * NTHR + c.tid; const float ai = a[i]; int rank = 0;
        for (int j4 = 0; j4 < SEQ / 4; ++j4) { const f32x4 av = *(const LAS f32x4*)(a + 4 * j4); const int j = 4 * j4;
            rank += (av.x > ai || (av.x == ai && j < i)) ? 1 : 0; rank += (av.y > ai || (av.y == ai && j + 1 < i)) ? 1 : 0;
            rank += (av.z > ai || (av.z == ai && j + 2 < i)) ? 1 : 0; rank += (av.w > ai || (av.w == ai && j + 3 < i)) ? 1 : 0; }
        if (rank < CAP) { idx[(b * NE + e) * CAP + rank] = i; gs[(b * NE + e) * CAP + rank] = ai; inv[(size_t)(b * SEQ + i) * NE + e] = rank; }
        else inv[(size_t)(b * SEQ + i) * NE + e] = -1;
    }
}

__device__ __forceinline__ void ph_gather(const PD& p, const Ctx& c) {
    const int gw = c.bid * NWAVES + c.wave, NGW = c.G * NWAVES;
    const int* idx = (const int*)(p.ws() + WS_IDX);
    for (int r = gw; r < NE * NB * CAP; r += NGW) { const int e = r / (NB * CAP), b = (r / CAP) % NB, slot = r % CAP;
        const int t = idx[(b * NE + e) * CAP + slot];
        if (c.lane == 0) ((float*)(p.ws() + WS_RS + RS_X))[r] = ((const float*)(p.ws() + WS_RS + RS_MOE))[b * SEQ + t];
        const u32x4* s = (const u32x4*)((const bf16_t*)(p.ws() + WS_HN) + (size_t)(b * SEQ + t) * DM); u32x4* d = (u32x4*)((bf16_t*)(p.ws() + WS_XE) + (size_t)r * DM);
#pragma unroll
        for (int j = 0; j < 4; ++j) d[64 * j + c.lane] = s[64 * j + c.lane]; }
}

__device__ __forceinline__ void ph_combine(const PD& p, const Ctx& c, int l) {
    const int gw = c.bid * NWAVES + c.wave, NGW = c.G * NWAVES;
    const int* inv = (const int*)(p.ws() + WS_INV); const float* gs = (const float*)(p.ws() + WS_GSEL); const float* ym = (const float*)(p.ws() + WS_YMOE);
    for (int m = gw; m < NT; m += NGW) { const int b = m / SEQ;
        float* xr = (float*)(p.ws() + WS_XRES) + (size_t)m * DM;
        f32x4 v[8]; row_load_f32(xr, c.lane, v);
        for (int e = 0; e < NE; ++e) { const int slot = inv[(size_t)m * NE + e];
            if (slot >= 0) { const float g = gs[(b * NE + e) * CAP + slot]; const float* yr = ym + ((size_t)e * 1024 + b * CAP + slot) * DM;
#pragma unroll
                for (int j = 0; j < 8; ++j) v[j] = v[j] + g * *(const f32x4*)(yr + 256 * j + 4 * c.lane); } }
        if (l == DEPTH - 1) { const float rstd = rsqrtf(row_ssq(v) * (1.f / DM) + RMS_EPS); float* orow = p.out() + (size_t)m * DM; const float* gain = p.in(I_FINAL_NORM);
#pragma unroll
            for (int j = 0; j < 8; ++j) *(f32x4*)(orow + 256 * j + 4 * c.lane) = v[j] * rstd * *(const f32x4*)(gain + 256 * j + 4 * c.lane); }
        else { const float rstd = row_store_x(v, xr, (bf16_t*)(p.ws() + WS_HN) + (size_t)m * DM, c.lane);
            if (c.lane == 0) ((float*)(p.ws() + WS_RS + RS_MIX))[m] = rstd; }
    }
}
template <int PH> __device__ __forceinline__ void run_phase(const Ctx& c_in, int l) {
    asm volatile("; PHASE_MARK %0" :: "n"(PH));
    Ctx c = c_in; { int ln; asm volatile("v_mbcnt_lo_u32_b32 %0, -1, 0\n\tv_mbcnt_hi_u32_b32 %0, -1, %0" : "=v"(ln)); c.lane = ln; c.tid = c_in.wave * 64 + ln; }
    PD p; { KArgQ q = (KArgQ)__builtin_amdgcn_kernarg_segment_ptr(); asm volatile("" : "+s"(q)); p.q = q; }
    unsigned char* ws = p.ws();
    if constexpr (PH == PH_CVT) ph_cvt(p, c);
    else if constexpr (PH == PH_PRE) ph_pre(p, c);
    else if constexpr (PH == PH_INPROJ) {
        pg8::Gemm g{(const bf16_t*)(ws + WS_HN), (const bf16_t*)(ws + WS_WIN) + (size_t)l * PIN * DM, DM};
        pg8::StaticOrder S; S.init(NT, PIN, c.G, c.bid);
        EpiInProj E{(bf16_t*)(ws + WS_PROJ), (const float*)(ws + WS_ROT), (const float*)(ws + WS_ROT) + SEQ * 64, (const float*)(ws + WS_RS + RS_MIX)};
        pg8::gemm_phase(c.lds, c.tid, g, S, E);
    }
    else if constexpr (PH == PH_NA) ph_na(p, c, l);
    else if constexpr (PH == PH_HYPRE) ph_hypre(p, c, l);
    else if constexpr (PH == PH_HYCONV) ph_hyconv(p, c, l);
    else if constexpr (PH == PH_RET) ph_ret(p, c, l);
    else if constexpr (PH == PH_GNORM) ph_gnorm(p, c, l);
    else if constexpr (PH == PH_OUT) {
        pg8::Gemm g{(const bf16_t*)(ws + WS_YN), (const bf16_t*)(ws + WS_WOUT) + (size_t)l * DM * DM, DM};
        pg8::StaticOrder S; S.init(NT, DM, c.G, c.bid);
        EpiResid E{(float*)(ws + WS_XRES), (bf16_t*)(ws + WS_HN), (float*)(ws + WS_RS + RS_SSQ)};
        pg8::gemm_phase(c.lds, c.tid, g, S, E);
    }
    else if constexpr (PH == PH_CQ) {
        pg8::Gemm g{(const bf16_t*)(ws + WS_HN), (const bf16_t*)(ws + WS_WCQ) + (size_t)l * DM * DM, DM};
        pg8::StaticOrder S; S.init(NT, DM, c.G, c.bid);
        LAS float* rl = (LAS float*)(c.lds + pg8::STAGE_BYTES);
        { pg8::Unit u0; if (S.next(0, u0)) { const int row = c.tid >> 1, hf = c.tid & 1; const float* sp = (const float*)(ws + WS_RS + RS_SSQ) + (size_t)(u0.pm * 256 + row) * 32 + 16 * hf;
            const f32x4 a0 = *(const f32x4*)sp, a1 = *(const f32x4*)(sp + 4), a2 = *(const f32x4*)(sp + 8), a3 = *(const f32x4*)(sp + 12);
            float s = ((a0.x + a0.y) + (a0.z + a0.w)) + ((a1.x + a1.y) + (a1.z + a1.w)) + ((a2.x + a2.y) + (a2.z + a2.w)) + ((a3.x + a3.y) + (a3.z + a3.w));
            s += __shfl_xor(s, 1);
            if (hf == 0) rl[row] = rsqrtf(s * (1.f / DM) + RMS_EPS); } }
        __syncthreads();
        EpiBf16 E{(bf16_t*)(ws + WS_QC), DM, rl};
        pg8::gemm_phase(c.lds, c.tid, g, S, E);
    }
    else if constexpr (PH == PH_CKV) {
        pg8::Gemm g{(const bf16_t*)(ws + WS_MEMN), (const bf16_t*)(ws + WS_WCKV) + (size_t)l * 4096 * DM, DM};
        pg8::StaticOrder S; S.init(NB * NMEM, 4096, c.G, (c.bid + 160) & 255);
        EpiBf16 E{(bf16_t*)(ws + WS_KVC) + (size_t)l * 1024 * 4096, 4096, nullptr};
        pg8::gemm_phase(c.lds, c.tid, g, S, E);
    }
    else if constexpr (PH == PH_XATT) ph_xatt(p, c, l);
    else if constexpr (PH == PH_CO) {
        pg8::Gemm g{(const bf16_t*)(ws + WS_OC), (const bf16_t*)(ws + WS_WCO) + (size_t)l * DM * DM, DM};
        pg8::StaticOrder S; S.init(NT, DM, c.G, c.bid);
        EpiResid E{(float*)(ws + WS_XRES), (bf16_t*)(ws + WS_HN), nullptr};
        pg8::gemm_phase(c.lds, c.tid, g, S, E);
    }
    else if constexpr (PH == PH_ROUTER) ph_router(p, c, l);
    else if constexpr (PH == PH_TOPK) ph_topk(p, c);
    else if constexpr (PH == PH_GATHER) ph_gather(p, c);
    else if constexpr (PH == PH_GU) {
        pg8::Gemm g{(const bf16_t*)(ws + WS_XE), (const bf16_t*)(ws + WS_WGU) + (size_t)l * NE * 4096 * DM, DM};
        pg8::MoeOrder S; S.init(16, c.G, c.bid);
        EpiGU E{(bf16_t*)(ws + WS_ACT), 16, (const float*)(ws + WS_RS + RS_X)};
        pg8::gemm_phase(c.lds, c.tid, g, S, E);
    }
    else if constexpr (PH == PH_DOWN) {
        pg8::Gemm g{(const bf16_t*)(ws + WS_ACT), (const bf16_t*)(ws + WS_WDN) + (size_t)l * NE * DM * FF, FF};
        pg8::MoeOrder S; S.init(8, c.G, c.bid);
        EpiDown E{(float*)(ws + WS_YMOE), 8};
        pg8::gemm_phase(c.lds, c.tid, g, S, E);
    }
    else if constexpr (PH == PH_COMBINE) ph_combine(p, c, l);
    else if constexpr (PH == PH_KCOPY) ph_kcopy(p, c);
}

__global__ void __launch_bounds__(NTHR, 2) mega_fwd(P p) {
    extern __shared__ __attribute__((aligned(16))) unsigned char lds_raw[];
    Ctx c; c.tid = 0; c.lane = 0; c.wave = __builtin_amdgcn_readfirstlane((int)threadIdx.x >> 6); c.G = gridDim.x; c.bid = blockIdx.x; c.lds = (LAS unsigned char*)lds_raw;
    volatile LAS unsigned* st = (volatile LAS unsigned*)(c.lds + LDS_BYTES - 16);
    if (threadIdx.x < 4) st[threadIdx.x] = 0u;
    __syncthreads();
    (void)xcd_barrier_post((unsigned*)((unsigned char*)(GAS unsigned char*)p.ws + WS_CTL), st);
#ifndef PROBE_MASK
#define PROBE_MASK 0
#endif
#define RUNP(PH, ...) do { run_phase<PH>(__VA_ARGS__); if ((PROBE_MASK >> (PH)) & 1) { GRID_BAR(); run_phase<PH>(__VA_ARGS__); } } while (0)
#define GRID_BAR() do { PD _p; { KArgQ _q = (KArgQ)__builtin_amdgcn_kernarg_segment_ptr(); asm volatile("" : "+s"(_q)); _p.q = _q; } \
        XcdBarrier _b; _b.bar = (unsigned*)(_p.ws() + WS_CTL); _b.x = xb_xcc_id(); _b.st = (volatile LAS unsigned*)(c.lds + LDS_BYTES - 16); xcd_barrier(_b); } while (0)
    RUNP(PH_CVT, c, 0);
    RUNP(PH_PRE, c, 0);
    GRID_BAR();
    for (int l = 0; l < DEPTH; ++l) {
        RUNP(PH_INPROJ, c, l);
        RUNP(PH_CKV, c, l);
        GRID_BAR();
        RUNP(PH_HYPRE, c, l);
        RUNP(PH_NA, c, l);
        if (l == 0) RUNP(PH_KCOPY, c, 0);
        GRID_BAR();
        RUNP(PH_HYCONV, c, l);
        RUNP(PH_RET, c, l);
        GRID_BAR();
        RUNP(PH_GNORM, c, l);
        GRID_BAR();
        RUNP(PH_OUT, c, l);
        GRID_BAR();
        RUNP(PH_CQ, c, l);
        GRID_BAR();
        RUNP(PH_XATT, c, l);
        GRID_BAR();
        RUNP(PH_CO, c, l);
        GRID_BAR();
        RUNP(PH_ROUTER, c, l);
        GRID_BAR();
        RUNP(PH_TOPK, c, l);
        GRID_BAR();
        RUNP(PH_GATHER, c, l);
        GRID_BAR();
        RUNP(PH_GU, c, l);
        GRID_BAR();
        RUNP(PH_DOWN, c, l);
        GRID_BAR();
        RUNP(PH_COMBINE, c, l);
        if (l + 1 < DEPTH) GRID_BAR();
    }
}

extern "C" void kernel_launch(void* const* d_in, const int* in_sizes, int n_in, void* d_out, int out_size, void* d_ws, size_t ws_size, hipStream_t stream) {
    if (n_in != N_IN || out_size != NT * DM || ws_size < WS_END) { fprintf(stderr, "kernel_launch: unexpected shapes (n_in %d, out %d, ws %zu < %zu); nothing launched\n", n_in, out_size, ws_size, (size_t)WS_END); return; }
    static int grid = 0;
    if (!grid) {
        int dev = 0, cus = 0, per_cu = 0;
        if (hipGetDevice(&dev) != hipSuccess || hipDeviceGetAttribute(&cus, hipDeviceAttributeMultiprocessorCount, dev) != hipSuccess) { fprintf(stderr, "kernel_launch: device query failed\n"); return; }
        if (hipFuncSetAttribute((const void*)mega_fwd, hipFuncAttributeMaxDynamicSharedMemorySize, LDS_BYTES) != hipSuccess) { fprintf(stderr, "kernel_launch: hipFuncSetAttribute failed\n"); return; }
        if (hipOccupancyMaxActiveBlocksPerMultiprocessor(&per_cu, (const void*)mega_fwd, NTHR, LDS_BYTES) != hipSuccess || per_cu < 1) fprintf(stderr, "kernel_launch: occupancy query reports %d workgroups per CU\n", per_cu);
        grid = cus;
    }
    P p{};
    for (int i = 0; i < N_IN; ++i) p.in[i] = (const float*)d_in[i];
    p.out = (float*)d_out; p.ws = (unsigned char*)d_ws;
    if (hipMemsetAsync((char*)d_ws + WS_CTL, 0, XCD_BAR_WORDS * sizeof(unsigned), stream) != hipSuccess) { fprintf(stderr, "kernel_launch: memset failed\n"); return; }
    hipLaunchKernelGGL(mega_fwd, dim3(grid), dim3(NTHR), LDS_BYTES, stream, p);
    hipError_t le = hipGetLastError();
    if (le != hipSuccess) fprintf(stderr, "kernel_launch: launch failed: %s\n", hipGetErrorName(le));
}
```
